# Optimizing an MI355X kernel written in HIP

```python
import math, functools
import jax, jax.numpy as jnp
from jax import lax
import numpy as np

D_MODEL = 1024
BATCH = 8
SEQ = 4096
DEPTH = 4

CTX_LEN = 256
GRID_W = 64
N_BRANCH = 4
BRANCH_W = D_MODEL // N_BRANCH
EPS = 1e-6
HY_W = BRANCH_W
HY_ORDER = 2
HY_SHORT = 3
HY_EMB = 33
HY_FFN = 64
HY_TARGET = 1e-2
HY_FAST = 0.3
HY_SLOW = 1.5
CF_W = BRANCH_W
CF_WIDTH = 31
HEAD_DIM = 64
GQA_QH = BRANCH_W // HEAD_DIM
GQA_KVH = GQA_QH // 2
DIFF_H = 4
DIFF_D = BRANCH_W // DIFF_H // 2
DIFF_DV = 2 * DIFF_D
ROPE_BASE = 10000.0
QBLK = 128
D_FF = 2816
N_EXPERTS = 8
TOP_K = 2
D_FF_EXPERT = 3584
MOE_BLK = 256
N_DENSE = (DEPTH + 1) // 2
N_MOE = DEPTH // 2
HY_IN = (HY_ORDER + 1) * HY_W
CF_IN = 2 * CF_W
GQA_IN = (GQA_QH + 2 * GQA_KVH) * HEAD_DIM
DIFF_IN = 2 * (DIFF_H * 2 * DIFF_D) + DIFF_H * DIFF_DV
GATE_IN = N_BRANCH * D_MODEL
D_IN = HY_IN + CF_IN + GQA_IN + DIFF_IN + GATE_IN
IN_OFFSETS = [HY_IN, HY_IN + CF_IN, HY_IN + CF_IN + GQA_IN, HY_IN + CF_IN + GQA_IN + DIFF_IN]
HY_FILT_OUT = 2 * HY_ORDER * HY_W

kernel_name = 'hybrid_gated_mixers_ctx_prefix_dit'


def rmsnorm(x, g):
    xf = x.astype(jnp.float32)
    return (xf * lax.rsqrt(jnp.mean(xf * xf, axis=-1, keepdims=True) + EPS)).astype(x.dtype) * g


def layernorm(x, g, b):
    xf = x.astype(jnp.float32)
    mu = jnp.mean(xf, axis=-1, keepdims=True)
    var = jnp.mean(jnp.square(xf - mu), axis=-1, keepdims=True)
    return ((xf - mu) * lax.rsqrt(var + EPS)).astype(x.dtype) * g + b


def modulate(h, shift, scale):
    return h * (1.0 + scale) + shift


def depthwise_conv(x, w, b):
    pad = w.shape[0] // 2
    y = lax.conv_general_dilated(x, w[:, None, :].astype(x.dtype), window_strides=(1,), padding=[(pad, pad)],
                                 dimension_numbers=('NWC', 'WIO', 'NWC'), feature_group_count=x.shape[-1])
    return y + b


def rope_2d(x, rows, cols):
    half = x.shape[-1] // 2
    nf = half // 2
    inv = ROPE_BASE ** (-jnp.arange(nf, dtype=jnp.float32) / nf)
    bshape = (x.shape[1],) + (1,) * (x.ndim - 3) + (nf,)

    def rot(xa, p):
        ang = (p[:, None] * inv).reshape(bshape)
        cs, sn = jnp.cos(ang), jnp.sin(ang)
        x1, x2 = xa[..., :nf], xa[..., nf:]
        return jnp.concatenate([x1 * cs - x2 * sn, x2 * cs + x1 * sn], axis=-1)

    xf = x.astype(jnp.float32)
    return jnp.concatenate([rot(xf[..., :half], rows), rot(xf[..., half:], cols)], axis=-1).astype(x.dtype)


def hyena_filter_fft(L, w1, b1, w2, b2, w3, b3, w4, freq):
    f32 = jnp.float32
    t = jnp.linspace(0.0, 1.0, L, dtype=f32)[:, None]
    bands = (HY_EMB - 1) // 2
    fr = jnp.linspace(1e-4, bands - 1, bands, dtype=f32)[None, :]
    wpos = 2.0 * math.pi * jnp.arange(L, dtype=f32)[:, None] / L
    z = jnp.concatenate([t, jnp.cos(fr * wpos), -jnp.sin(fr * wpos)], axis=-1)
    fq = freq.astype(f32)
    a = jnp.sin(fq * (z @ w1.astype(f32) + b1.astype(f32)))
    a = jnp.sin(fq * (a @ w2.astype(f32) + b2.astype(f32)))
    a = jnp.sin(fq * (a @ w3.astype(f32) + b3.astype(f32)))
    hf = (a @ w4.astype(f32)).reshape(L, 2, HY_ORDER, HY_W)
    deltas = jnp.abs(jnp.linspace(math.log(HY_TARGET) / HY_SLOW, math.log(HY_TARGET) / HY_FAST, HY_W, dtype=f32))
    hf = hf * jnp.exp(-t[:, :, None, None] * deltas)
    fwd, bwd = hf[:, 0], hf[:, 1]
    k = jnp.concatenate([fwd, jnp.zeros((1, HY_ORDER, HY_W), f32), bwd[1:][::-1]], axis=0)
    k = k * lax.rsqrt(jnp.sum(k * k, axis=0, keepdims=True) + EPS)
    return jnp.fft.rfft(k, axis=0)


def hyena(u, short_w, short_b, w1, b1, w2, b2, w3, b3, w4, freq, bias):
    L = u.shape[1]
    u = depthwise_conv(u, short_w, short_b)
    x1, x2, v = jnp.split(u, 3, axis=-1)
    kf = hyena_filter_fft(L, w1, b1, w2, b2, w3, b3, w4, freq)
    z = v
    for o, gate in enumerate((x1, x2)):
        zf = jnp.fft.rfft(z.astype(jnp.float32), n=2 * L, axis=1)
        conv = jnp.fft.irfft(zf * kf[:, o], n=2 * L, axis=1)[:, :L]
        z = gate * (conv.astype(z.dtype) + bias[o] * z)
    return z


def conformer_conv(u, dw_w, dw_b, ln_g, ln_b):
    a, g = jnp.split(u, 2, axis=-1)
    y = depthwise_conv(a * jax.nn.sigmoid(g), dw_w, dw_b)
    return jax.nn.silu(layernorm(y, ln_g, ln_b))


def gqa_qkv(u, qn, kn, pos):
    B, L, _ = u.shape
    nq, nk = GQA_QH * HEAD_DIM, GQA_KVH * HEAD_DIM
    q = rmsnorm(u[..., :nq].reshape(B, L, GQA_QH, HEAD_DIM), qn)
    k = rmsnorm(u[..., nq:nq + nk].reshape(B, L, GQA_KVH, HEAD_DIM), kn)
    v = u[..., nq + nk:].reshape(B, L, GQA_KVH, HEAD_DIM)
    if pos is not None:
        q, k = rope_2d(q, *pos), rope_2d(k, *pos)
    return q.reshape(B, L, GQA_KVH, GQA_QH // GQA_KVH, HEAD_DIM), k, v


def gqa_core(qb, k, v):
    s = jnp.einsum('bqhgd,bkhd->bhgqk', qb, k).astype(jnp.float32) * (HEAD_DIM ** -0.5)
    p = jax.nn.softmax(s, axis=-1)
    return jnp.einsum('bhgqk,bkhd->bqhgd', p.astype(v.dtype), v)


def diff_qkv(u, qn, kn, pos):
    B, L, _ = u.shape
    nq = DIFF_H * 2 * DIFF_D
    q = rmsnorm(u[..., :nq].reshape(B, L, DIFF_H, 2, DIFF_D), qn)
    k = rmsnorm(u[..., nq:2 * nq].reshape(B, L, DIFF_H, 2, DIFF_D), kn)
    v = u[..., 2 * nq:].reshape(B, L, DIFF_H, DIFF_DV)
    if pos is not None:
        q, k = rope_2d(q, *pos), rope_2d(k, *pos)
    return q, k, v


def diff_core(qb, k, v, lam):
    s = jnp.einsum('bqhmd,bkhmd->bhmqk', qb, k).astype(jnp.float32) * (DIFF_D ** -0.5)
    p = jax.nn.softmax(s, axis=-1)
    a = p[:, :, 0] - lam * p[:, :, 1]
    return jnp.einsum('bhqk,bkhd->bqhd', a.astype(v.dtype), v)


def diff_out(y, g, lam_init):
    B, L = y.shape[:2]
    return (rmsnorm(y, g) * (1.0 - lam_init)).reshape(B, L, DIFF_H * DIFF_DV)


def sweep_query_blocks(fn, q, k, v):
    B, L = q.shape[:2]
    nb = L // QBLK
    qb = jnp.moveaxis(q.reshape((B, nb, QBLK) + q.shape[2:]), 1, 0)
    out = lax.map(lambda qi: fn(qi, k, v), qb)
    return jnp.moveaxis(out, 0, 1).reshape((B, L) + out.shape[3:])


def merge_branches(branches, u_gate, w_branch, w_out):
    D = w_out.shape[0]
    g = jax.nn.sigmoid(u_gate.astype(jnp.float32)).astype(u_gate.dtype)
    acc = g[..., :D] * (branches[0] @ w_branch[0])
    for i in range(1, N_BRANCH):
        acc = acc + g[..., i * D:(i + 1) * D] * (branches[i] @ w_branch[i])
    return acc @ w_out


def swiglu(t, w1, w3, w2):
    return (jax.nn.silu(t @ w1) * (t @ w3)) @ w2


def moe_swiglu(h, w_router, w1, w3, w2):
    n, D = h.shape
    logits = (h @ w_router).astype(jnp.float32)
    top_v, top_e = lax.top_k(logits, TOP_K)
    gate = jax.nn.softmax(top_v, axis=-1)
    nk = n * TOP_K
    flat_e = top_e.reshape(nk)
    flat_tok = jnp.repeat(jnp.arange(n, dtype=jnp.int32), TOP_K)
    flat_g = gate.reshape(nk)
    order = jnp.argsort(flat_e)
    s_e, s_tok, s_g = flat_e[order], flat_tok[order], flat_g[order]
    counts = jnp.bincount(flat_e, length=N_EXPERTS)
    padded = (counts + MOE_BLK - 1) // MOE_BLK * MOE_BLK
    start = jnp.cumsum(counts) - counts
    pend = jnp.cumsum(padded)
    pstart = pend - padded
    dest = pstart[s_e] + jnp.arange(nk, dtype=jnp.int32) - start[s_e]
    n_blocks = -(-nk // MOE_BLK) + N_EXPERTS
    p = n_blocks * MOE_BLK
    tok_p = jnp.full((p,), n, jnp.int32).at[dest].set(s_tok)
    g_p = jnp.zeros((p,), jnp.float32).at[dest].set(s_g)
    blk_e = jnp.minimum(jnp.searchsorted(pend, jnp.arange(n_blocks, dtype=jnp.int32) * MOE_BLK, side='right'),
                        N_EXPERTS - 1)
    h_pad = jnp.concatenate([h, jnp.zeros((1, D), h.dtype)], axis=0)
    xb = h_pad[tok_p].reshape(n_blocks, MOE_BLK, D)

    def expert_block(args):
        xi, e = args
        return (jax.nn.silu(xi @ w1[e]) * (xi @ w3[e])) @ w2[e]

    yb = lax.map(expert_block, (xb, blk_e)).reshape(p, D)
    yb = yb * g_p[:, None].astype(yb.dtype)
    return jnp.zeros((n + 1, D), yb.dtype).at[tok_p].add(yb)[:n]


def setup_inputs(seed: int = 0) -> dict:
    key = jax.random.key(seed)
    ks = iter(jax.random.split(key, 48))
    f32 = jnp.float32
    D = D_MODEL

    def nrm(shape, scale):
        return jax.random.normal(next(ks), shape, f32) * scale

    def gain(shape):
        return 1.0 + nrm(shape, 0.02)

    return {
        'x': nrm((BATCH, SEQ, D), 1.0),
        'c': nrm((BATCH, D), 1.0),
        'ctx': nrm((BATCH, CTX_LEN, D), 1.0),
        'c_ctx': nrm((D,), 1.0),
        'w_ada': nrm((DEPTH, D, 6 * D), 0.5 * D ** -0.5),
        'b_ada': nrm((DEPTH, 6 * D), 0.02),
        'norm_mix': gain((DEPTH, D)),
        'norm_ffn': gain((DEPTH, D)),
        'w_in': nrm((DEPTH, D, D_IN), D ** -0.5),
        'hy_short_w': nrm((DEPTH, HY_SHORT, HY_IN), HY_SHORT ** -0.5),
        'hy_short_b': nrm((DEPTH, HY_IN), 0.02),
        'hy_w1': nrm((DEPTH, HY_EMB, HY_FFN), HY_EMB ** -0.5),
        'hy_b1': nrm((DEPTH, HY_FFN), 0.02),
        'hy_w2': nrm((DEPTH, HY_FFN, HY_FFN), HY_FFN ** -0.5),
        'hy_b2': nrm((DEPTH, HY_FFN), 0.02),
        'hy_w3': nrm((DEPTH, HY_FFN, HY_FFN), HY_FFN ** -0.5),
        'hy_b3': nrm((DEPTH, HY_FFN), 0.02),
        'hy_w4': nrm((DEPTH, HY_FFN, HY_FILT_OUT), HY_FFN ** -0.5),
        'hy_freq': gain((DEPTH, HY_FFN)),
        'hy_bias': nrm((DEPTH, HY_ORDER, HY_W), 1.0),
        'cf_dw_w': nrm((DEPTH, CF_WIDTH, CF_W), CF_WIDTH ** -0.5),
        'cf_dw_b': nrm((DEPTH, CF_W), 0.02),
        'cf_ln_g': gain((DEPTH, CF_W)),
        'cf_ln_b': nrm((DEPTH, CF_W), 0.02),
        'gqa_qn': gain((DEPTH, HEAD_DIM)),
        'gqa_kn': gain((DEPTH, HEAD_DIM)),
        'diff_qn': gain((DEPTH, 2, DIFF_D)),
        'diff_kn': gain((DEPTH, 2, DIFF_D)),
        'diff_lq1': nrm((DEPTH, DIFF_D), 0.1),
        'diff_lk1': nrm((DEPTH, DIFF_D), 0.1),
        'diff_lq2': nrm((DEPTH, DIFF_D), 0.1),
        'diff_lk2': nrm((DEPTH, DIFF_D), 0.1),
        'diff_subln': gain((DEPTH, DIFF_DV)),
        'w_branch': nrm((DEPTH, N_BRANCH, BRANCH_W, D), BRANCH_W ** -0.5),
        'w_out': nrm((DEPTH, D, D), D ** -0.5),
        'ffn_w1': nrm((N_DENSE, D, D_FF), D ** -0.5),
        'ffn_w3': nrm((N_DENSE, D, D_FF), D ** -0.5),
        'ffn_w2': nrm((N_DENSE, D_FF, D), D_FF ** -0.5),
        'moe_router': nrm((N_MOE, D, N_EXPERTS), D ** -0.5),
        'moe_w1': nrm((N_MOE, N_EXPERTS, D, D_FF_EXPERT), D ** -0.5),
        'moe_w3': nrm((N_MOE, N_EXPERTS, D, D_FF_EXPERT), D ** -0.5),
        'moe_w2': nrm((N_MOE, N_EXPERTS, D_FF_EXPERT, D), D_FF_EXPERT ** -0.5),
    }


def reference(x, c, ctx, c_ctx, w_ada, b_ada, norm_mix, norm_ffn, w_in,
              hy_short_w, hy_short_b, hy_w1, hy_b1, hy_w2, hy_b2, hy_w3, hy_b3, hy_w4, hy_freq, hy_bias,
              cf_dw_w, cf_dw_b, cf_ln_g, cf_ln_b, gqa_qn, gqa_kn,
              diff_qn, diff_kn, diff_lq1, diff_lk1, diff_lq2, diff_lk2, diff_subln,
              w_branch, w_out, ffn_w1, ffn_w3, ffn_w2, moe_router, moe_w1, moe_w3, moe_w2):
    f32 = jnp.float32
    B, S, D = x.shape
    n_ctx = ctx.shape[1]
    n_rows = S // GRID_W
    rows = jnp.broadcast_to(jnp.arange(n_rows, dtype=f32)[:, None], (n_rows, GRID_W)).reshape(S)
    cols = jnp.broadcast_to(jnp.arange(GRID_W, dtype=f32)[None, :], (n_rows, GRID_W)).reshape(S)
    pos = (rows, cols)
    s_lat = jax.nn.silu(c)
    s_ctx = jax.nn.silu(c_ctx)
    xc = ctx
    for l in range(DEPTH):
        last = l == DEPTH - 1
        mod = (s_lat @ w_ada[l] + b_ada[l]).reshape(B, 1, 6, D)
        modc = (s_ctx @ w_ada[l] + b_ada[l]).reshape(6, D)
        h = modulate(rmsnorm(x, norm_mix[l]), mod[:, :, 0], mod[:, :, 1])
        hc = modulate(rmsnorm(xc, norm_mix[l]), modc[0], modc[1])
        u_hy, u_cf, u_gqa, u_diff, u_gate = jnp.split(h @ w_in[l], IN_OFFSETS, axis=-1)
        uc_hy, uc_cf, uc_gqa, uc_diff, uc_gate = jnp.split(hc @ w_in[l], IN_OFFSETS, axis=-1)
        lam_init = 0.8 - 0.6 * math.exp(-0.3 * l)
        lam = (jnp.exp(jnp.sum(diff_lq1[l].astype(f32) * diff_lk1[l].astype(f32)))
               - jnp.exp(jnp.sum(diff_lq2[l].astype(f32) * diff_lk2[l].astype(f32))) + lam_init)
        qg, kg, vg = gqa_qkv(u_gqa, gqa_qn[l], gqa_kn[l], pos)
        qgc, kgc, vgc = gqa_qkv(uc_gqa, gqa_qn[l], gqa_kn[l], None)
        qd, kd, vd = diff_qkv(u_diff, diff_qn[l], diff_kn[l], pos)
        qdc, kdc, vdc = diff_qkv(uc_diff, diff_qn[l], diff_kn[l], None)
        hy_p = (hy_short_w[l], hy_short_b[l], hy_w1[l], hy_b1[l], hy_w2[l], hy_b2[l], hy_w3[l], hy_b3[l],
                hy_w4[l], hy_freq[l], hy_bias[l])
        cf_p = (cf_dw_w[l], cf_dw_b[l], cf_ln_g[l], cf_ln_b[l])
        y_gqa = sweep_query_blocks(gqa_core, qg, jnp.concatenate([kg, kgc], axis=1),
                                   jnp.concatenate([vg, vgc], axis=1)).reshape(B, S, BRANCH_W)
        y_diff = sweep_query_blocks(functools.partial(diff_core, lam=lam), qd, jnp.concatenate([kd, kdc], axis=1),
                                    jnp.concatenate([vd, vdc], axis=1))
        branches = (hyena(u_hy, *hy_p), conformer_conv(u_cf, *cf_p), y_gqa,
                    diff_out(y_diff, diff_subln[l], lam_init))
        mix = merge_branches(branches, u_gate, w_branch[l], w_out[l])
        if not last:
            branches_c = (hyena(uc_hy, *hy_p), conformer_conv(uc_cf, *cf_p),
                          gqa_core(qgc, kgc, vgc).reshape(B, n_ctx, BRANCH_W),
                          diff_out(diff_core(qdc, kdc, vdc, lam), diff_subln[l], lam_init))
            xc = xc + modc[2] * merge_branches(branches_c, uc_gate, w_branch[l], w_out[l])
        x = x + mod[:, :, 2] * mix
        tok = modulate(rmsnorm(x, norm_ffn[l]), mod[:, :, 3], mod[:, :, 4]).reshape(B * S, D)
        if not last:
            h2c = modulate(rmsnorm(xc, norm_ffn[l]), modc[3], modc[4]).reshape(B * n_ctx, D)
            tok = jnp.concatenate([tok, h2c], axis=0)
        i = l // 2
        if l % 2 == 0:
            f = swiglu(tok, ffn_w1[i], ffn_w3[i], ffn_w2[i])
        else:
            f = moe_swiglu(tok, moe_router[i], moe_w1[i], moe_w3[i], moe_w2[i])
        x = x + mod[:, :, 5] * f[:B * S].reshape(B, S, D)
        if not last:
            xc = xc + modc[5] * f[B * S:].reshape(B, n_ctx, D)
    return x
```

```cpp
#include <hip/hip_runtime.h>
#include <hip/hip_bf16.h>
#include <cstdio>
#include <cstdint>
#include <cmath>

#define GAS __attribute__((address_space(1)))
#define LAS __attribute__((address_space(3)))
typedef unsigned short bf16_t;
typedef short bf16x8 __attribute__((ext_vector_type(8)));
typedef float f32x4 __attribute__((ext_vector_type(4)));
typedef float f32x2 __attribute__((ext_vector_type(2)));
typedef float f32x16 __attribute__((ext_vector_type(16)));
typedef unsigned u32x4 __attribute__((ext_vector_type(4)));
typedef unsigned u32x2 __attribute__((ext_vector_type(2)));
typedef short s16x4 __attribute__((ext_vector_type(4)));
#define RLX_AGENT __ATOMIC_RELAXED, __HIP_MEMORY_SCOPE_AGENT
#define LDS_WAIT() asm volatile("s_waitcnt lgkmcnt(0)" ::: "memory")
#define VM_WAIT() asm volatile("s_waitcnt vmcnt(0)" ::: "memory")

constexpr int DM = 1024, NB = 8, SEQ = 4096, NCTX = 256, DEPTH = 4;
constexpr int TB = SEQ + NCTX;
constexpr int MT = NB * TB;
constexpr int UBW = 2560;
constexpr int OFF_CF = 768, OFF_GQA = 1280, OFF_DIFF = 1792, OFF_GATE = 2560, D_IN = 6656;
constexpr int DFF = 2816, DFFE = 3584, NEXP = 8;
constexpr int NPAN = MT / 256;
constexpr float EPS = 1e-6f;
constexpr float LOG2E = 1.4426950408889634f;

constexpr size_t MiB = 1u << 20;
constexpr size_t WS_CTL = 0, CTL_ZERO_BYTES = 65536;
constexpr size_t WS_MODS = 1 * MiB;
constexpr size_t WS_A3 = 2 * MiB;
constexpr size_t WS_XC = 8 * MiB;
constexpr size_t WS_HB = 16 * MiB;
constexpr size_t WS_UB = 86 * MiB;
constexpr size_t WS_RB = 256 * MiB;
constexpr size_t WS_YB = 528 * MiB;
constexpr size_t WS_QG = 596 * MiB;
constexpr size_t WS_KG = 613 * MiB;
constexpr size_t WS_QD = 622 * MiB;
constexpr size_t WS_KD = 656 * MiB;
constexpr size_t WS_HT = 690 * MiB;
constexpr size_t WS_KF = 744 * MiB;
constexpr size_t WS_KC = 776 * MiB;
constexpr size_t WS_WIN = 778 * MiB;
constexpr size_t WS_WBR = 791 * MiB;
constexpr size_t WS_WOUT = 793 * MiB;
constexpr size_t WS_WF1 = 795 * MiB;
constexpr size_t WS_WF2 = 806 * MiB;
constexpr size_t WS_WM13 = 812 * MiB;
constexpr size_t WS_WM2 = 924 * MiB;
constexpr size_t WS_TOK = 980 * MiB;
constexpr size_t WS_GW = 982 * MiB;
constexpr size_t WS_END = 984 * MiB;
constexpr size_t WS_HID = WS_UB;
constexpr size_t WS_SLOT = 576 * MiB;
constexpr int CW_TMO = 0, CW_BAR = 4096, CW_MOE = 8192, CW_Q = 12288;

constexpr int LDS_BYTES = 163840, MISC_OFF = LDS_BYTES - 256;
constexpr int NWAVES = 8, NTHR = 512;

__device__ __forceinline__ unsigned f2bf(float f) { unsigned u = __builtin_bit_cast(unsigned, f); return (u + 0x7fffu + ((u >> 16) & 1u)) >> 16; }
__device__ __forceinline__ unsigned pk2(float lo, float hi) { return f2bf(lo) | (f2bf(hi) << 16); }
typedef __bf16 bf16x2_v __attribute__((ext_vector_type(2)));
__device__ __forceinline__ unsigned cvt_pk_bf16(float lo, float hi) { f32x2 v = {lo, hi}; bf16x2_v b = __builtin_convertvector(v, bf16x2_v); return __builtin_bit_cast(unsigned, b); }
__device__ __forceinline__ float bf_lo(unsigned w) { return __uint_as_float(w << 16); }
__device__ __forceinline__ float bf_hi(unsigned w) { return __uint_as_float(w & 0xffff0000u); }
__device__ __forceinline__ float bf2f(bf16_t b) { return __uint_as_float(((unsigned)b) << 16); }
template <int N> __device__ __forceinline__ float dpp_row_ror(float v) { return __builtin_bit_cast(float, __builtin_amdgcn_update_dpp(0, __builtin_bit_cast(int, v), 0x120 + N, 0xf, 0xf, false)); }
__device__ __forceinline__ float wave_sum(float v) {
    v += dpp_row_ror<1>(v); v += dpp_row_ror<2>(v); v += dpp_row_ror<4>(v); v += dpp_row_ror<8>(v);
    const int iv = __builtin_bit_cast(int, v);
    const float a = __builtin_bit_cast(float, __builtin_amdgcn_readlane(iv, 0)), b = __builtin_bit_cast(float, __builtin_amdgcn_readlane(iv, 16));
    const float c = __builtin_bit_cast(float, __builtin_amdgcn_readlane(iv, 32)), d = __builtin_bit_cast(float, __builtin_amdgcn_readlane(iv, 48));
    return (a + b) + (c + d);
}
__device__ __forceinline__ int opaque_tid(int wv) { int ln; asm volatile("v_mbcnt_lo_u32_b32 %0, -1, 0\n\tv_mbcnt_hi_u32_b32 %0, -1, %0" : "=v"(ln)); return wv * 64 + ln; }
__device__ __forceinline__ GAS unsigned char* opaque_ptr(const void* p) { const unsigned long long v = (unsigned long long)p; unsigned lo = __builtin_amdgcn_readfirstlane((unsigned)v), hi = __builtin_amdgcn_readfirstlane((unsigned)(v >> 32));
    asm volatile("" : "+s"(lo), "+s"(hi)); return (GAS unsigned char*)(((unsigned long long)hi << 32) | lo); }
#define INP(F, i) ((const float*)(const GAS float*)((F).in[i]))
__device__ __forceinline__ float fast_sigmoid(float x) { return __builtin_amdgcn_rcpf(1.0f + __builtin_amdgcn_exp2f(-x * LOG2E)); }

#define XB_TMO      128
#define XB_XCNT(j)  (256  + 64 * (j))
#define XB_XSUB(j)  (1280 + 64 * (j))
#define XB_XGEN(j)  (2304 + 64 * (j))
#define XB_TOP      3328
#define XB_TOPGEN   3392
#define XCD_BAR_WORDS 3456
#define XB_SPIN_CAP (1u << 18)
__device__ __forceinline__ unsigned xb_ld(unsigned* p)              { return __hip_atomic_load(p, __ATOMIC_RELAXED, __HIP_MEMORY_SCOPE_AGENT); }
__device__ __forceinline__ unsigned xb_add(unsigned* p, unsigned v) { return __hip_atomic_fetch_add(p, v, __ATOMIC_RELAXED, __HIP_MEMORY_SCOPE_AGENT); }
__device__ __forceinline__ unsigned xb_xcc_id() { return (unsigned)__builtin_amdgcn_s_getreg((3 << 11) | 20) & 0xFu; }
#define XB_SPIN(cond, bar) do { unsigned _sp = 0; while (cond) { __builtin_amdgcn_s_sleep(1); \
    if ((++_sp & 255u) == 0u) { if (xb_ld(&(bar)[XB_TMO])) break; if (_sp > XB_SPIN_CAP) { atomicAdd(&(bar)[XB_TMO], 1u); break; } } } } while (0)
struct XcdBarrier { unsigned* bar; unsigned x; volatile LAS unsigned* st; };
__device__ __forceinline__ XcdBarrier xcd_barrier_post(unsigned* bar, volatile LAS unsigned* st) {
    XcdBarrier b; b.bar = bar; b.x = xb_xcc_id(); b.st = st;
    if (threadIdx.x == 0) (void)xb_add(&bar[XB_XCNT(b.x)], 1u);
    return b;
}
__device__ __forceinline__ void xcd_barrier_complete(unsigned* bar, unsigned x, unsigned& nloc, unsigned& nx) {
    const unsigned G = gridDim.x * gridDim.y * gridDim.z;
    unsigned sum, cnt, mine, sp = 0u;
    for (;;) {
        sum = 0u; cnt = 0u; mine = 0u;
#pragma unroll
        for (unsigned j = 0; j < 16; ++j) { const unsigned c = xb_ld(&bar[XB_XCNT(j)]); sum += c; cnt += (c > 0u) ? 1u : 0u; mine = (j == x) ? c : mine; }
        if (sum == G) break;
        __builtin_amdgcn_s_sleep(1);
        if ((++sp & 255u) == 0u) { if (xb_ld(&bar[XB_TMO])) break; if (sp > XB_SPIN_CAP) { atomicAdd(&bar[XB_TMO], 1u); break; } }
    }
    nloc = mine > 0u ? mine : 1u; nx = cnt > 0u ? cnt : 1u;
}
__device__ __forceinline__ void xcd_barrier(const XcdBarrier& b) {
    asm volatile("s_waitcnt vmcnt(0)" ::: "memory");
    __syncthreads();
    if (threadIdx.x == 0) {
        unsigned* bar = b.bar;
        __builtin_amdgcn_s_waitcnt(0);
        unsigned nloc = b.st[0], nx = b.st[1];
        if (nloc == 0u) { xcd_barrier_complete(bar, b.x, nloc, nx); b.st[0] = nloc; b.st[1] = nx; }
        const unsigned old = xb_add(&bar[XB_XSUB(b.x)], 1u);
        const unsigned gen = old / nloc;
        if (old + 1u == (gen + 1u) * nloc) {
            __builtin_amdgcn_fence(__ATOMIC_RELEASE, "agent");
            asm volatile("s_waitcnt vmcnt(0)" ::: "memory");
            const unsigned og = xb_add(&bar[XB_TOP], 1u);
            const unsigned tg = og / nx;
            if (og + 1u == (tg + 1u) * nx) xb_add(&bar[XB_TOPGEN], 1u);
            else XB_SPIN(xb_ld(&bar[XB_TOPGEN]) == tg, bar);
            __builtin_amdgcn_fence(__ATOMIC_ACQUIRE, "agent");
            xb_add(&bar[XB_XGEN(b.x)], 1u);
            asm volatile("s_waitcnt vmcnt(0)" ::: "memory");
        } else {
            XB_SPIN(xb_ld(&bar[XB_XGEN(b.x)]) == gen, bar);
            __builtin_amdgcn_fence(__ATOMIC_ACQUIRE, "agent");
            asm volatile("s_waitcnt vmcnt(0)" ::: "memory");
        }
    }
    __syncthreads();
}

namespace pg8 {
constexpr int BM = 256, BK = 64, HALF = 128, HTB = HALF * BK * 2, STAGE_BYTES = 8 * HTB, NXCD = 8, WGM = 8;
__host__ __device__ __forceinline__ int lds_byte(int r, int c) { const int st = (r >> 4) * 2 + (c >> 5), rr = r & 15, cc = c & 31, ob = rr * 64 + cc * 2; return st * 1024 + (ob ^ (((ob >> 9) & 1) << 5)); }
__host__ __device__ __forceinline__ void stage_rc(int b, int& R, int& C) { const int st = b / 1024, sb = b % 1024, swz = sb ^ (((sb >> 9) & 1) << 5); R = (st >> 1) * 16 + swz / 64; C = (st & 1) * 32 + (swz % 64) / 2; }
__host__ __device__ __forceinline__ int perm32(int rho) { const int n = rho >> 4, i = rho & 15; return 8 * (i >> 2) + 4 * n + (i & 3); }

struct Unit { int pm, pn; const char* a; const char* b; int aux; };

struct GridOrder {
    int nM, nN, nwg, G, c;
    __device__ void init(int nM_, int nN_, int G_, int c_) { nM = nM_; nN = nN_; nwg = nM * nN; G = G_; c = c_; }
    __device__ __forceinline__ bool tile(int i, int& pm, int& pn) const {
        const long L = (long)i * G + c; if (L >= nwg) return false;
        int wgid = (int)L; { const int q = nwg / NXCD, r = nwg % NXCD, xcd = wgid % NXCD, off = wgid / NXCD; wgid = (xcd < r ? xcd * (q + 1) : r * (q + 1) + (xcd - r) * q) + off; }
        const int nig = WGM * nN, gid = wgid / nig, fm = gid * WGM, gsz = (nM - fm) < WGM ? (nM - fm) : WGM;
        pm = fm + ((wgid % nig) % gsz); pn = (wgid % nig) / gsz; return true;
    }
};

template <class Epi, class Sched, bool GATHER = false, bool HOOK = false, bool ALIGN = true>
__device__ __forceinline__ void gemm_phase(LAS unsigned char* lds, const int K, const Sched& S, const Epi& E, const int wv) {
    const int tid = opaque_tid(wv), wid = __builtin_amdgcn_readfirstlane(tid >> 6), lane = tid & 63, wr = wid >> 2, wc = wid & 3, fr = lane & 15, fq = lane >> 4;
    const int nt = K / BK;
    unsigned voffB[2], vA0[2], vA1[2], nA0[2], nA1[2];
#pragma unroll
    for (int i = 0; i < 2; ++i) { int R, C; stage_rc(tid * 16 + i * 8192, R, C); const int Rb = Epi::PERM ? ((R & ~31) + perm32(R & 31)) : R;
        vA0[i] = (unsigned)(R * K + C) * 2u; vA1[i] = 0u; voffB[i] = (unsigned)(Rb * K + C) * 2u; nA0[i] = 0u; nA1[i] = 0u; }
#define PG8_RR(i) ((((wid + 8 * (i)) >> 1) << 4) + (lane >> 2))
    const size_t kstep = (size_t)(BK * 2);
    const size_t hstep = (size_t)HALF * K * 2;
    const unsigned ldsw = (unsigned)wid * 1024u;
    const int aoff = lds_byte(wr * 64 + fr, fq * 8), boff = lds_byte(wc * 32 + fr, fq * 8);
#define PG8_SA(b, h) (((b) * 2 + (h)) * HTB)
#define PG8_SB(b, h) ((4 + (b) * 2 + (h)) * HTB)
#define PG8_STAGE(bufoff, gbase, voff) do { _Pragma("unroll") for (int _i = 0; _i < 2; ++_i) \
        __builtin_amdgcn_global_load_lds((const unsigned*)((const char*)(gbase) + (voff)[_i]), (LAS unsigned*)(lds + (bufoff) + ldsw + _i * 8192), 16, 0, 0); } while (0)
#define PG8_LDA(dst, b, h) do { _Pragma("unroll") for (int m = 0; m < 4; ++m) _Pragma("unroll") for (int k = 0; k < 2; ++k) dst[m][k] = *(const LAS bf16x8*)(lds + PG8_SA(b, h) + aoff + m * 2048 + k * 1024); } while (0)
#define PG8_LDB(dst, b, h) do { _Pragma("unroll") for (int n = 0; n < 2; ++n) _Pragma("unroll") for (int k = 0; k < 2; ++k) dst[n][k] = *(const LAS bf16x8*)(lds + PG8_SB(b, h) + boff + n * 2048 + k * 1024); } while (0)
#define PG8_MMA(ai, bj, At, Bt) do { __builtin_amdgcn_s_setprio(1); _Pragma("unroll") for (int m = 0; m < 4; ++m) _Pragma("unroll") for (int n = 0; n < 2; ++n) _Pragma("unroll") for (int k = 0; k < 2; ++k) \
        acc[ai][bj][m][n] = __builtin_amdgcn_mfma_f32_16x16x32_bf16(Bt[n][k], At[m][k], acc[ai][bj][m][n], 0, 0, 0); __builtin_amdgcn_s_setprio(0); } while (0)
#define PG8_WAIT_V(n) asm volatile("s_waitcnt vmcnt(" #n ")" ::: "memory")
#define PG8_WAIT_L(n) asm volatile("s_waitcnt lgkmcnt(" #n ")" ::: "memory")
#define PG8_BAR __builtin_amdgcn_s_barrier()
#define PG8_SCHED __builtin_amdgcn_sched_barrier(0)
    Unit cur, nxt; int ui = 0;
    if (!S.next(0, cur)) return;
    f32x4 acc[2][2][4][2];
#pragma unroll
    for (int a = 0; a < 2; ++a)
#pragma unroll
        for (int b = 0; b < 2; ++b)
#pragma unroll
            for (int m = 0; m < 4; ++m)
#pragma unroll
                for (int n = 0; n < 2; ++n) acc[a][b][m][n] = (f32x4){0.f, 0.f, 0.f, 0.f};
    bf16x8 At[4][2], B0[2][2], B1[2][2];
    const char* cA0 = cur.a; const char* cA1 = GATHER ? cur.a : cur.a + hstep; const char* cB = cur.b;
    unsigned ccol[2] = {0u, 0u};
    if constexpr (GATHER) {
#pragma unroll
        for (int i = 0; i < 2; ++i) { ccol[i] = vA0[i] - (unsigned)(PG8_RR(i) * K) * 2u; vA0[i] = S.row_off(cur, PG8_RR(i)) + ccol[i]; vA1[i] = S.row_off(cur, PG8_RR(i) + HALF) + ccol[i]; }
    }
    PG8_STAGE(PG8_SB(0, 0), cB, voffB); PG8_STAGE(PG8_SB(0, 1), cB + hstep, voffB); PG8_STAGE(PG8_SA(0, 0), cA0, vA0); if constexpr (GATHER) { PG8_STAGE(PG8_SA(0, 1), cA1, vA1); } else { PG8_STAGE(PG8_SA(0, 1), cA1, vA0); }
    if (wr == 1) PG8_BAR;
    PG8_WAIT_V(2); PG8_BAR;
    PG8_STAGE(PG8_SB(1, 0), cB + kstep, voffB); PG8_STAGE(PG8_SA(1, 0), cA0 + kstep, vA0); PG8_STAGE(PG8_SB(1, 1), cB + hstep + kstep, voffB);
    PG8_WAIT_V(6); PG8_BAR;
    for (;;) {
        const bool has_next = S.next(ui + 1, nxt);
        const char* nAp0 = has_next ? nxt.a : cA0; const char* nAp1 = has_next ? (GATHER ? nxt.a : nxt.a + hstep) : cA1; const char* nB = has_next ? nxt.b : cB;
        if constexpr (GATHER) {
            if (has_next) {
#pragma unroll
                for (int i = 0; i < 2; ++i) { nA0[i] = S.row_off(nxt, PG8_RR(i)) + ccol[i]; nA1[i] = S.row_off(nxt, PG8_RR(i) + HALF) + ccol[i]; }
            } else {
#pragma unroll
                for (int i = 0; i < 2; ++i) { nA0[i] = vA0[i]; nA1[i] = vA1[i]; }
            }
        }
        for (int t = 0; t < nt; t += 2) {
            const bool last = (t == nt - 2);
            const char* a1h1 = cA1 + (size_t)(t + 1) * kstep;
            const char* a2h0 = last ? nAp0 : cA0 + (size_t)(t + 2) * kstep; const char* a2h1 = last ? nAp1 : cA1 + (size_t)(t + 2) * kstep;
            const char* b2 = last ? nB : cB + (size_t)(t + 2) * kstep;
            const char* a3h0 = a2h0 + kstep; const char* b3 = b2 + kstep;
            unsigned w0[2], w1[2], u1[2];
#pragma unroll
            for (int i = 0; i < 2; ++i) { if constexpr (GATHER) { w0[i] = last ? nA0[i] : vA0[i]; w1[i] = last ? nA1[i] : vA1[i]; u1[i] = vA1[i]; } else { w0[i] = vA0[i]; w1[i] = vA0[i]; u1[i] = vA0[i]; } }
            PG8_LDB(B0, 0, 0); PG8_LDB(B1, 0, 1); PG8_SCHED; PG8_LDA(At, 0, 0); PG8_STAGE(PG8_SA(1, 1), a1h1, u1);
            PG8_WAIT_V(8); PG8_WAIT_L(0); PG8_BAR; PG8_MMA(0, 0, At, B0); PG8_MMA(0, 1, At, B1); PG8_BAR; PG8_SCHED;
            PG8_LDA(At, 0, 1); PG8_STAGE(PG8_SB(0, 0), b2, voffB); PG8_STAGE(PG8_SB(0, 1), b2 + hstep, voffB); PG8_STAGE(PG8_SA(0, 0), a2h0, w0);
            PG8_WAIT_V(8); PG8_WAIT_L(0); PG8_BAR; PG8_MMA(1, 0, At, B0); PG8_MMA(1, 1, At, B1); PG8_BAR; PG8_SCHED;
            PG8_LDB(B0, 1, 0); PG8_LDB(B1, 1, 1); PG8_SCHED; PG8_LDA(At, 1, 0); PG8_STAGE(PG8_SA(0, 1), a2h1, w1);
            PG8_WAIT_V(8); PG8_WAIT_L(0); PG8_BAR; PG8_MMA(0, 0, At, B0); PG8_MMA(0, 1, At, B1); PG8_BAR; PG8_SCHED;
            PG8_LDA(At, 1, 1); PG8_STAGE(PG8_SB(1, 0), b3, voffB); PG8_STAGE(PG8_SB(1, 1), b3 + hstep, voffB); PG8_STAGE(PG8_SA(1, 0), a3h0, w0);
            PG8_WAIT_V(8); PG8_WAIT_L(0); PG8_BAR; PG8_MMA(1, 0, At, B0); PG8_MMA(1, 1, At, B1); PG8_BAR; PG8_SCHED;
            if constexpr (HOOK) { if ((t & 2) && !last) E.hook(acc, cur, t >> 2, wr, wc, fr, fq); }
        }
        if constexpr (ALIGN) { if (wr == 0) PG8_BAR; }
        E(acc, cur, wr, wc, fr, fq);
        if (!has_next) break;
#pragma unroll
        for (int a = 0; a < 2; ++a)
#pragma unroll
            for (int b = 0; b < 2; ++b)
#pragma unroll
                for (int m = 0; m < 4; ++m)
#pragma unroll
                    for (int n = 0; n < 2; ++n) acc[a][b][m][n] = (f32x4){0.f, 0.f, 0.f, 0.f};
        cur = nxt; cA0 = nAp0; cA1 = nAp1; cB = nB; ++ui;
        if constexpr (GATHER) {
#pragma unroll
            for (int i = 0; i < 2; ++i) { vA0[i] = nA0[i]; vA1[i] = nA1[i]; }
        }
        if constexpr (ALIGN) { if (wr == 1) PG8_BAR; }
    }
    PG8_WAIT_V(0);
    if constexpr (!ALIGN) { if (wr == 0) PG8_BAR; }
    PG8_BAR;
#undef PG8_RR
#undef PG8_SA
#undef PG8_SB
#undef PG8_STAGE
#undef PG8_LDA
#undef PG8_LDB
#undef PG8_MMA
#undef PG8_WAIT_V
#undef PG8_WAIT_L
#undef PG8_BAR
#undef PG8_SCHED
}
}
struct XMap { float* lat; float* ctx; };
__device__ __forceinline__ float* xrow(const XMap& X, int m) { const int b = m / TB, t = m - b * TB; return t < SEQ ? X.lat + ((size_t)b * SEQ + t) * DM : X.ctx + ((size_t)b * NCTX + (t - SEQ)) * DM; }
__device__ __forceinline__ int modrow(int m) { const int b = m / TB, t = m - b * TB; return t < SEQ ? b : NB; }

struct SchedPlain {
    pg8::GridOrder O; const char* A; const char* Bt; size_t tstep; bool lat_only;
    __device__ void init(const bf16_t* A_, const bf16_t* Bt_, int nM, int nN, int K, int G, int c, bool lat_only_ = false) { lat_only = lat_only_; O.init(lat_only ? nM - nM / 17 : nM, nN, G, c); A = (const char*)A_; Bt = (const char*)Bt_; tstep = (size_t)256 * K * 2; }
    __device__ __forceinline__ bool next(int i, pg8::Unit& u) const { int pm, pn; if (!O.tile(i, pm, pn)) return false; if (lat_only) pm += pm >> 4; u.pm = pm; u.pn = pn; u.a = A + (size_t)pm * tstep; u.b = Bt + (size_t)pn * tstep; u.aux = 0; return true; }
    __device__ __forceinline__ unsigned row_off(const pg8::Unit&, int) const { return 0u; }
};
struct MoeInfo { const LAS int* p; };
__device__ __forceinline__ void moe_info_build(LAS int* p, const unsigned* cw) {
    int s = 0;
    for (int e = 0; e < NEXP; ++e) { const int c = (int)__hip_atomic_load(cw + e * 64, RLX_AGENT); p[e] = c; p[8 + e] = s; s += (c + 255) >> 8; }
    p[16] = s;
}
__device__ __forceinline__ int moe_expert_of(const MoeInfo& I, int blk) { int e = 0;
#pragma unroll
    for (int j = 1; j < NEXP; ++j) e += (blk >= I.p[8 + j]) ? 1 : 0;
    return e; }
struct SchedMoeUp {
    MoeInfo I; int nN, G, c; const char* A; const char* W; const int* tok; size_t wstride, tstep;
    __device__ __forceinline__ bool next(int i, pg8::Unit& u) const {
        const int nblk = I.p[16]; const long total = (long)nblk * nN;
        long L;
        if (G % 8 == 0) { const int per_x = G / 8; L = ((long)i * 8 + (c & 7)) * per_x + (c >> 3); } else L = (long)i * G + c;
        if (L >= total) return false;
        const int tsz = 4 * nN; const int t4 = (int)(L / tsz), q = (int)(L % tsz); const int b0 = t4 * 4, rb = (nblk - b0) < 4 ? (nblk - b0) : 4;
        const int blk = b0 + q % rb, pn = q / rb;
        const int e = moe_expert_of(I, blk);
        u.pm = blk; u.pn = pn; u.a = A; u.b = W + (size_t)e * wstride + (size_t)pn * tstep; u.aux = e * MT + (blk - I.p[8 + e]) * 256; return true;
    }
    __device__ __forceinline__ unsigned row_off(const pg8::Unit& u, int r) const {
        const int e = u.aux / MT, j0 = u.aux - e * MT; const int valid = I.p[e] - j0;
        int row = MT;
        if (r < valid) row = tok[u.aux + r] & 0x7fffffff;
        return (unsigned)row * (unsigned)(DM * 2);
    }
};
struct SchedMoeDown {
    MoeInfo I; int nN, G, c; const char* A; const char* W; size_t wstride, tstepA, tstepB;
    __device__ __forceinline__ bool next(int i, pg8::Unit& u) const {
        const long L = (long)i * G + c; const int nblk = I.p[16]; if (L >= (long)nblk * nN) return false;
        const int per = 8 * nN; const int g = (int)(L / per), r = (int)(L % per); const int g0 = g * 8, gsz = (nblk - g0) < 8 ? (nblk - g0) : 8;
        const int blk = g0 + r % gsz, pn = r / gsz;
        const int e = moe_expert_of(I, blk);
        u.pm = blk; u.pn = pn; u.a = A + (size_t)blk * tstepA; u.b = W + (size_t)e * wstride + (size_t)pn * tstepB; u.aux = e * MT + (blk - I.p[8 + e]) * 256; return true;
    }
    __device__ __forceinline__ unsigned row_off(const pg8::Unit&, int) const { return 0u; }
};

typedef f32x4 acc_t[2][2][4][2];

struct EpiInProj {
    static constexpr bool PERM = true;
    bf16_t* UB; bf16_t* RB;
    __device__ __forceinline__ void operator()(const acc_t& acc, const pg8::Unit& u, int wr, int wc, int fr, int fq) const {
        const int row0 = u.pm * 256 + wr * 64 + fr;
        if (u.pn < 10) {
            const int col0 = u.pn * 256 + wc * 32 + 8 * fq;
#pragma unroll
            for (int ai = 0; ai < 2; ++ai)
#pragma unroll
                for (int m = 0; m < 4; ++m) { bf16_t* rowp = UB + (size_t)(row0 + ai * 128 + m * 16) * UBW + col0;
#pragma unroll
                    for (int bj = 0; bj < 2; ++bj) { const f32x4 v0 = acc[ai][bj][m][0], v1 = acc[ai][bj][m][1];
                        u32x4 w; w.x = cvt_pk_bf16(v0[0], v0[1]); w.y = cvt_pk_bf16(v0[2], v0[3]); w.z = cvt_pk_bf16(v1[0], v1[1]); w.w = cvt_pk_bf16(v1[2], v1[3]);
                        *(u32x4*)(rowp + bj * 128) = w; } }
        } else {
            const int ch0 = (u.pn - 10) * 64 + wc * 16 + fq * 4;
#pragma unroll
            for (int ai = 0; ai < 2; ++ai)
#pragma unroll
                for (int m = 0; m < 4; ++m) { bf16_t* rowp = RB + (size_t)(row0 + ai * 128 + m * 16) * 4096 + ch0;
                    f32x4 e[4];
#pragma unroll
                    for (int i = 0; i < 4; ++i) { const f32x4 v = acc[ai][i >> 1][m][i & 1];
#pragma unroll
                        for (int j = 0; j < 4; ++j) { const float x = fminf(fmaxf(v[j], -30.f), 30.f); e[i][j] = __builtin_amdgcn_exp2f(-x * LOG2E); } }
#pragma unroll
                    for (int i = 0; i < 4; ++i) { f32x4 r;
#pragma unroll
                        for (int j = 0; j < 4; ++j) r[j] = (i < 3) ? (1.0f + e[i + 1][j]) * __builtin_amdgcn_rcpf(1.0f + e[i][j]) : __builtin_amdgcn_rcpf(1.0f + e[3][j]);
                        u32x2 w; w.x = cvt_pk_bf16(r[0], r[1]); w.y = cvt_pk_bf16(r[2], r[3]);
                        *(u32x2*)(rowp + i * 1024) = w; } }
        }
    }
};
struct EpiMerge {
    static constexpr bool PERM = true;
    const bf16_t* RB; bf16_t* T;
    __device__ __forceinline__ void scale(acc_t& acc, const pg8::Unit& u, int seg, int wr, int wc, int fr, int fq) const {
        asm volatile("" : "+v"(fr), "+v"(fq));
        const int row0 = u.pm * 256 + wr * 64 + fr, ch0 = u.pn * 256 + wc * 64 + fq * 16;
#pragma unroll
        for (int ai = 0; ai < 2; ++ai) { u32x4 q[4][2];
#pragma unroll
            for (int m = 0; m < 4; ++m) { const bf16_t* rp = RB + (size_t)(row0 + ai * 128 + m * 16) * 4096 + seg * 1024 + ch0;
                q[m][0] = *(const u32x4*)rp; q[m][1] = *(const u32x4*)(rp + 8); }
#pragma unroll
            for (int m = 0; m < 4; ++m)
#pragma unroll
                for (int bj = 0; bj < 2; ++bj) { const u32x4 q0 = q[m][bj];
                    acc[ai][bj][m][0] *= (f32x4){bf_lo(q0.x), bf_hi(q0.x), bf_lo(q0.y), bf_hi(q0.y)};
                    acc[ai][bj][m][1] *= (f32x4){bf_lo(q0.z), bf_hi(q0.z), bf_lo(q0.w), bf_hi(q0.w)}; }
            asm volatile("" ::: "memory"); }
    }
    __device__ __forceinline__ void hook(acc_t& acc, const pg8::Unit& u, int seg, int wr, int wc, int fr, int fq) const {
        scale(acc, u, seg, wr, wc, fr, fq);
    }
    __device__ __forceinline__ void operator()(acc_t& acc, const pg8::Unit& u, int wr, int wc, int fr, int fq) const {
        scale(acc, u, 3, wr, wc, fr, fq);
        const int row0 = u.pm * 256 + wr * 64 + fr, ch0 = u.pn * 256 + wc * 64 + fq * 16;
#pragma unroll
        for (int ai = 0; ai < 2; ++ai)
#pragma unroll
            for (int m = 0; m < 4; ++m) { bf16_t* rowp = T + (size_t)(row0 + ai * 128 + m * 16) * DM + ch0;
#pragma unroll
                for (int bj = 0; bj < 2; ++bj) { const f32x4 v0 = acc[ai][bj][m][0], v1 = acc[ai][bj][m][1];
                    u32x4 w; w.x = cvt_pk_bf16(v0[0], v0[1]); w.y = cvt_pk_bf16(v0[2], v0[3]); w.z = cvt_pk_bf16(v1[0], v1[1]); w.w = cvt_pk_bf16(v1[2], v1[3]);
                    *(u32x4*)(rowp + bj * 8) = w; } }
    }
};
struct EpiResid {
    static constexpr bool PERM = false;
    XMap X; const float* mod;
    bool skip_ctx;
    const float* rd_lat; const float* rd_ctx;
    __device__ __forceinline__ void operator()(const acc_t& acc, const pg8::Unit& u, int wr, int wc, int fr, int fq) const {
        const int m0 = u.pm * 256; const int b = m0 / TB, t0 = m0 - b * TB; const bool isctx = t0 >= SEQ;
        if (isctx && skip_ctx) return;
        float* base = isctx ? X.ctx + ((size_t)b * NCTX + (t0 - SEQ)) * DM : X.lat + ((size_t)b * SEQ + t0) * DM;
        const float* rbase = isctx ? rd_ctx + ((size_t)b * NCTX + (t0 - SEQ)) * DM : rd_lat + ((size_t)b * SEQ + t0) * DM;
        const float* mv = mod + (size_t)(isctx ? NB : b) * 6144;
        const int rl0 = wr * 64 + fr, col0 = u.pn * 256 + wc * 32 + 4 * fq;
        f32x4 mq[2][2];
#pragma unroll
        for (int bj = 0; bj < 2; ++bj)
#pragma unroll
            for (int n = 0; n < 2; ++n) mq[bj][n] = *(const f32x4*)(mv + col0 + bj * 128 + n * 16);
#pragma unroll
        for (int ai = 0; ai < 2; ++ai)
#pragma unroll
            for (int m2 = 0; m2 < 4; m2 += 2) { f32x4 xv[2][2][2];
#pragma unroll
                for (int mm = 0; mm < 2; ++mm) { const float* rowp = rbase + (size_t)(rl0 + ai * 128 + (m2 + mm) * 16) * DM + col0;
#pragma unroll
                    for (int bj = 0; bj < 2; ++bj)
#pragma unroll
                        for (int n = 0; n < 2; ++n) xv[mm][bj][n] = *(const f32x4*)(rowp + bj * 128 + n * 16); }
#pragma unroll
                for (int mm = 0; mm < 2; ++mm) { float* rowp = base + (size_t)(rl0 + ai * 128 + (m2 + mm) * 16) * DM + col0;
#pragma unroll
                    for (int bj = 0; bj < 2; ++bj)
#pragma unroll
                        for (int n = 0; n < 2; ++n) *(f32x4*)(rowp + bj * 128 + n * 16) = xv[mm][bj][n] + mq[bj][n] * acc[ai][bj][m2 + mm][n]; }
                asm volatile("" ::: "memory"); }
    }
};
struct EpiSwiGLU {
    static constexpr bool PERM = true;
    bf16_t* H; int ldh;
    __device__ __forceinline__ void operator()(const acc_t& acc, const pg8::Unit& u, int wr, int wc, int fr, int fq) const {
        const int row0 = u.pm * 256 + wr * 64 + fr, col0 = u.pn * 128 + wc * 32 + 8 * fq;
#pragma unroll
        for (int ai = 0; ai < 2; ++ai)
#pragma unroll
            for (int m = 0; m < 4; ++m) { bf16_t* rowp = H + (size_t)(row0 + ai * 128 + m * 16) * ldh + col0; float o[8];
#pragma unroll
                for (int n = 0; n < 2; ++n)
#pragma unroll
                    for (int j = 0; j < 4; ++j) { const float a = acc[ai][0][m][n][j], g = acc[ai][1][m][n][j]; o[n * 4 + j] = a * fast_sigmoid(a) * g; }
                u32x4 w; w.x = cvt_pk_bf16(o[0], o[1]); w.y = cvt_pk_bf16(o[2], o[3]); w.z = cvt_pk_bf16(o[4], o[5]); w.w = cvt_pk_bf16(o[6], o[7]);
                *(u32x4*)rowp = w; }
    }
};
struct EpiMoeDown {
    static constexpr bool PERM = true;
    const MoeInfo* I; const int* tok; const float* gw; bf16_t* slot;
    __device__ __forceinline__ void operator()(const acc_t& acc, const pg8::Unit& u, int wr, int wc, int fr, int fq) const {
        const int e = u.aux / MT, j0 = u.aux - e * MT; const int valid = I->p[e] - j0;
        const int rl0 = wr * 64 + fr, col0 = u.pn * 256 + wc * 32 + 8 * fq;
#pragma unroll
        for (int ai = 0; ai < 2; ++ai)
#pragma unroll
            for (int m = 0; m < 4; ++m) { const int r = rl0 + ai * 128 + m * 16;
                if (r < valid) { const int tk = tok[u.aux + r]; const float g = gw[u.aux + r]; const int token = tk & 0x7fffffff, k = (tk >> 31) & 1;
                    bf16_t* rowp = slot + ((size_t)token * 2 + k) * DM + col0;
#pragma unroll
                    for (int bj = 0; bj < 2; ++bj) { const f32x4 v0 = acc[ai][bj][m][0] * g, v1 = acc[ai][bj][m][1] * g;
                        u32x4 w; w.x = cvt_pk_bf16(v0[0], v0[1]); w.y = cvt_pk_bf16(v0[2], v0[3]); w.z = cvt_pk_bf16(v1[0], v1[1]); w.w = cvt_pk_bf16(v1[2], v1[3]);
                        *(u32x4*)(rowp + bj * 128) = w; } } }
    }
};
struct Frame {
    LAS unsigned char* lds;
    unsigned* ctl;
    int tid, lane, wave, G, bid, wv;
    const float* const* in;
    unsigned char* ws;
    float* out;
};
enum { I_X = 0, I_C, I_CTX, I_CCTX, I_WADA, I_BADA, I_NMIX, I_NFFN, I_WIN, I_HSW, I_HSB, I_HW1, I_HB1, I_HW2, I_HB2, I_HW3, I_HB3, I_HW4, I_HFREQ, I_HBIAS,
       I_CFW, I_CFB, I_CFG, I_CFLB, I_GQN, I_GKN, I_DQN, I_DKN, I_LQ1, I_LK1, I_LQ2, I_LK2, I_SUBLN, I_WBR, I_WOUT, I_FW1, I_FW3, I_FW2, I_ROUTER, I_MW1, I_MW3, I_MW2 };

__device__ __forceinline__ void p0_mods(Frame& F) {
    F.tid = opaque_tid(F.wv); F.lane = F.tid & 63; F.wave = __builtin_amdgcn_readfirstlane(F.tid >> 6);
    LAS float* s = (LAS float*)F.lds;
    LAS float* red = (LAS float*)(F.lds + 40960);
    const float* c = INP(F, I_C); const float* cc = INP(F, I_CCTX);
    for (int i = F.tid; i < 9 * 1024; i += NTHR) { const float v = i < 8192 ? c[i] : cc[i - 8192]; s[i] = v * fast_sigmoid(v); }
    __syncthreads();
    float* MODS = (float*)(F.ws + WS_MODS);
    for (int u = F.bid; u < 4 * 96; u += F.G) {
        const int l = u / 96, n0 = (u % 96) * 64;
        const float* w = INP(F, I_WADA) + (size_t)l * DM * 6144 + n0 + F.lane;
        float acc[9];
#pragma unroll
        for (int r = 0; r < 9; ++r) acc[r] = 0.f;
        const int k0 = F.wave * 128;
#pragma unroll 16
        for (int k = k0; k < k0 + 128; ++k) { const float wv = w[(size_t)k * 6144];
#pragma unroll
            for (int r = 0; r < 9; ++r) acc[r] += s[r * 1024 + k] * wv; }
#pragma unroll
        for (int r = 0; r < 9; ++r) red[(F.wave * 9 + r) * 64 + F.lane] = acc[r];
        __syncthreads();
        for (int i = F.tid; i < 9 * 64; i += NTHR) { const int r = i >> 6, ln = i & 63; float t = INP(F, I_BADA)[l * 6144 + n0 + ln];
#pragma unroll
            for (int w8 = 0; w8 < 8; ++w8) t += red[(w8 * 9 + r) * 64 + ln];
            const int sl6 = n0 >> 10, cl = (n0 & 1023) + ln;
            if (sl6 == 1) t = INP(F, I_NMIX)[l * DM + cl] * (1.0f + t);
            if (sl6 == 4) t = INP(F, I_NFFN)[l * DM + cl] * (1.0f + t);
            MODS[((size_t)l * 9 + r) * 6144 + n0 + ln] = t; }
        __syncthreads();
    }
}
__device__ __forceinline__ void p0_a3(Frame& F) {
    F.tid = opaque_tid(F.wv); F.lane = F.tid & 63; F.wave = __builtin_amdgcn_readfirstlane(F.tid >> 6);
    const int gw = F.bid * NWAVES + F.wave, NGW = F.G * NWAVES;
    const int l = gw & 3; const int j = F.lane;
    float w1r[33], w2r[64], w3r[64];
    const float* w1 = INP(F, I_HW1) + l * 33 * 64; const float* w2 = INP(F, I_HW2) + l * 4096; const float* w3 = INP(F, I_HW3) + l * 4096;
#pragma unroll
    for (int i = 0; i < 33; ++i) w1r[i] = w1[i * 64 + j];
#pragma unroll
    for (int i = 0; i < 64; ++i) { w2r[i] = w2[i * 64 + j]; w3r[i] = w3[i * 64 + j]; }
    const float b1 = INP(F, I_HB1)[l * 64 + j], b2 = INP(F, I_HB2)[l * 64 + j], b3 = INP(F, I_HB3)[l * 64 + j], fq = INP(F, I_HFREQ)[l * 64 + j];
    float* A3 = (float*)(F.ws + WS_A3) + (size_t)l * TB * 64;
    for (int i = gw >> 2; i < TB; i += NGW >> 2) {
        const int L = i < SEQ ? SEQ : NCTX, pos = i < SEQ ? i : i - SEQ;
        float z = 0.f;
        { const float t = (float)pos / (float)(L - 1); const float wpos = 6.283185307179586f * (float)pos / (float)L;
          const int bnd = (j >= 17) ? j - 17 : j - 1; const float fr = 1e-4f + (float)bnd * ((15.0f - 1e-4f) / 15.0f); const float ang = fr * wpos;
          z = (j == 0) ? t : (j < 17 ? cosf(ang) : (j < 33 ? -sinf(ang) : 0.f)); }
        float p = b1;
#pragma unroll
        for (int k = 0; k < 33; ++k) p += __builtin_bit_cast(float, __builtin_amdgcn_readlane(__builtin_bit_cast(int, z), k)) * w1r[k];
        float a = sinf(fq * p);
        p = b2;
#pragma unroll
        for (int k = 0; k < 64; ++k) p += __builtin_bit_cast(float, __builtin_amdgcn_readlane(__builtin_bit_cast(int, a), k)) * w2r[k];
        a = sinf(fq * p);
        p = b3;
#pragma unroll
        for (int k = 0; k < 64; ++k) p += __builtin_bit_cast(float, __builtin_amdgcn_readlane(__builtin_bit_cast(int, a), k)) * w3r[k];
        a = sinf(fq * p);
        A3[(size_t)i * 64 + j] = a;
    }
}
__device__ __forceinline__ void p0_zero_rows(Frame& F) {
    u32x4* z = (u32x4*)(F.ws + WS_HB + (size_t)MT * DM * 2);
    for (int i = F.bid * NTHR + F.tid; i < 256 * DM * 2 / 16; i += F.G * NTHR) z[i] = (u32x4){0u, 0u, 0u, 0u};
}

template <class Map>
__device__ __forceinline__ void transpose_item(const float* W, int ldw, int k0, int n0, bf16_t* WT, int ldwt, int kdst, const Map& map, LAS float* scr, int lane) {
    asm volatile("" : "+s"(ldw));
    const float* src = W + (size_t)(k0 + (lane >> 5)) * ldw + n0 + (lane & 31);
    float v[32];
#pragma unroll
    for (int i = 0; i < 32; ++i) v[i] = src[(size_t)(2 * i) * ldw];
#pragma unroll
    for (int i = 0; i < 32; ++i) scr[(2 * i + (lane >> 5)) * 33 + (lane & 31)] = v[i];
    LDS_WAIT(); asm volatile("" ::: "memory");
    const int c = lane & 7;
#pragma unroll
    for (int j = 0; j < 4; ++j) { const int n = (lane >> 3) + 8 * j; const LAS float* s = scr + (8 * c) * 33 + n;
        u32x4 o; o.x = pk2(s[0 * 33], s[1 * 33]); o.y = pk2(s[2 * 33], s[3 * 33]); o.z = pk2(s[4 * 33], s[5 * 33]); o.w = pk2(s[6 * 33], s[7 * 33]);
        *(GAS u32x4*)(WT + (size_t)map(n0 + n) * ldwt + kdst + k0 + 8 * c) = o; }
    LDS_WAIT(); asm volatile("" ::: "memory");
}
struct MapId { __device__ __forceinline__ int operator()(int n) const { return n; } };
struct MapWin {
    __device__ __forceinline__ int operator()(int n) const { if (n < OFF_GATE) return n; const int g = n - OFF_GATE, i = g >> 10, ch = g & 1023;
        return OFF_GATE + 256 * (ch >> 6) + 128 * (i >> 1) + 32 * ((ch >> 4) & 3) + 8 * ((ch >> 2) & 3) + 4 * (i & 1) + (ch & 3); } };
struct MapMerge {
    __device__ __forceinline__ int operator()(int ch) const { return (ch & ~255) + 128 * ((ch >> 3) & 1) + 32 * ((ch >> 6) & 3) + 8 * ((ch >> 4) & 3) + (ch & 7); } };
struct MapGlu {
    int half; __device__ __forceinline__ int operator()(int j) const { return 256 * (j >> 7) + 128 * half + (j & 127); } };

constexpr int CV_WIN = 16 * (D_IN / 32), CV_BR = 4 * 4 * 32, CV_OUT = 16 * 32, CV_SMALL = CV_WIN + CV_BR + CV_OUT;
constexpr int CV_F13 = 16 * (DFF / 32), CV_F2 = (DFF / 64) * 32, CV_DENSE = 2 * CV_F13 + CV_F2;
constexpr int CV_M13 = 16 * (DFFE / 32), CV_M2 = (DFFE / 64) * 32, CV_MOE1 = 2 * CV_M13 + CV_M2, CV_MOE = NEXP * CV_MOE1;
__device__ __forceinline__ int cv_ffn_total(int l) { return (l & 1) ? CV_MOE : CV_DENSE; }
__device__ __forceinline__ void convert_small_item(Frame& F, int l, int r, LAS float* scr) {
    if (r < CV_WIN) { const int nb = D_IN / 32; transpose_item(INP(F, I_WIN) + (size_t)l * DM * D_IN, D_IN, 64 * (r / nb), 32 * (r % nb), (bf16_t*)(F.ws + WS_WIN), DM, 0, MapWin{}, scr, F.lane); return; } r -= CV_WIN;
    if (r < CV_BR) { const int i = r / 128, q = r % 128; transpose_item(INP(F, I_WBR) + ((size_t)l * 4 + i) * 256 * DM, DM, 64 * (q / 32), 32 * (q % 32), (bf16_t*)(F.ws + WS_WBR), DM, 256 * i, MapMerge{}, scr, F.lane); return; } r -= CV_BR;
    transpose_item(INP(F, I_WOUT) + (size_t)l * DM * DM, DM, 64 * (r / 32), 32 * (r % 32), (bf16_t*)(F.ws + WS_WOUT), DM, 0, MapId{}, scr, F.lane);
}
__device__ __forceinline__ void convert_ffn_item(Frame& F, int l, int r, LAS float* scr) {
    const bool moe = l & 1; const int li = l >> 1;
    if (!moe) {
        if (r < 2 * CV_F13) { const int half = r / CV_F13, q = r % CV_F13, nb = DFF / 32; transpose_item(INP(F, half ? I_FW3 : I_FW1) + (size_t)li * DM * DFF, DFF, 64 * (q / nb), 32 * (q % nb), (bf16_t*)(F.ws + WS_WF1), DM, 0, MapGlu{half}, scr, F.lane); return; } r -= 2 * CV_F13;
        transpose_item(INP(F, I_FW2) + (size_t)li * DFF * DM, DM, 64 * (r / 32), 32 * (r % 32), (bf16_t*)(F.ws + WS_WF2), DFF, 0, MapId{}, scr, F.lane);
    } else {
        const int e = r / CV_MOE1; r %= CV_MOE1;
        if (r < 2 * CV_M13) { const int half = r / CV_M13, q = r % CV_M13, nb = DFFE / 32; transpose_item(INP(F, half ? I_MW3 : I_MW1) + ((size_t)li * NEXP + e) * DM * DFFE, DFFE, 64 * (q / nb), 32 * (q % nb), (bf16_t*)(F.ws + WS_WM13) + (size_t)e * 2 * DFFE * DM, DM, 0, MapGlu{half}, scr, F.lane); return; } r -= 2 * CV_M13;
        transpose_item(INP(F, I_MW2) + ((size_t)li * NEXP + e) * DFFE * DM, DM, 64 * (r / 32), 32 * (r % 32), (bf16_t*)(F.ws + WS_WM2) + (size_t)e * DM * DFFE, DFFE, 0, MapId{}, scr, F.lane);
    }
}
__device__ __forceinline__ void convert_ffn_queue(Frame& F, int l, int quota) {
    F.tid = opaque_tid(F.wv); F.lane = F.tid & 63; F.wave = __builtin_amdgcn_readfirstlane(F.tid >> 6);
    LAS float* scr = (LAS float*)(F.lds + 65536 + F.wave * 8704);
    unsigned* q = F.ctl + CW_Q + l * 64; const int total = cv_ffn_total(l);
    constexpr int BATCH = 8;
    for (int n = 0; n < quota; ++n) {
        int idx = 0; if (F.lane == 0) idx = (int)__hip_atomic_fetch_add(q, (unsigned)BATCH, RLX_AGENT);
        idx = __builtin_amdgcn_readfirstlane(idx);
        if (idx >= total) break;
        const int end = (idx + BATCH < total) ? idx + BATCH : total;
        for (int it = idx; it < end; ++it) convert_ffn_item(F, l, it, scr);
    }
}
__device__ __forceinline__ void convert_weights(Frame& F, int l) {
    F.tid = opaque_tid(F.wv); F.lane = F.tid & 63; F.wave = __builtin_amdgcn_readfirstlane(F.tid >> 6);
    LAS float* scr = (LAS float*)(F.lds + 65536 + F.wave * 8704);
    const int gw = F.bid * NWAVES + F.wave, NGW = F.G * NWAVES;
    for (int it = gw; it < CV_SMALL; it += NGW) convert_small_item(F, l, it, scr);
    convert_ffn_queue(F, l, 1 << 30);
}

#define FP(i) ((i) + ((i) >> 4))
__device__ __forceinline__ f32x2 cmul(f32x2 a, f32x2 b) { return (f32x2){a.x * b.x - a.y * b.y, a.x * b.y + a.y * b.x}; }
__device__ __forceinline__ f32x2 twid(float rev) { return (f32x2){__builtin_amdgcn_cosf(rev), __builtin_amdgcn_sinf(rev)}; }
template <int K> __device__ __forceinline__ void bfly(f32x2& a, f32x2& b) {
    constexpr float C1 = 0.9238795325112867f, S1 = 0.3826834323650898f, C2 = 0.7071067811865476f;
    const f32x2 s = a + b, d = a - b; a = s;
    if constexpr (K == 0) b = d;
    else if constexpr (K == 1) b = (f32x2){d.x * C1 + d.y * S1, d.y * C1 - d.x * S1};
    else if constexpr (K == 2) b = (f32x2){(d.x + d.y) * C2, (d.y - d.x) * C2};
    else if constexpr (K == 3) b = (f32x2){d.x * S1 + d.y * C1, d.y * S1 - d.x * C1};
    else if constexpr (K == 4) b = (f32x2){d.y, -d.x};
    else if constexpr (K == 5) b = (f32x2){d.y * C1 - d.x * S1, -d.x * C1 - d.y * S1};
    else if constexpr (K == 6) b = (f32x2){(d.y - d.x) * C2, -(d.x + d.y) * C2};
    else b = (f32x2){d.y * S1 - d.x * C1, -d.x * S1 - d.y * C1};
}
__device__ __forceinline__ void fft16(f32x2 (&v)[16]) {
    bfly<0>(v[0], v[8]); bfly<1>(v[1], v[9]); bfly<2>(v[2], v[10]); bfly<3>(v[3], v[11]); bfly<4>(v[4], v[12]); bfly<5>(v[5], v[13]); bfly<6>(v[6], v[14]); bfly<7>(v[7], v[15]);
    bfly<0>(v[0], v[4]); bfly<2>(v[1], v[5]); bfly<4>(v[2], v[6]); bfly<6>(v[3], v[7]); bfly<0>(v[8], v[12]); bfly<2>(v[9], v[13]); bfly<4>(v[10], v[14]); bfly<6>(v[11], v[15]);
    bfly<0>(v[0], v[2]); bfly<4>(v[1], v[3]); bfly<0>(v[4], v[6]); bfly<4>(v[5], v[7]); bfly<0>(v[8], v[10]); bfly<4>(v[9], v[11]); bfly<0>(v[12], v[14]); bfly<4>(v[13], v[15]);
    bfly<0>(v[0], v[1]); bfly<0>(v[2], v[3]); bfly<0>(v[4], v[5]); bfly<0>(v[6], v[7]); bfly<0>(v[8], v[9]); bfly<0>(v[10], v[11]); bfly<0>(v[12], v[13]); bfly<0>(v[14], v[15]);
    f32x2 t;
    t = v[1]; v[1] = v[8]; v[8] = t;   t = v[2]; v[2] = v[4]; v[4] = t;   t = v[3]; v[3] = v[12]; v[12] = t;
    t = v[5]; v[5] = v[10]; v[10] = t; t = v[7]; v[7] = v[14]; v[14] = t; t = v[11]; v[11] = v[13]; v[13] = t;
}
__device__ __forceinline__ void fft8192(LAS f32x2* buf, int tid) {
    constexpr int N = 8192;
#pragma unroll 1
    for (int pass = 0; pass < 3; ++pass) {
        const int Ns = pass == 0 ? 1 : (pass == 1 ? 16 : 256);
        const int j = tid;
        const int jm = j & (Ns - 1);
        const f32x2 w1 = twid(-(float)jm / (float)(Ns * 16));
        f32x2 v[16];
#pragma unroll
        for (int r = 0; r < 16; ++r) v[r] = buf[FP(j + r * (N / 16))];
        f32x2 w = w1;
#pragma unroll
        for (int r = 1; r < 16; ++r) { v[r] = cmul(v[r], w); w = cmul(w, w1); }
        fft16(v);
        __syncthreads();
        const int idx = ((j - jm) << 4) + jm;
#pragma unroll
        for (int r = 0; r < 16; ++r) buf[FP(idx + r * Ns)] = v[r];
        __syncthreads();
    }
    {
        f32x2 a[8], b[8];
#pragma unroll
        for (int q = 0; q < 8; ++q) { const int j = tid + q * NTHR; a[q] = buf[FP(j)]; b[q] = cmul(buf[FP(j + 4096)], twid(-(float)j / 8192.0f)); }
        __syncthreads();
#pragma unroll
        for (int q = 0; q < 8; ++q) { const int j = tid + q * NTHR; buf[FP(j)] = a[q] + b[q]; buf[FP(j + 4096)] = a[q] - b[q]; }
        __syncthreads();
    }
}

template <bool TW = true> __device__ __forceinline__ void fft_pass16(LAS f32x2* buf, int tid, int Ns) {
    asm volatile("" : "+v"(tid), "+s"(Ns));
    const int j = tid, jm = j & (Ns - 1);
    const f32x2 w1 = twid(-(float)jm / (float)(Ns * 16));
    f32x2 v[16];
#pragma unroll
    for (int r = 0; r < 16; ++r) v[r] = buf[FP(j + r * 512)];
    if constexpr (TW) { f32x2 w = w1;
#pragma unroll
        for (int r = 1; r < 16; ++r) { v[r] = cmul(v[r], w); w = cmul(w, w1); } }
    fft16(v);
    __syncthreads();
    const int idx = ((j - jm) << 4) + jm;
#pragma unroll
    for (int r = 0; r < 16; ++r) buf[FP(idx + r * Ns)] = v[r];
    __syncthreads();
}
__device__ __forceinline__ void fft_fwd_regs_mulK(LAS f32x2* buf, int tid, const f32x2 (&z)[8], const f32x2* __restrict__ KF) {
    asm volatile("" : "+v"(tid));
    { f32x2 v[16];
#pragma unroll
      for (int r = 0; r < 8; ++r) { v[r] = z[r]; v[r + 8] = (f32x2){0.f, 0.f}; }
      fft16(v);
#pragma unroll
      for (int r = 0; r < 16; ++r) buf[FP(tid * 16 + r)] = v[r];
      __syncthreads(); }
    fft_pass16(buf, tid, 16);
    fft_pass16(buf, tid, 256);
    asm volatile("" : "+v"(tid));
    { f32x2 a[8], b[8], k0[8], k1[8];
#pragma unroll
      for (int q = 0; q < 8; ++q) { const int j = tid + q * NTHR; k0[q] = KF[j]; k1[q] = KF[j + 4096]; }
#pragma unroll
      for (int q = 0; q < 8; ++q) { const int j = tid + q * NTHR; a[q] = buf[FP(j)]; b[q] = cmul(buf[FP(j + 4096)], twid(-(float)j / 8192.0f)); }
      __syncthreads();
#pragma unroll
      for (int q = 0; q < 8; ++q) { const int j = tid + q * NTHR; const f32x2 y0 = cmul(a[q] + b[q], k0[q]), y1 = cmul(a[q] - b[q], k1[q]);
          buf[FP(j)] = (f32x2){y0.x, -y0.y}; buf[FP(j + 4096)] = (f32x2){y1.x, -y1.y}; }
      __syncthreads(); }
}
__device__ __forceinline__ void fft_to_regs_lo(LAS f32x2* buf, int tid, f32x2 (&out)[8]) {
    fft_pass16<false>(buf, tid, 1);
    fft_pass16(buf, tid, 16);
    fft_pass16(buf, tid, 256);
    asm volatile("" : "+v"(tid));
#pragma unroll
    for (int q = 0; q < 8; ++q) { const int j = tid + q * NTHR; out[q] = buf[FP(j)] + cmul(buf[FP(j + 4096)], twid(-(float)j / 8192.0f)); }
}

template <bool TW = true> __device__ __forceinline__ void fft_pass16_x2(LAS f32x2* bufA, LAS f32x2* bufB, int tid, int Ns) {
    asm volatile("" : "+v"(tid), "+s"(Ns));
    const int j = tid, jm = j & (Ns - 1);
    const f32x2 w1 = twid(-(float)jm / (float)(Ns * 16));
    f32x2 va[16], vb[16];
#pragma unroll
    for (int r = 0; r < 16; ++r) { va[r] = bufA[FP(j + r * 512)]; vb[r] = bufB[FP(j + r * 512)]; }
    if constexpr (TW) { f32x2 w = w1;
#pragma unroll
        for (int r = 1; r < 16; ++r) { va[r] = cmul(va[r], w); vb[r] = cmul(vb[r], w); w = cmul(w, w1); } }
    fft16(va); fft16(vb);
    __syncthreads();
    const int idx = ((j - jm) << 4) + jm;
#pragma unroll
    for (int r = 0; r < 16; ++r) { bufA[FP(idx + r * Ns)] = va[r]; bufB[FP(idx + r * Ns)] = vb[r]; }
    __syncthreads();
}
__device__ __forceinline__ void fft_fwd_regs_mulK_x2(LAS f32x2* bufA, LAS f32x2* bufB, int tid, const f32x2 (&za)[8], const f32x2 (&zb)[8], const f32x2* __restrict__ KF) {
    asm volatile("" : "+v"(tid));
    { f32x2 v[16];
#pragma unroll
      for (int r = 0; r < 8; ++r) { v[r] = za[r]; v[r + 8] = (f32x2){0.f, 0.f}; }
      fft16(v);
#pragma unroll
      for (int r = 0; r < 16; ++r) bufA[FP(tid * 16 + r)] = v[r];
#pragma unroll
      for (int r = 0; r < 8; ++r) { v[r] = zb[r]; v[r + 8] = (f32x2){0.f, 0.f}; }
      fft16(v);
#pragma unroll
      for (int r = 0; r < 16; ++r) bufB[FP(tid * 16 + r)] = v[r];
      __syncthreads(); }
    fft_pass16_x2(bufA, bufB, tid, 16);
    fft_pass16_x2(bufA, bufB, tid, 256);
    asm volatile("" : "+v"(tid));
#pragma unroll
    for (int hq = 0; hq < 2; ++hq) {
      f32x2 a[4], b[4], c[4], d[4], k0[4], k1[4];
#pragma unroll
      for (int q = 0; q < 4; ++q) { const int j = tid + (hq * 4 + q) * NTHR; k0[q] = KF[j]; k1[q] = KF[j + 4096]; }
#pragma unroll
      for (int q = 0; q < 4; ++q) { const int j = tid + (hq * 4 + q) * NTHR; const f32x2 tw = twid(-(float)j / 8192.0f);
          a[q] = bufA[FP(j)]; b[q] = cmul(bufA[FP(j + 4096)], tw); c[q] = bufB[FP(j)]; d[q] = cmul(bufB[FP(j + 4096)], tw); }
#pragma unroll
      for (int q = 0; q < 4; ++q) { const int j = tid + (hq * 4 + q) * NTHR;
          const f32x2 y0 = cmul(a[q] + b[q], k0[q]), y1 = cmul(a[q] - b[q], k1[q]), y2 = cmul(c[q] + d[q], k0[q]), y3 = cmul(c[q] - d[q], k1[q]);
          bufA[FP(j)] = (f32x2){y0.x, -y0.y}; bufA[FP(j + 4096)] = (f32x2){y1.x, -y1.y}; bufB[FP(j)] = (f32x2){y2.x, -y2.y}; bufB[FP(j + 4096)] = (f32x2){y3.x, -y3.y}; }
    }
    __syncthreads();
}
__device__ __forceinline__ void fft_to_regs_lo_x2(LAS f32x2* bufA, LAS f32x2* bufB, int tid, f32x2 (&oa)[8], f32x2 (&ob)[8]) {
    fft_pass16_x2<false>(bufA, bufB, tid, 1);
    fft_pass16_x2(bufA, bufB, tid, 16);
    fft_pass16_x2(bufA, bufB, tid, 256);
    asm volatile("" : "+v"(tid));
#pragma unroll
    for (int q = 0; q < 8; ++q) { const int j = tid + q * NTHR; const f32x2 tw = twid(-(float)j / 8192.0f);
        oa[q] = bufA[FP(j)] + cmul(bufA[FP(j + 4096)], tw); ob[q] = bufB[FP(j)] + cmul(bufB[FP(j + 4096)], tw); }
}

__device__ __forceinline__ float block_sum(LAS float* red, float v, int tid, int lane, int wave) {
    v = wave_sum(v);
    __syncthreads();
    if (lane == 0) red[wave] = v;
    __syncthreads();
    float s = 0.f;
#pragma unroll
    for (int w = 0; w < NWAVES; ++w) s += red[w];
    return s;
}
__device__ __forceinline__ void hyena_filter_unit(Frame& F, int l, int c) {
    F.tid = opaque_tid(F.wv); F.lane = F.tid & 63; F.wave = __builtin_amdgcn_readfirstlane(F.tid >> 6);
    LAS f32x2* buf = (LAS f32x2*)F.lds;
    LAS float* w4c = (LAS float*)(F.lds + 73728);
    LAS float* red = (LAS float*)(F.lds + 73728 + 1024);
    const float* w4 = INP(F, I_HW4) + (size_t)l * 64 * 1024;
    __syncthreads();
    if (F.tid < 256) { const int q = F.tid >> 6, j = F.tid & 63; w4c[q * 64 + j] = w4[j * 1024 + q * 256 + c]; }
    __syncthreads();
    const float lt = -4.605170185988091f;
    const float d0 = lt / 1.5f, d1 = lt / 0.3f;
    const float delta = fabsf(d0 + (float)c * ((d1 - d0) / 255.0f));
    const float* A3 = (const float*)(F.ws + WS_A3) + (size_t)l * TB * 64;
    float ss0 = 0.f, ss1 = 0.f;
#pragma unroll 1
    for (int t = F.tid; t < SEQ; t += NTHR) {
        const f32x4* ar = (const f32x4*)(A3 + (size_t)t * 64);
        float h[4] = {0.f, 0.f, 0.f, 0.f};
        LAS float* wq = w4c; asm volatile("" : "+v"(wq));
#pragma unroll 4
        for (int j4 = 0; j4 < 16; ++j4) { const f32x4 a = ar[j4];
#pragma unroll
            for (int q = 0; q < 4; ++q) { const f32x4 w = *(const LAS f32x4*)(wq + q * 64 + 4 * j4); h[q] += (a[0] * w[0] + a[1] * w[1]) + (a[2] * w[2] + a[3] * w[3]); } }
        const float win = __expf(-((float)t / (float)(SEQ - 1)) * delta);
        const float f0 = h[0] * win, f1 = h[1] * win, b0 = h[2] * win, b1 = h[3] * win;
        buf[FP(t)] = (f32x2){f0, f1}; ss0 += f0 * f0; ss1 += f1 * f1;
        if (t >= 1) { buf[FP(2 * SEQ - t)] = (f32x2){b0, b1}; ss0 += b0 * b0; ss1 += b1 * b1; }
    }
    if (F.tid == 0) { float z0 = 0.f; asm volatile("" : "+v"(z0)); buf[FP(SEQ)] = (f32x2){z0, z0}; }
    const float t0 = block_sum(red, ss0, F.tid, F.lane, F.wave);
    const float t1 = block_sum(red, ss1, F.tid, F.lane, F.wave);
    const float s0 = 1.0f / sqrtf(t0 + EPS), s1 = 1.0f / sqrtf(t1 + EPS);
#pragma unroll 2
    for (int i = F.tid; i < 8192; i += NTHR) { f32x2 v = buf[FP(i)]; v.x *= s0; v.y *= s1; buf[FP(i)] = v; }
    __syncthreads();
    fft8192(buf, F.tid);
    f32x2* KF0 = (f32x2*)(F.ws + WS_KF) + (size_t)c * 8192; f32x2* KF1 = KF0 + (size_t)256 * 8192;
    const float sc = 0.5f / 8192.0f;
#pragma unroll 2
    for (int f = F.tid; f < 8192; f += NTHR) { const f32x2 a = buf[FP(f)], bb = buf[FP((8192 - f) & 8191)]; const f32x2 b = (f32x2){bb.x, -bb.y};
        KF0[f] = (f32x2){(a.x + b.x) * sc, (a.y + b.y) * sc}; const float dr = a.x - b.x, di = a.y - b.y; KF1[f] = (f32x2){di * sc, -dr * sc}; }
    __syncthreads();
    float* KC = (float*)(F.ws + WS_KC);
    float v[4] = {0.f, 0.f, 0.f, 0.f};
    if (F.tid < NCTX) { const int t = F.tid; const f32x4* ar = (const f32x4*)(A3 + (size_t)(SEQ + t) * 64);
#pragma unroll 4
        for (int j4 = 0; j4 < 16; ++j4) { const f32x4 a = ar[j4];
#pragma unroll
            for (int q = 0; q < 4; ++q) { const f32x4 w = *(const LAS f32x4*)(w4c + q * 64 + 4 * j4); v[q] += (a[0] * w[0] + a[1] * w[1]) + (a[2] * w[2] + a[3] * w[3]); } }
        const float win = __expf(-((float)t / (float)(NCTX - 1)) * delta);
#pragma unroll
        for (int q = 0; q < 4; ++q) v[q] *= win; }
    const bool has_b = F.tid >= 1 && F.tid < NCTX;
    const float u0 = block_sum(red, v[0] * v[0] + (has_b ? v[2] * v[2] : 0.f), F.tid, F.lane, F.wave);
    const float u1 = block_sum(red, v[1] * v[1] + (has_b ? v[3] * v[3] : 0.f), F.tid, F.lane, F.wave);
    if (F.tid < NCTX) { const int t = F.tid; const float r0 = 1.0f / sqrtf(u0 + EPS), r1 = 1.0f / sqrtf(u1 + EPS);
        KC[((size_t)0 * 256 + c) * 512 + 255 + t] = v[0] * r0; KC[((size_t)1 * 256 + c) * 512 + 255 + t] = v[1] * r1;
        if (t >= 1) { KC[((size_t)0 * 256 + c) * 512 + 255 - t] = v[2] * r0; KC[((size_t)1 * 256 + c) * 512 + 255 - t] = v[3] * r1; } }
    __syncthreads();
}

__device__ __forceinline__ void load_xrow(Frame& F, int m, int mode, f32x4 (&v)[4]) {
    const int b = m / TB, t = m - b * TB; const bool isctx = t >= SEQ;
    const float* src = isctx ? (const float*)(F.ws + WS_XC) + ((size_t)b * NCTX + (t - SEQ)) * DM : F.out + ((size_t)b * SEQ + t) * DM;
    if (mode & 1) src = isctx ? INP(F, I_CTX) + ((size_t)b * NCTX + (t - SEQ)) * DM : INP(F, I_X) + ((size_t)b * SEQ + t) * DM;
    const GAS f32x4* xr = (const GAS f32x4*)src + F.lane;
#pragma unroll
    for (int j = 0; j < 4; ++j) v[j] = xr[64 * j];
}
__device__ __forceinline__ void norm_row(Frame& F, int l, int m, int slice0, int mode, float (&xv)[16], bool write_h, const f32x4 (&vin)[4], int mn, f32x4 (&nx2)[4]) {
    const int b = m / TB, t = m - b * TB; const bool isctx = t >= SEQ; const int r = isctx ? NB : b;
    float* xs = isctx ? (float*)(F.ws + WS_XC) + ((size_t)b * NCTX + (t - SEQ)) * DM : F.out + ((size_t)b * SEQ + t) * DM;
    f32x4 v[4];
#pragma unroll
    for (int j = 0; j < 4; ++j) v[j] = vin[j];
    const float* MODS = (const float*)(F.ws + WS_MODS);
    const float* sh = MODS + ((size_t)l * 9 + r) * 6144 + slice0 * DM; const float* scp = sh + DM;
    f32x4 sv[4], hv[4];
#pragma unroll
    for (int j = 0; j < 4; ++j) { const int col = 4 * F.lane + 256 * j; sv[j] = *(const f32x4*)(scp + col); hv[j] = *(const f32x4*)(sh + col); }
    u32x2 s0[4], s1[4]; f32x4 mq[4];
    if (mode & 2) {
        const bf16_t* sl = (const bf16_t*)(F.ws + WS_SLOT) + (size_t)m * 2 * DM;
        const float* m5 = MODS + ((size_t)(l - 1) * 9 + r) * 6144 + 5 * DM;
#pragma unroll
        for (int j = 0; j < 4; ++j) { const int col = 4 * F.lane + 256 * j; s0[j] = *(const u32x2*)(sl + col); s1[j] = *(const u32x2*)(sl + DM + col); mq[j] = *(const f32x4*)(m5 + col); }
    }
    asm volatile("" ::: "memory");
    load_xrow(F, mn, mode, nx2);
    asm volatile("" ::: "memory");
    if (mode & 2) {
#pragma unroll
        for (int j = 0; j < 4; ++j) {
            v[j][0] += mq[j][0] * (bf_lo(s0[j].x) + bf_lo(s1[j].x)); v[j][1] += mq[j][1] * (bf_hi(s0[j].x) + bf_hi(s1[j].x));
            v[j][2] += mq[j][2] * (bf_lo(s0[j].y) + bf_lo(s1[j].y)); v[j][3] += mq[j][3] * (bf_hi(s0[j].y) + bf_hi(s1[j].y)); }
        GAS f32x4* xo = (GAS f32x4*)xs + F.lane;
#pragma unroll
        for (int j = 0; j < 4; ++j) xo[64 * j] = v[j];
    }
    float ss = 0.f;
#pragma unroll
    for (int j = 0; j < 4; ++j) ss += (v[j][0] * v[j][0] + v[j][1] * v[j][1]) + (v[j][2] * v[j][2] + v[j][3] * v[j][3]);
    const float rstd = 1.0f / sqrtf(wave_sum(ss) * (1.0f / DM) + EPS);
    bf16_t* hrow = (bf16_t*)(F.ws + WS_HB) + (size_t)m * DM;
#pragma unroll
    for (int j = 0; j < 4; ++j) { const int col = 4 * F.lane + 256 * j;
        f32x4 h;
#pragma unroll
        for (int q = 0; q < 4; ++q) { h[q] = (v[j][q] * rstd) * sv[j][q] + hv[j][q]; xv[4 * j + q] = h[q]; }
        if (write_h) { u32x2 w; w.x = pk2(h[0], h[1]); w.y = pk2(h[2], h[3]); *(u32x2*)(hrow + col) = w; } }
}
__device__ __forceinline__ void hyena_short_unit(Frame& F, int l, int unit) {
    F.tid = opaque_tid(F.wv); F.lane = F.tid & 63; F.wave = __builtin_amdgcn_readfirstlane(F.tid >> 6);
    LAS bf16_t* s = (LAS bf16_t*)F.lds;
    constexpr int LDW = 258;
    const int g = unit % 3, tt = (unit / 3) % 68, b = unit / (3 * 68);
    const int t0 = tt * 64; const bool isctx = t0 >= SEQ; const int lo = isctx ? SEQ : 0, hi = isctx ? TB : SEQ;
    const bf16_t* UB = (const bf16_t*)(F.ws + WS_UB) + (size_t)b * TB * UBW + g * 256;
    __syncthreads();
    for (int i = F.tid; i < 66 * 32; i += NTHR) { const int rr = i >> 5, ch8 = (i & 31) * 8; const int t = t0 - 1 + rr;
        u32x4 v = (u32x4){0u, 0u, 0u, 0u}; if (t >= lo && t < hi) v = *(const u32x4*)(UB + (size_t)t * UBW + ch8);
        LAS unsigned* d = (LAS unsigned*)(s + rr * LDW + ch8); d[0] = v.x; d[1] = v.y; d[2] = v.z; d[3] = v.w; }
    __syncthreads();
    const int ch = F.tid & 255, tg = F.tid >> 8;
    const float* sw = INP(F, I_HSW) + (size_t)l * 3 * 768 + g * 256 + ch;
    const float w0 = sw[0], w1 = sw[768], w2 = sw[1536], bias = INP(F, I_HSB)[l * 768 + g * 256 + ch];
    bf16_t* dst = (bf16_t*)(F.ws + WS_HT) + (((size_t)b * 3 + g) * 256 + ch) * TB + t0 + tg * 32;
    float p0 = bf2f(s[(tg * 32) * LDW + ch]), p1 = bf2f(s[(tg * 32 + 1) * LDW + ch]);
#pragma unroll
    for (int q = 0; q < 4; ++q) { unsigned w[4];
#pragma unroll
        for (int e = 0; e < 4; ++e) { const int tl = tg * 32 + q * 8 + e * 2;
            const float p2 = bf2f(s[(tl + 2) * LDW + ch]), p3 = bf2f(s[(tl + 3) * LDW + ch]);
            const float o0 = w0 * p0 + w1 * p1 + w2 * p2 + bias, o1 = w0 * p1 + w1 * p2 + w2 * p3 + bias;
            w[e] = pk2(o0, o1); p0 = p2; p1 = p3; }
        *(u32x4*)(dst + q * 8) = (u32x4){w[0], w[1], w[2], w[3]}; }
}
__device__ __forceinline__ void conformer_unit(Frame& F, int l, int unit) {
    F.tid = opaque_tid(F.wv); F.lane = F.tid & 63; F.wave = __builtin_amdgcn_readfirstlane(F.tid >> 6);
    LAS float* y = (LAS float*)F.lds;
    LAS float* o = (LAS float*)(F.lds + 62 * 256 * 4);
    const int tt = unit % 136, b = unit / 136; const int t0 = tt * 32; const bool isctx = t0 >= SEQ; const int lo = isctx ? SEQ : 0, hi = isctx ? TB : SEQ;
    const bf16_t* UB = (const bf16_t*)(F.ws + WS_UB) + (size_t)b * TB * UBW + OFF_CF;
    __syncthreads();
    for (int i = F.tid; i < 62 * 32; i += NTHR) { const int rr = i >> 5, ch8 = (i & 31) * 8; const int t = t0 - 15 + rr;
        float r[8];
        if (t >= lo && t < hi) { const u32x4 a = *(const u32x4*)(UB + (size_t)t * UBW + ch8), g = *(const u32x4*)(UB + (size_t)t * UBW + 256 + ch8);
            r[0] = bf_lo(a.x) * fast_sigmoid(bf_lo(g.x)); r[1] = bf_hi(a.x) * fast_sigmoid(bf_hi(g.x)); r[2] = bf_lo(a.y) * fast_sigmoid(bf_lo(g.y)); r[3] = bf_hi(a.y) * fast_sigmoid(bf_hi(g.y));
            r[4] = bf_lo(a.z) * fast_sigmoid(bf_lo(g.z)); r[5] = bf_hi(a.z) * fast_sigmoid(bf_hi(g.z)); r[6] = bf_lo(a.w) * fast_sigmoid(bf_lo(g.w)); r[7] = bf_hi(a.w) * fast_sigmoid(bf_hi(g.w));
        } else {
#pragma unroll
            for (int q = 0; q < 8; ++q) r[q] = 0.f; }
        *(LAS f32x4*)(y + rr * 256 + ch8) = (f32x4){r[0], r[1], r[2], r[3]}; *(LAS f32x4*)(y + rr * 256 + ch8 + 4) = (f32x4){r[4], r[5], r[6], r[7]}; }
    __syncthreads();
    { const int ch = F.tid & 255, tg = F.tid >> 8;
      const float* dw = INP(F, I_CFW) + (size_t)l * 31 * 256 + ch; const float bias = INP(F, I_CFB)[l * 256 + ch];
      float acc[16];
#pragma unroll
      for (int q = 0; q < 16; ++q) acc[q] = bias;
#pragma unroll
      for (int j = 0; j < 46; ++j) { const float v = y[(tg * 16 + j) * 256 + ch];
#pragma unroll
          for (int q = 0; q < 16; ++q) { const int tap = j - q; if (tap >= 0 && tap < 31) acc[q] += dw[tap * 256] * v; } }
#pragma unroll
      for (int q = 0; q < 16; ++q) o[(tg * 16 + q) * 256 + ch] = acc[q]; }
    __syncthreads();
    { const float* lg = INP(F, I_CFG) + l * 256; const float* lb = INP(F, I_CFLB) + l * 256;
      const f32x4 gv = *(const f32x4*)(lg + 4 * F.lane), bv = *(const f32x4*)(lb + 4 * F.lane);
      bf16_t* YB = (bf16_t*)(F.ws + WS_YB) + ((size_t)b * TB + t0) * DM + 256 + 4 * F.lane;
#pragma unroll
      for (int q = 0; q < 4; ++q) { const int tl = F.wave * 4 + q; const f32x4 v = *(const LAS f32x4*)(o + tl * 256 + 4 * F.lane);
          const float mu = wave_sum((v[0] + v[1]) + (v[2] + v[3])) * (1.0f / 256.0f);
          const f32x4 d = v - mu; const float var = wave_sum((d[0] * d[0] + d[1] * d[1]) + (d[2] * d[2] + d[3] * d[3])) * (1.0f / 256.0f);
          const float rstd = 1.0f / sqrtf(var + EPS); float z[4];
#pragma unroll
          for (int e = 0; e < 4; ++e) { const float h = d[e] * rstd * gv[e] + bv[e]; z[e] = h * fast_sigmoid(h); }
          u32x2 w; w.x = pk2(z[0], z[1]); w.y = pk2(z[2], z[3]); *(u32x2*)(YB + (size_t)tl * DM) = w; } }
}
__device__ __forceinline__ void qk_prep_tables(Frame& F) {
    LAS f32x2* cs64 = (LAS f32x2*)F.lds; LAS f32x2* cs32 = cs64 + 64 * 16;
    __syncthreads();
    for (int i = F.tid; i < 64 * 16; i += NTHR) { const int p = i >> 4, f = i & 15; const float inv = powf(10000.0f, -(float)f / 16.0f); const float a = (float)p * inv; cs64[i] = (f32x2){cosf(a), sinf(a)}; }
    for (int i = F.tid; i < 64 * 8; i += NTHR) { const int p = i >> 3, f = i & 7; const float inv = powf(10000.0f, -(float)f / 8.0f); const float a = (float)p * inv; cs32[i] = (f32x2){cosf(a), sinf(a)}; }
    __syncthreads();
}
__device__ __forceinline__ void qk_prep_items(Frame& F, int l) {
    F.tid = opaque_tid(F.wv); F.lane = F.tid & 63; F.wave = __builtin_amdgcn_readfirstlane(F.tid >> 6);
    LAS f32x2* cs64 = (LAS f32x2*)F.lds; LAS f32x2* cs32 = cs64 + 64 * 16;
    const bf16_t* UB = (const bf16_t*)(F.ws + WS_UB);
    const float C2G = 0.125f * LOG2E, C2D = 0.17677669529663687f * LOG2E;
    const int T = F.bid * NTHR + F.tid, NT = F.G * NTHR;
    {
        const int rows_per_sweep = NT / 6; const int q = T % 6; const bool isq = q < 4; const int h = isq ? q : q - 4;
        const float* gn = INP(F, isq ? I_GQN : I_GKN) + l * 64; float g[64];
#pragma unroll
        for (int d = 0; d < 64; ++d) g[d] = gn[d];
        const float sc = isq ? C2G : 1.0f;
        if (T < rows_per_sweep * 6) {
        u32x4 raw[8];
        { const int m = T / 6; const bf16_t* src = UB + (size_t)m * UBW + OFF_GQA + (isq ? 0 : 256) + h * 64;
#pragma unroll
          for (int c8 = 0; c8 < 8; ++c8) raw[c8] = *(const u32x4*)(src + c8 * 8); }
        for (int m = T / 6; m < MT; m += rows_per_sweep) {
            const int b = m / TB, t = m - b * TB; const bool lat = t < SEQ; const int prow = t >> 6, pcol = t & 63;
            float v[64]; float ss = 0.f;
#pragma unroll
            for (int c8 = 0; c8 < 8; ++c8) { const u32x4 w = raw[c8];
                v[c8 * 8 + 0] = bf_lo(w.x); v[c8 * 8 + 1] = bf_hi(w.x); v[c8 * 8 + 2] = bf_lo(w.y); v[c8 * 8 + 3] = bf_hi(w.y); v[c8 * 8 + 4] = bf_lo(w.z); v[c8 * 8 + 5] = bf_hi(w.z); v[c8 * 8 + 6] = bf_lo(w.w); v[c8 * 8 + 7] = bf_hi(w.w); }
            { const int mn = (m + rows_per_sweep < MT) ? m + rows_per_sweep : m; const bf16_t* src = UB + (size_t)mn * UBW + OFF_GQA + (isq ? 0 : 256) + h * 64;
              asm volatile("" ::: "memory");
#pragma unroll
              for (int c8 = 0; c8 < 8; ++c8) raw[c8] = *(const u32x4*)(src + c8 * 8);
              asm volatile("" ::: "memory"); }
#pragma unroll
            for (int d = 0; d < 64; ++d) ss += v[d] * v[d];
            const float rstd = 1.0f / sqrtf(ss * (1.0f / 64.0f) + EPS);
#pragma unroll
            for (int d = 0; d < 64; ++d) v[d] = v[d] * rstd * g[d];
            if (lat) {
#pragma unroll
                for (int hf = 0; hf < 2; ++hf) { const int p = hf ? pcol : prow;
#pragma unroll
                    for (int f = 0; f < 16; ++f) { const f32x2 cs = cs64[p * 16 + f]; const float x1 = v[hf * 32 + f], x2 = v[hf * 32 + 16 + f];
                        v[hf * 32 + f] = x1 * cs.x - x2 * cs.y; v[hf * 32 + 16 + f] = x2 * cs.x + x1 * cs.y; } }
            }
            bf16_t* dst = isq ? (bf16_t*)(F.ws + WS_QG) + (size_t)m * 256 + h * 64 : (bf16_t*)(F.ws + WS_KG) + (size_t)m * 128 + h * 64;
#pragma unroll
            for (int c8 = 0; c8 < 8; ++c8) { u32x4 w; w.x = pk2(v[c8 * 8] * sc, v[c8 * 8 + 1] * sc); w.y = pk2(v[c8 * 8 + 2] * sc, v[c8 * 8 + 3] * sc); w.z = pk2(v[c8 * 8 + 4] * sc, v[c8 * 8 + 5] * sc); w.w = pk2(v[c8 * 8 + 6] * sc, v[c8 * 8 + 7] * sc);
                *(u32x4*)(dst + c8 * 8) = w; }
        }
        }
    }
    {
        const int rows_per_sweep = NT / 16; const int q = T % 16; const bool isq = q < 8; const int hm = q & 7; const int mm = hm & 1;
        const float* gn = INP(F, isq ? I_DQN : I_DKN) + l * 64 + mm * 32; float g[32];
#pragma unroll
        for (int d = 0; d < 32; ++d) g[d] = gn[d];
        const float sc = isq ? C2D : 1.0f;
        u32x4 raw[2][4];
#pragma unroll
        for (int u = 0; u < 2; ++u) { const int m = T / 16 + u * rows_per_sweep; const int mc = m < MT ? m : T / 16;
            const bf16_t* src = UB + (size_t)mc * UBW + OFF_DIFF + (isq ? 0 : 256) + hm * 32;
#pragma unroll
            for (int c8 = 0; c8 < 4; ++c8) raw[u][c8] = *(const u32x4*)(src + c8 * 8); }
        for (int m0 = T / 16; m0 < MT; m0 += 2 * rows_per_sweep) {
            float v[2][32]; bool ok[2];
#pragma unroll
            for (int u = 0; u < 2; ++u) { const int m = m0 + u * rows_per_sweep; ok[u] = m < MT;
#pragma unroll
                for (int c8 = 0; c8 < 4; ++c8) { const u32x4 w = raw[u][c8];
                    v[u][c8 * 8 + 0] = bf_lo(w.x); v[u][c8 * 8 + 1] = bf_hi(w.x); v[u][c8 * 8 + 2] = bf_lo(w.y); v[u][c8 * 8 + 3] = bf_hi(w.y); v[u][c8 * 8 + 4] = bf_lo(w.z); v[u][c8 * 8 + 5] = bf_hi(w.z); v[u][c8 * 8 + 6] = bf_lo(w.w); v[u][c8 * 8 + 7] = bf_hi(w.w); } }
            asm volatile("" ::: "memory");
#pragma unroll
            for (int u = 0; u < 2; ++u) { const int m = m0 + (2 + u) * rows_per_sweep; const int mc = m < MT ? m : m0;
                const bf16_t* src = UB + (size_t)mc * UBW + OFF_DIFF + (isq ? 0 : 256) + hm * 32;
#pragma unroll
                for (int c8 = 0; c8 < 4; ++c8) raw[u][c8] = *(const u32x4*)(src + c8 * 8); }
            asm volatile("" ::: "memory");
#pragma unroll
            for (int u = 0; u < 2; ++u) { const int m = m0 + u * rows_per_sweep; if (!ok[u]) continue;
                const int b = m / TB, t = m - b * TB; const bool lat = t < SEQ; const int prow = t >> 6, pcol = t & 63;
                float ss = 0.f;
#pragma unroll
                for (int d = 0; d < 32; ++d) ss += v[u][d] * v[u][d];
                const float rstd = 1.0f / sqrtf(ss * (1.0f / 32.0f) + EPS);
#pragma unroll
                for (int d = 0; d < 32; ++d) v[u][d] = v[u][d] * rstd * g[d];
                if (lat) {
#pragma unroll
                    for (int hf = 0; hf < 2; ++hf) { const int p = hf ? pcol : prow;
#pragma unroll
                        for (int f = 0; f < 8; ++f) { const f32x2 cs = cs32[p * 8 + f]; const float x1 = v[u][hf * 16 + f], x2 = v[u][hf * 16 + 8 + f];
                            v[u][hf * 16 + f] = x1 * cs.x - x2 * cs.y; v[u][hf * 16 + 8 + f] = x2 * cs.x + x1 * cs.y; } }
                }
                bf16_t* dst = (bf16_t*)(F.ws + (isq ? WS_QD : WS_KD)) + (size_t)m * 256 + hm * 32;
#pragma unroll
                for (int c8 = 0; c8 < 4; ++c8) { u32x4 w; w.x = pk2(v[u][c8 * 8] * sc, v[u][c8 * 8 + 1] * sc); w.y = pk2(v[u][c8 * 8 + 2] * sc, v[u][c8 * 8 + 3] * sc); w.z = pk2(v[u][c8 * 8 + 4] * sc, v[u][c8 * 8 + 5] * sc); w.w = pk2(v[u][c8 * 8 + 6] * sc, v[u][c8 * 8 + 7] * sc);
                    *(u32x4*)(dst + c8 * 8) = w; } }
        }
    }
}

__device__ __forceinline__ void hyena_conv_unit(Frame& F, int l, int unit) {
    F.tid = opaque_tid(F.wv); F.lane = F.tid & 63; F.wave = __builtin_amdgcn_readfirstlane(F.tid >> 6);
    LAS f32x2* bufA = (LAS f32x2*)F.lds; LAS f32x2* bufB = (LAS f32x2*)(F.lds + 69632);
    const int c = unit >> 1, hb = unit & 1; const int b0 = 4 * hb, b1 = b0 + 1, b2 = b0 + 2, b3 = b0 + 3;
    const bf16_t* HT = (const bf16_t*)(F.ws + WS_HT);
    const size_t bstr = (size_t)3 * 256 * TB;
    const bf16_t* x1p = HT + ((size_t)b0 * 3 * 256 + 0 * 256 + c) * TB; const bf16_t* x2p = HT + ((size_t)b0 * 3 * 256 + 1 * 256 + c) * TB; const bf16_t* vp = HT + ((size_t)b0 * 3 * 256 + 2 * 256 + c) * TB;
    const f32x2* KF0 = (const f32x2*)(F.ws + WS_KF) + (size_t)c * 8192; const f32x2* KF1 = KF0 + (size_t)256 * 8192;
    const float bias0 = INP(F, I_HBIAS)[(l * 2 + 0) * 256 + c], bias1 = INP(F, I_HBIAS)[(l * 2 + 1) * 256 + c];
    f32x2 za[8], zb[8];
    __syncthreads();
#pragma unroll
    for (int q = 0; q < 8; ++q) { const int t = F.tid + NTHR * q; za[q] = (f32x2){bf2f(vp[t]), bf2f(vp[bstr + t])}; zb[q] = (f32x2){bf2f(vp[2 * bstr + t]), bf2f(vp[3 * bstr + t])}; }
#pragma unroll 1
    for (int o = 0; o < 2; ++o) {
        fft_fwd_regs_mulK_x2(bufA, bufB, F.tid, za, zb, o ? KF1 : KF0);
        f32x2 ra[8], rb[8];
        fft_to_regs_lo_x2(bufA, bufB, F.tid, ra, rb);
        const bf16_t* gp = o ? x2p : x1p; const float bias = o ? bias1 : bias0;
#pragma unroll
        for (int q = 0; q < 8; ++q) { const int t = F.tid + NTHR * q;
            za[q] = (f32x2){bf2f(gp[t]) * (ra[q].x + bias * za[q].x), bf2f(gp[bstr + t]) * (-ra[q].y + bias * za[q].y)};
            zb[q] = (f32x2){bf2f(gp[2 * bstr + t]) * (rb[q].x + bias * zb[q].x), bf2f(gp[3 * bstr + t]) * (-rb[q].y + bias * zb[q].y)}; }
        __syncthreads();
    }
    bf16_t* YB = (bf16_t*)(F.ws + WS_YB);
#pragma unroll
    for (int q = 0; q < 8; ++q) { const int t = F.tid + NTHR * q;
        YB[((size_t)b0 * TB + t) * DM + c] = (bf16_t)f2bf(za[q].x); YB[((size_t)b1 * TB + t) * DM + c] = (bf16_t)f2bf(za[q].y);
        YB[((size_t)b2 * TB + t) * DM + c] = (bf16_t)f2bf(zb[q].x); YB[((size_t)b3 * TB + t) * DM + c] = (bf16_t)f2bf(zb[q].y); }
}
__device__ __forceinline__ void hyena_ctx_unit(Frame& F, int l, int unit) {
    F.tid = opaque_tid(F.wv); F.lane = F.tid & 63; F.wave = __builtin_amdgcn_readfirstlane(F.tid >> 6);
    LAS float* zs = (LAS float*)F.lds;
    LAS float* Gs = (LAS float*)(F.lds + 8192);
    const int b = unit >> 5, c0 = (unit & 31) * 8; const int ch = F.tid & 7, tg = F.tid >> 3; const int c = c0 + ch;
    const bf16_t* HT = (const bf16_t*)(F.ws + WS_HT);
    const bf16_t* x1 = HT + (((size_t)b * 3 + 0) * 256 + c) * TB + SEQ; const bf16_t* x2 = HT + (((size_t)b * 3 + 1) * 256 + c) * TB + SEQ; const bf16_t* vv = HT + (((size_t)b * 3 + 2) * 256 + c) * TB + SEQ;
    const float* KC = (const float*)(F.ws + WS_KC);
    const int t0 = tg * 4;
    float z[4];
#pragma unroll
    for (int q = 0; q < 4; ++q) z[q] = bf2f(vv[t0 + q]);
#pragma unroll 1
    for (int o = 0; o < 2; ++o) {
        __syncthreads();
#pragma unroll
        for (int q = 0; q < 4; ++q) zs[(t0 + q) * 8 + ch] = z[q];
        for (int i = F.tid; i < 512 * 8; i += NTHR) { const int d = i >> 3, cc = i & 7; Gs[i] = d < 511 ? KC[((size_t)o * 256 + c0 + cc) * 512 + d] : 0.f; }
        __syncthreads();
        float acc[4] = {0.f, 0.f, 0.f, 0.f};
#pragma unroll 1
        for (int s0 = 0; s0 < 256; s0 += 16) {
            float tw[19];
#pragma unroll
            for (int i = 0; i < 19; ++i) tw[i] = Gs[(t0 - s0 - 15 + i + 255) * 8 + ch];
#pragma unroll
            for (int k = 0; k < 16; ++k) { const float zv = zs[(s0 + k) * 8 + ch];
#pragma unroll
                for (int q = 0; q < 4; ++q) acc[q] += zv * tw[q - k + 15]; }
        }
        const bf16_t* g = o ? x2 : x1; const float bias = INP(F, I_HBIAS)[(l * 2 + o) * 256 + c];
#pragma unroll
        for (int q = 0; q < 4; ++q) z[q] = bf2f(g[t0 + q]) * (acc[q] + bias * z[q]);
    }
    bf16_t* YB = (bf16_t*)(F.ws + WS_YB) + ((size_t)b * TB + SEQ) * DM + c;
#pragma unroll
    for (int q = 0; q < 4; ++q) YB[(size_t)(t0 + q) * DM] = (bf16_t)f2bf(z[q]);
}
namespace attn_body {
constexpr int D = 64, NW = 8, QBLK = 32, QB = QBLK * NW, KVBLK = 64;
__device__ __forceinline__ int crow(int r, int hi) { return (r & 3) + 8 * (r >> 2) + 4 * hi; }
#define SBAR() __builtin_amdgcn_sched_barrier(0)
constexpr int NSLOT = 3, SLOTB = 8192;
constexpr int LDS_K = 0, LDS_V = NSLOT * SLOTB, LDS_WS = 2 * NSLOT * SLOTB, LDS_OST = LDS_WS + NW * 64 * 4, LDS_O1 = LDS_OST + NW * 4096, LDS_BYTES_ATTN = LDS_O1 + NW * 8192;
__device__ __forceinline__ void glds16(const void* gsrc, unsigned lds_dst) { unsigned keep;
  asm volatile("s_mov_b32 %0, m0\n\ts_mov_b32 m0, %2\n\ts_nop 0\n\tglobal_load_lds_dwordx4 %1, off\n\ts_mov_b32 m0, %0" : "=&s"(keep) : "v"(gsrc), "s"(lds_dst) : "memory"); }
__device__ __forceinline__ float max3f(float a, float b, float c) { float r; asm("v_max3_f32 %0, %1, %2, %3" : "=v"(r) : "v"(a), "v"(b), "v"(c)); return r; }
__device__ __forceinline__ float max2f(float a, float b) { float r; asm("v_max_f32_e32 %0, %1, %2" : "=v"(r) : "v"(a), "v"(b)); return r; }
__device__ __forceinline__ float fadd_s(float a, float b) { float r; asm("v_add_f32_e32 %0, %1, %2" : "=v"(r) : "v"(a), "v"(b)); return r; }
__device__ __forceinline__ float fsub_s(float a, float b) { float r; asm("v_sub_f32_e32 %0, %1, %2" : "=v"(r) : "v"(a), "v"(b)); return r; }
typedef float f32x2_t __attribute__((ext_vector_type(2))); typedef __bf16 bf16x2_t __attribute__((ext_vector_type(2)));
__device__ __forceinline__ unsigned cvtpk_s(float lo, float hi) { f32x2_t v = {lo, hi}; bf16x2_t b = __builtin_convertvector(v, bf16x2_t); return __builtin_bit_cast(unsigned, b); }
#define WAIT_BAR(N) asm volatile("s_waitcnt vmcnt(" #N ") lgkmcnt(0)\n\ts_barrier" ::: "memory")
template <int ND0> __device__ __forceinline__ void qkt(f32x16& p0, f32x16& p1, const char* Kslot, const bf16x8* qr, const f32x16& negm, int r32, int hi) {
  const char* kb = Kslot + hi * 1024 + r32 * 16;
  #pragma unroll
  for (int d0 = 0; d0 < ND0; ++d0) {
    const bf16x8 b0 = *reinterpret_cast<const bf16x8*>(kb + d0 * 2048);
    const bf16x8 b1 = *reinterpret_cast<const bf16x8*>(kb + d0 * 2048 + 512);
    if (d0 == 0) { p0 = __builtin_amdgcn_mfma_f32_32x32x16_bf16(b0, qr[0], negm, 0, 0, 0); p1 = __builtin_amdgcn_mfma_f32_32x32x16_bf16(b1, qr[0], negm, 0, 0, 0); }
    else { p0 = __builtin_amdgcn_mfma_f32_32x32x16_bf16(b0, qr[d0], p0, 0, 0, 0); p1 = __builtin_amdgcn_mfma_f32_32x32x16_bf16(b1, qr[d0], p1, 0, 0, 0); } }
}
typedef __attribute__((address_space(3))) const char* lds_cptr;
typedef short v4i16_t __attribute__((ext_vector_type(4)));
template <int ND0> __device__ __forceinline__ void kload8(bf16x8* kf, lds_cptr kp) {
  kf[0] = *(const __attribute__((address_space(3))) bf16x8*)(kp);        kf[1] = *(const __attribute__((address_space(3))) bf16x8*)(kp + 512);
  kf[2] = *(const __attribute__((address_space(3))) bf16x8*)(kp + 2048); kf[3] = *(const __attribute__((address_space(3))) bf16x8*)(kp + 2560);
  if constexpr (ND0 == 4) {
  kf[4] = *(const __attribute__((address_space(3))) bf16x8*)(kp + 4096); kf[5] = *(const __attribute__((address_space(3))) bf16x8*)(kp + 4608);
  kf[6] = *(const __attribute__((address_space(3))) bf16x8*)(kp + 6144); kf[7] = *(const __attribute__((address_space(3))) bf16x8*)(kp + 6656); }
}
__device__ __forceinline__ void kload2(bf16x8* kf, lds_cptr kp, int j) { kf[2 * j] = *(const __attribute__((address_space(3))) bf16x8*)(kp + j * 2048); kf[2 * j + 1] = *(const __attribute__((address_space(3))) bf16x8*)(kp + j * 2048 + 512); }
__device__ __forceinline__ s16x4 vtr(lds_cptr p) { return __builtin_bit_cast(s16x4, __builtin_amdgcn_ds_read_tr16_b64_v4i16((__attribute__((address_space(3))) v4i16_t*)p)); }
__device__ __forceinline__ float rowmax(const f32x16& p0, const f32x16& p1) {
  float a = max3f(p0[0], p0[1], p1[0]), b = max3f(p0[2], p0[3], p1[1]); a = max3f(a, p1[2], p1[3]);
  #pragma unroll
  for (int r = 4; r < 16; r += 4) { a = max3f(a, p0[r], p0[r + 1]); b = max3f(b, p0[r + 2], p0[r + 3]); a = max3f(a, p1[r], p1[r + 1]); b = max3f(b, p1[r + 2], p1[r + 3]); }
  const float m = max2f(a, b);
  auto rr = __builtin_amdgcn_permlane32_swap(__float_as_uint(m), __float_as_uint(m), false, false);
  return max2f(__uint_as_float(rr[0]), __uint_as_float(rr[1]));
}
__device__ __forceinline__ void pv(f32x16* o, int vb, bf16x8 pa0, bf16x8 pa1, bf16x8 pa2, bf16x8 pa3) {
  #pragma unroll
  for (int d0 = 0; d0 < 2; ++d0) { s16x4 lo[4], hi[4];
    #pragma unroll
    for (int ks = 0; ks < 4; ++ks) {
      asm volatile("ds_read_b64_tr_b16 %0,%1 offset:%c2" : "=&v"(lo[ks]) : "v"(vb), "i"(d0 * 4096 + ks * 1024) : "memory");
      asm volatile("ds_read_b64_tr_b16 %0,%1 offset:%c2" : "=&v"(hi[ks]) : "v"(vb), "i"(d0 * 4096 + ks * 1024 + 512) : "memory"); }
    asm volatile("s_waitcnt lgkmcnt(0)" ::: "memory"); SBAR();
    #define PK(k) (bf16x8){lo[k][0], lo[k][1], lo[k][2], lo[k][3], hi[k][0], hi[k][1], hi[k][2], hi[k][3]}
    o[d0] = __builtin_amdgcn_mfma_f32_32x32x16_bf16(pa0, PK(0), o[d0], 0, 0, 0);
    o[d0] = __builtin_amdgcn_mfma_f32_32x32x16_bf16(pa1, PK(1), o[d0], 0, 0, 0);
    o[d0] = __builtin_amdgcn_mfma_f32_32x32x16_bf16(pa2, PK(2), o[d0], 0, 0, 0);
    o[d0] = __builtin_amdgcn_mfma_f32_32x32x16_bf16(pa3, PK(3), o[d0], 0, 0, 0);
    #undef PK
  }
}
template <int THRL, int MODE, int DQ = 64> __device__ __forceinline__ void attn_unit(const bf16_t* Qw0, int qp, const bf16_t* __restrict__ Kh, int kp, const bf16_t* __restrict__ Vh, int vp, int NT, bf16_t* Ow0, int op, char* shm, float lam, const float* gsub, float post, const int wv) {
  const int tid = opaque_tid(wv), lane = tid & 63, r32 = lane & 31, hi = lane >> 5; const int wid = __builtin_amdgcn_readfirstlane(tid >> 6);
  const bf16_t* Qw = Qw0 + (long)wid * QBLK * qp;
  const unsigned lds0 = (unsigned)(uintptr_t)shm;
  float* wsf = (float*)(shm + LDS_WS) + wid * 64;
  constexpr int ND0 = DQ / 16;
  const int kch = (DQ == 32) ? (wid & 3) : wid;
  const bf16_t* ksrc = Kh + (long)lane * kp + kch * 8;
  const bf16_t* vsrc = Vh + (long)(16 * (wid & 3) + (lane >> 2)) * vp + (wid >> 2) * 32 + (lane & 3) * 8;
  const unsigned kdst = lds0 + LDS_K + kch * 1024, vdst = lds0 + LDS_V + wid * 1024;
  #define DMA_K(t, slot) glds16(ksrc + (long)(t) * KVBLK * kp, (unsigned)__builtin_amdgcn_readfirstlane(kdst + (slot)))
  #define DMA_V(t, slot) glds16(vsrc + (long)(t) * KVBLK * vp, (unsigned)__builtin_amdgcn_readfirstlane(vdst + (slot)))
  const int vb0 = (int)(lds0 + LDS_V) + ((lane >> 4) & 1) * 32 + (lane & 3) * 8 + (4 * hi + ((lane & 15) >> 2)) * 64;
  const char* Kbase = shm + LDS_K; bf16x8 kf[8];
  const lds_cptr shm3 = (lds_cptr)shm; const lds_cptr kp0 = shm3 + LDS_K + hi * 1024 + r32 * 16; const lds_cptr vp0 = shm3 + LDS_V + ((lane >> 4) & 1) * 32 + (lane & 3) * 8 + (4 * hi + ((lane & 15) >> 2)) * 64;
  DMA_K(0, 0); DMA_V(0, 0); DMA_K(1, SLOTB);
  bf16x8 qr[4];
  #pragma unroll
  for (int d0 = 0; d0 < ND0; ++d0) qr[d0] = *reinterpret_cast<const bf16x8*>(&Qw[(long)r32 * qp + d0 * 16 + hi * 8]);
  float mhat = 0.f, l_reg = 0.f; f32x16 o[2]; o[0] = f32x16{}; o[1] = f32x16{}; f32x16 negm = f32x16{}; asm volatile("" : "+v"(negm));
  bool resc = false;
  #define START(P0, P1) do { const float rm = rowmax(P0, P1); resc = false; \
    { const float dl = rm; mhat = fadd_s(mhat, dl); \
      _Pragma("unroll") for (int r = 0; r < 16; ++r) { P0[r] = fsub_s(P0[r], dl); P1[r] = fsub_s(P1[r], dl); } \
      _Pragma("unroll") for (int r = 0; r < 16; ++r) negm[r] = -mhat; asm volatile("" : "+v"(negm)); } \
    _Pragma("unroll") for (int r = 0; r < 16; ++r) P0[r] = __builtin_amdgcn_exp2f(P0[r]); } while (0)
  #define RESC() do { if (resc) { asm volatile("s_waitcnt lgkmcnt(0)" ::: "memory"); \
      _Pragma("unroll") for (int d_ = 0; d_ < 2; ++d_) _Pragma("unroll") for (int r = 0; r < 16; ++r) o[d_][r] *= wsf[crow(r, hi)]; } } while (0)
  f32x16 pA0, pA1, pB0, pB1;
  int sl_prev = 0, sl_cur = 0, sl_next = SLOTB;
  #define ROT() do { sl_prev = sl_cur; sl_cur = sl_next; sl_next = (sl_next == (NSLOT - 1) * SLOTB) ? 0 : sl_next + SLOTB; } while (0)
  DMA_K(2, 2 * SLOTB);
  WAIT_BAR(3);
  qkt<ND0>(pA0, pA1, Kbase, qr, negm, r32, hi); asm volatile("s_nop 15\n\ts_nop 7" : "+v"(pA0), "+v"(pA1));
  START(pA0, pA1);
  _Pragma("unroll") for (int r = 0; r < 16; ++r) pA1[r] = __builtin_amdgcn_exp2f(pA1[r]);
  WAIT_BAR(0);
  DMA_K(3, 0); DMA_V(1, SLOTB);
  ROT();
  kload8<ND0>(kf, kp0 + sl_cur);
  WAIT_BAR(2);
  s16x4 vlo[8], vhi[8]; u32x4 pw0, pw1, pw2, pw3;
  #define PKW(P, B) cvtpk_s(P[B], P[B + 1])
  #define PAF(k) __builtin_bit_cast(bf16x8, pw##k)
  #define VFR(i) (bf16x8){vlo[i][0], vlo[i][1], vlo[i][2], vlo[i][3], vhi[i][0], vhi[i][1], vhi[i][2], vhi[i][3]}
  #define PIN(x) asm volatile("" : "+v"(x))
  #define MX3(a, b, c) __builtin_fmaxf(__builtin_fmaxf((a), (b)), (c))
  #define GAPA(MF, A0, A1, A2, A3, W0, W1, PW) do { MF; sacc += A0; sacc += A1; sacc += A2; sacc += A3; PIN(sacc); W0; W1; PIN(PW); SBAR(); } while (0)
  #define EX(v) __builtin_amdgcn_exp2f(v)
  #define GAPB(MF, X, B) do { MF; X[B] = EX(X[B]); X[B + 1] = EX(X[B + 1]); X[B + 2] = EX(X[B + 2]); X[B + 3] = EX(X[B + 3]); PIN(X); SBAR(); } while (0)
  #define VRD(i) do { vlo[i] = vtr(vp_ + (((i) >> 2) * 4096 + ((i) & 3) * 1024)); vhi[i] = vtr(vp_ + (((i) >> 2) * 4096 + ((i) & 3) * 1024 + 512)); } while (0)
  #define KRD(G, j) do { if ((j) < ND0 && (G)) { kload2(kf, kp0 + sl_next, j); SBAR(); } } while (0)
  #define QKX(C, k, q) do { if constexpr (ND0 == 4) { C = __builtin_amdgcn_mfma_f32_32x32x16_bf16(kf[k], qr[q], C, 0, 0, 0); } } while (0)
  #define STEP(C0, C1, P0, P1, t, GK, GV, GL) do { SBAR(); \
    const lds_cptr vp_ = vp0 + sl_prev; \
    VRD(0); SBAR(); float sacc = (P0[0] + P0[1]); \
    GAPA(C0 = __builtin_amdgcn_mfma_f32_32x32x16_bf16(kf[0], qr[0], negm, 0, 0, 0), P0[2], P0[3], P0[4], P0[5],     pw0[0] = PKW(P0, 0), pw0[1] = PKW(P0, 2), pw0); \
    VRD(4); SBAR(); GAPA(C1 = __builtin_amdgcn_mfma_f32_32x32x16_bf16(kf[1], qr[0], negm, 0, 0, 0), P0[6], P0[7], P0[8], P0[9],     pw0[2] = PKW(P0, 4), pw0[3] = PKW(P0, 6), pw0); \
    VRD(1); SBAR(); GAPA(C0 = __builtin_amdgcn_mfma_f32_32x32x16_bf16(kf[2], qr[1], C0, 0, 0, 0),   P0[10], P0[11], P0[12], P0[13], pw1[0] = PKW(P0, 8), pw1[1] = PKW(P0, 10), pw1); \
    VRD(5); SBAR(); GAPA(C1 = __builtin_amdgcn_mfma_f32_32x32x16_bf16(kf[3], qr[1], C1, 0, 0, 0),   P0[14], P0[15], P1[0], P1[1],   pw1[2] = PKW(P0, 12), pw1[3] = PKW(P0, 14), pw1); \
    VRD(2); SBAR(); GAPA(QKX(C0, 4, 2),   P1[2], P1[3], P1[4], P1[5],     pw2[0] = PKW(P1, 0), pw2[1] = PKW(P1, 2), pw2); \
    VRD(6); SBAR(); GAPA(QKX(C1, 5, 2),   P1[6], P1[7], P1[8], P1[9],     pw2[2] = PKW(P1, 4), pw2[3] = PKW(P1, 6), pw2); \
    VRD(3); SBAR(); GAPA(QKX(C0, 6, 3),   P1[10], P1[11], P1[12], P1[13], pw3[0] = PKW(P1, 8), pw3[1] = PKW(P1, 10), pw3); \
    VRD(7); SBAR(); GAPA(QKX(C1, 7, 3),   P1[14], P1[15], 0.f, 0.f,       pw3[2] = PKW(P1, 12), pw3[3] = PKW(P1, 14), pw3); \
    l_reg += sacc; \
    if (GK) { DMA_K((t) + 3, sl_cur); } if (GV) { DMA_V((t) + 1, sl_next); } \
    { float a = MX3(C0[0], C0[1], C1[0]), b = MX3(C0[2], C0[3], C1[1]); a = MX3(a, C1[2], C1[3]); \
      _Pragma("unroll") for (int r = 4; r < 16; r += 4) { a = MX3(a, C0[r], C0[r + 1]); b = MX3(b, C0[r + 2], C0[r + 3]); a = MX3(a, C1[r], C1[r + 1]); b = MX3(b, C1[r + 2], C1[r + 3]); } \
      float rm = __builtin_fmaxf(a, b); { auto rr = __builtin_amdgcn_permlane32_swap(__float_as_uint(rm), __float_as_uint(rm), false, false); rm = __builtin_fmaxf(__uint_as_float(rr[0]), __uint_as_float(rr[1])); } \
      resc = false; \
      if (__builtin_expect(__any(rm > (float)THRL), 0)) { const float dl = __builtin_fmaxf(rm, 0.f); mhat += dl; \
        _Pragma("unroll") for (int r = 0; r < 16; ++r) { C0[r] -= dl; C1[r] -= dl; } \
        _Pragma("unroll") for (int r = 0; r < 16; ++r) negm[r] = -mhat; asm volatile("" : "+v"(negm)); \
        const float f = __builtin_amdgcn_exp2f(-dl); l_reg *= f; if (hi == 0) wsf[r32] = f; resc = true; } } \
    SBAR(); \
    GAPB(o[0] = __builtin_amdgcn_mfma_f32_32x32x16_bf16(PAF(0), VFR(0), o[0], 0, 0, 0), C0, 0); \
    GAPB(o[1] = __builtin_amdgcn_mfma_f32_32x32x16_bf16(PAF(0), VFR(4), o[1], 0, 0, 0), C0, 4); \
    KRD(GL, 0); GAPB(o[0] = __builtin_amdgcn_mfma_f32_32x32x16_bf16(PAF(1), VFR(1), o[0], 0, 0, 0), C0, 8); \
    KRD(GL, 1); GAPB(o[1] = __builtin_amdgcn_mfma_f32_32x32x16_bf16(PAF(1), VFR(5), o[1], 0, 0, 0), C0, 12); \
    KRD(GL, 2); GAPB(o[0] = __builtin_amdgcn_mfma_f32_32x32x16_bf16(PAF(2), VFR(2), o[0], 0, 0, 0), C1, 0); \
    KRD(GL, 3); GAPB(o[1] = __builtin_amdgcn_mfma_f32_32x32x16_bf16(PAF(2), VFR(6), o[1], 0, 0, 0), C1, 4); \
    GAPB(o[0] = __builtin_amdgcn_mfma_f32_32x32x16_bf16(PAF(3), VFR(3), o[0], 0, 0, 0), C1, 8); \
    GAPB(o[1] = __builtin_amdgcn_mfma_f32_32x32x16_bf16(PAF(3), VFR(7), o[1], 0, 0, 0), C1, 12); \
    } while (0)
  int t = 1;
  for (; t + 5 < NT; t += 2) {
    STEP(pB0, pB1, pA0, pA1, t, true, true, true);     WAIT_BAR(2); RESC(); ROT();
    STEP(pA0, pA1, pB0, pB1, t + 1, true, true, true); WAIT_BAR(2); RESC(); ROT();
  }
  #define ENDW(tt) do { if ((tt) + 3 < NT) { WAIT_BAR(2); } else if ((tt) + 2 < NT) { WAIT_BAR(1); } else { WAIT_BAR(0); } } while (0)
  for (; t + 1 < NT; t += 2) {
    STEP(pB0, pB1, pA0, pA1, t, (t + 3 < NT), (t + 1 < NT), (t + 1 < NT));         ENDW(t);     RESC(); ROT();
    STEP(pA0, pA1, pB0, pB1, t + 1, (t + 4 < NT), (t + 2 < NT), (t + 2 < NT));     ENDW(t + 1); RESC(); ROT();
  }
  STEP(pB0, pB1, pA0, pA1, NT - 1, false, false, false); RESC();
  { float sacc = pB0[0] + pB0[1]; _Pragma("unroll") for (int r = 2; r < 16; ++r) sacc += pB0[r]; _Pragma("unroll") for (int r = 0; r < 16; ++r) sacc += pB1[r]; l_reg += sacc;
    pw0 = (u32x4){PKW(pB0, 0), PKW(pB0, 2), PKW(pB0, 4), PKW(pB0, 6)}; pw1 = (u32x4){PKW(pB0, 8), PKW(pB0, 10), PKW(pB0, 12), PKW(pB0, 14)}; pw2 = (u32x4){PKW(pB1, 0), PKW(pB1, 2), PKW(pB1, 4), PKW(pB1, 6)}; pw3 = (u32x4){PKW(pB1, 8), PKW(pB1, 10), PKW(pB1, 12), PKW(pB1, 14)};
    SBAR(); pv(o, vb0 + sl_cur, PAF(0), PAF(1), PAF(2), PAF(3)); }
  #undef PKW
  #undef PAF
  #undef VFR
  #undef PIN
  #undef MX3
  #undef GAPA
  #undef GAPB
  #undef EX
  #undef VRD
  #undef KRD
  #undef QKX
  #undef STEP
  #undef ENDW
  { auto rr = __builtin_amdgcn_permlane32_swap(__float_as_uint(l_reg), __float_as_uint(l_reg), false, false); l_reg = __uint_as_float(rr[0]) + __uint_as_float(rr[1]); }
  if (hi == 0) wsf[32 + r32] = l_reg; asm volatile("s_waitcnt lgkmcnt(0)" ::: "memory");
  float rli[16];
  #pragma unroll
  for (int r = 0; r < 16; ++r) rli[r] = __builtin_amdgcn_rcpf(wsf[32 + crow(r, hi)]);
  bf16_t* Ow = Ow0 + (long)wid * QBLK * op;
  float* o1s = (float*)(shm + LDS_O1) + wid * 2048;
  if constexpr (MODE == 0) {
    bf16_t* stg = (bf16_t*)(shm + LDS_OST) + wid * 2048;
    #pragma unroll
    for (int r = 0; r < 16; ++r) { const int orow = crow(r, hi);
      #pragma unroll
      for (int d0 = 0; d0 < 2; ++d0) stg[orow * 64 + d0 * 32 + r32] = (bf16_t)f2bf(o[d0][r] * rli[r]); }
    asm volatile("s_waitcnt lgkmcnt(0)" ::: "memory");
    #pragma unroll
    for (int i = 0; i < 4; ++i) { const int row = i * 8 + (lane >> 3), ch = lane & 7; const u32x4 v = *(const u32x4*)(stg + row * 64 + ch * 8); *(u32x4*)(Ow + (long)row * op + ch * 8) = v; }
  } else if constexpr (MODE == 1) {
    #pragma unroll
    for (int r = 0; r < 16; ++r) { const int orow = crow(r, hi);
      #pragma unroll
      for (int d0 = 0; d0 < 2; ++d0) o1s[orow * 64 + d0 * 32 + r32] = o[d0][r] * rli[r]; }
  } else {
    #pragma unroll
    for (int r = 0; r < 16; ++r) { const int orow = crow(r, hi);
      #pragma unroll
      for (int d0 = 0; d0 < 2; ++d0) { const int ix = orow * 64 + d0 * 32 + r32; o1s[ix] = o1s[ix] - lam * (o[d0][r] * rli[r]); } }
    asm volatile("s_waitcnt lgkmcnt(0)" ::: "memory");
    #pragma unroll
    for (int i = 0; i < 4; ++i) { const int row = i * 8 + (lane >> 3), ch = lane & 7;
      const f32x4 a = *(const f32x4*)(o1s + row * 64 + ch * 8), b = *(const f32x4*)(o1s + row * 64 + ch * 8 + 4);
      float ss = (a[0] * a[0] + a[1] * a[1]) + (a[2] * a[2] + a[3] * a[3]) + (b[0] * b[0] + b[1] * b[1]) + (b[2] * b[2] + b[3] * b[3]);
      ss += __builtin_bit_cast(float, __builtin_amdgcn_update_dpp(0, __builtin_bit_cast(int, ss), 0xB1, 0xf, 0xf, false));
      ss += __builtin_bit_cast(float, __builtin_amdgcn_update_dpp(0, __builtin_bit_cast(int, ss), 0x4E, 0xf, 0xf, false));
      ss += __builtin_bit_cast(float, __builtin_amdgcn_update_dpp(0, __builtin_bit_cast(int, ss), 0x141, 0xf, 0xf, false));
      const float rs = post / sqrtf(ss * (1.0f / 64.0f) + EPS);
      const f32x4 g0 = *(const f32x4*)(gsub + ch * 8), g1 = *(const f32x4*)(gsub + ch * 8 + 4);
      u32x4 v; v.x = pk2(a[0] * rs * g0[0], a[1] * rs * g0[1]); v.y = pk2(a[2] * rs * g0[2], a[3] * rs * g0[3]); v.z = pk2(b[0] * rs * g1[0], b[1] * rs * g1[1]); v.w = pk2(b[2] * rs * g1[2], b[3] * rs * g1[3]);
      *(u32x4*)(Ow + (long)row * op + ch * 8) = v; }
  }
  asm volatile("s_waitcnt lgkmcnt(0)\n\ts_barrier" ::: "memory");
  #undef DMA_K
  #undef DMA_V
  #undef START
  #undef RESC
  #undef ROT
}
#undef SBAR
#undef WAIT_BAR
}
__device__ __forceinline__ void norm2_rows(Frame& F, int l) {
    F.tid = opaque_tid(F.wv); F.lane = F.tid & 63; F.wave = __builtin_amdgcn_readfirstlane(F.tid >> 6);
    const int gw = F.bid * NWAVES + F.wave, NGW = F.G * NWAVES;
    const bool moe = l & 1, last = l == DEPTH - 1; const int li = l >> 1;
    const float* gain = INP(F, I_NFFN) + l * DM;
    const float* wr = INP(F, I_ROUTER) + (size_t)li * DM * NEXP;
    unsigned* cw = F.ctl + CW_MOE + li * NEXP * 64;
    int* TOK = (int*)(F.ws + WS_TOK); float* GWT = (float*)(F.ws + WS_GW);
    LAS int* lcnt = (LAS int*)F.lds;
    LAS int* lbase = lcnt + 8;
    LAS int* nrec = lcnt + 16;
    LAS int* rec_m = lcnt + 32;
    LAS int* rec_e = rec_m + 1024;
    LAS float* rec_g = (LAS float*)(rec_e + 1024);
    f32x4 wreg[16][2];
    if (moe) { __syncthreads(); if (F.tid < 17) lcnt[F.tid] = 0; __syncthreads();
#pragma unroll
        for (int j = 0; j < 4; ++j)
#pragma unroll
            for (int q = 0; q < 4; ++q) { const int col = 4 * F.lane + 256 * j + q; wreg[4 * j + q][0] = *(const f32x4*)(wr + (size_t)col * NEXP); wreg[4 * j + q][1] = *(const f32x4*)(wr + (size_t)col * NEXP + 4); } }
    f32x4 cur[4], nxt[4], nx2[4]; load_xrow(F, gw, 0, cur); load_xrow(F, (gw + NGW < MT) ? gw + NGW : gw, 0, nxt);
    for (int m = gw; m < MT; m += NGW) {
        const int mn = (m + 2 * NGW < MT) ? m + 2 * NGW : m;
        float h[16];
        const bool skip = last && (m % TB) >= SEQ;
        if (!skip) norm_row(F, l, m, 3, 0, h, true, cur, mn, nx2); else load_xrow(F, mn, 0, nx2);
#pragma unroll
        for (int j = 0; j < 4; ++j) { cur[j] = nxt[j]; nxt[j] = nx2[j]; }
        if (skip) continue;
        if (moe) {
            float lg[NEXP];
#pragma unroll
            for (int e = 0; e < NEXP; ++e) lg[e] = 0.f;
#pragma unroll
            for (int j = 0; j < 4; ++j)
#pragma unroll
                for (int q = 0; q < 4; ++q) { const f32x4 w0 = wreg[4 * j + q][0], w1 = wreg[4 * j + q][1]; const float hv = h[4 * j + q];
                    lg[0] += hv * w0[0]; lg[1] += hv * w0[1]; lg[2] += hv * w0[2]; lg[3] += hv * w0[3]; lg[4] += hv * w1[0]; lg[5] += hv * w1[1]; lg[6] += hv * w1[2]; lg[7] += hv * w1[3]; }
#pragma unroll
            for (int e = 0; e < NEXP; ++e) lg[e] = wave_sum(lg[e]);
            int e1 = 0; float v1 = lg[0];
#pragma unroll
            for (int e = 1; e < NEXP; ++e) if (lg[e] > v1) { v1 = lg[e]; e1 = e; }
            int e2 = -1; float v2 = -INFINITY;
#pragma unroll
            for (int e = 0; e < NEXP; ++e) if (e != e1 && lg[e] > v2) { v2 = lg[e]; e2 = e; }
            const float g1 = 1.0f / (1.0f + __expf(v2 - v1)), g2 = 1.0f - g1;
            if (F.lane < 2) { const int e = F.lane ? e2 : e1; const float g = F.lane ? g2 : g1;
                const int rank = __hip_atomic_fetch_add(lcnt + e, 1, __ATOMIC_RELAXED, __HIP_MEMORY_SCOPE_WORKGROUP);
                const int slot = __hip_atomic_fetch_add(nrec, 1, __ATOMIC_RELAXED, __HIP_MEMORY_SCOPE_WORKGROUP);
                rec_m[slot] = (int)((unsigned)m | ((unsigned)F.lane << 31)); rec_e[slot] = (e << 16) | rank; rec_g[slot] = g; }
        }
    }
    if (moe) {
        __syncthreads();
        if (F.tid < NEXP) lbase[F.tid] = (int)__hip_atomic_fetch_add(cw + F.tid * 64, (unsigned)lcnt[F.tid], RLX_AGENT);
        __syncthreads();
        const int n = nrec[0];
        for (int i = F.tid; i < n; i += NTHR) { const int er = rec_e[i], e = er >> 16, pos = lbase[e] + (er & 0xffff);
            TOK[(size_t)e * MT + pos] = rec_m[i]; GWT[(size_t)e * MT + pos] = rec_g[i]; }
        __syncthreads();
    }
}
__device__ __forceinline__ void final_rows(Frame& F) {
    F.tid = opaque_tid(F.wv); F.lane = F.tid & 63; F.wave = __builtin_amdgcn_readfirstlane(F.tid >> 6);
    const int gw = F.bid * NWAVES + F.wave, NGW = F.G * NWAVES; const int l = DEPTH - 1;
    const float* MODS = (const float*)(F.ws + WS_MODS);
    for (int i = gw; i < NB * SEQ; i += NGW) { const int b = i / SEQ, t = i - b * SEQ; const int m = b * TB + t;
        GAS f32x4* xr = (GAS f32x4*)(F.out + (size_t)i * DM) + F.lane;
        const bf16_t* sl = (const bf16_t*)(F.ws + WS_SLOT) + (size_t)m * 2 * DM; const float* m5 = MODS + ((size_t)l * 9 + b) * 6144 + 5 * DM;
#pragma unroll
        for (int j = 0; j < 4; ++j) { const int col = 4 * F.lane + 256 * j; f32x4 v = xr[64 * j];
            const u32x2 s0 = *(const u32x2*)(sl + col), s1 = *(const u32x2*)(sl + DM + col); const f32x4 mq = *(const f32x4*)(m5 + col);
            v[0] += mq[0] * (bf_lo(s0.x) + bf_lo(s1.x)); v[1] += mq[1] * (bf_hi(s0.x) + bf_hi(s1.x)); v[2] += mq[2] * (bf_lo(s0.y) + bf_lo(s1.y)); v[3] += mq[3] * (bf_hi(s0.y) + bf_hi(s1.y));
            xr[64 * j] = v; } }
}

struct Args { const float* in[42]; float* out; unsigned char* ws; };

#define PHASE_BEGIN { F.tid = opaque_tid(F.wv); F.lane = F.tid & 63; F.wave = __builtin_amdgcn_readfirstlane(F.tid >> 6); \
    F.ws = (unsigned char*)opaque_ptr(args.ws); F.ctl = (unsigned*)(F.ws + WS_CTL); F.out = (float*)(GAS float*)opaque_ptr(args.out);
#define PHASE_END   { XcdBarrier b2_ = bar; b2_.bar = (unsigned*)opaque_ptr(F.ctl + CW_BAR); unsigned x_ = __builtin_amdgcn_readfirstlane(bar.x); asm volatile("" : "+s"(x_)); b2_.x = x_; xcd_barrier(b2_); } }
template <int l> __device__ __forceinline__ void layer_phases(Frame& F, const Args& args, const XcdBarrier& bar, LAS unsigned* misc, const int vcu, const XMap& X, unsigned char* lds) {
        constexpr bool last = l == DEPTH - 1, moe = l & 1; constexpr int li = l >> 1;

        PHASE_BEGIN
            __syncthreads();
            for (int c = F.bid; c < 256; c += F.G) hyena_filter_unit(F, l, c);
            __syncthreads();
            convert_weights(F, l);
            { const int gw = F.bid * NWAVES + F.wave, NGW = F.G * NWAVES; const float* gain = INP(F, I_NMIX) + l * DM; const int mode = (l == 0) ? 1 : ((l & 1) ? 0 : 2); float h[16];
              f32x4 cur[4], nxt[4], nx2[4]; load_xrow(F, gw, mode, cur); load_xrow(F, (gw + NGW < MT) ? gw + NGW : gw, mode, nxt);
              for (int m = gw; m < MT; m += NGW) { const int mn = (m + 2 * NGW < MT) ? m + 2 * NGW : m;
                  norm_row(F, l, m, 0, mode, h, true, cur, mn, nx2);
#pragma unroll
                  for (int j = 0; j < 4; ++j) { cur[j] = nxt[j]; nxt[j] = nx2[j]; } } }
        PHASE_END
        PHASE_BEGIN
            SchedPlain S; S.init((const bf16_t*)(F.ws + WS_HB), (const bf16_t*)(F.ws + WS_WIN), NPAN, D_IN / 256, DM, F.G, F.bid);
            EpiInProj E{(bf16_t*)(F.ws + WS_UB), (bf16_t*)(F.ws + WS_RB)};
            pg8::gemm_phase<EpiInProj, SchedPlain, false, false>(F.lds, DM, S, E, F.wv);
        PHASE_END
        PHASE_BEGIN
            for (int u = F.bid; u < NB * 68 * 3; u += F.G) hyena_short_unit(F, l, u);
            for (int u = F.bid; u < NB * 136; u += F.G) conformer_unit(F, l, u);
            qk_prep_tables(F);
            qk_prep_items(F, l);
        PHASE_END
        PHASE_BEGIN
            __syncthreads();
            const bf16_t* QG = (const bf16_t*)(F.ws + WS_QG); const bf16_t* KG = (const bf16_t*)(F.ws + WS_KG); const bf16_t* QD = (const bf16_t*)(F.ws + WS_QD); const bf16_t* KD = (const bf16_t*)(F.ws + WS_KD);
            const bf16_t* UB = (const bf16_t*)(F.ws + WS_UB); bf16_t* YB = (bf16_t*)(F.ws + WS_YB);
#pragma unroll 1
            for (int i = 0; i < 3; ++i) {
                int b, hq, kvh, NT; size_t row0, kv0;
                if (i < 2) { const int U = vcu + F.G * i; if (U >= 512) continue; const int pr = U >> 5, w = U & 31; b = pr >> 1; kvh = pr & 1; hq = kvh * 2 + (w >> 4); row0 = (size_t)b * TB + (w & 15) * 256; kv0 = (size_t)b * TB; NT = 68; }
                else { if (last || F.bid >= 32) continue; b = F.bid >> 2; hq = F.bid & 3; kvh = hq >> 1; row0 = (size_t)b * TB + SEQ; kv0 = row0; NT = 4; }
                attn_body::attn_unit<8, 0>(QG + row0 * 256 + hq * 64, 256, KG + kv0 * 128 + kvh * 64, 128, UB + kv0 * UBW + OFF_GQA + 384 + kvh * 64, UBW, NT,
                                           YB + row0 * DM + 512 + hq * 64, DM, (char*)lds, 0.f, nullptr, 0.f, F.wv);
            }
            float lam, post; const float* gsub = INP(F, I_SUBLN) + l * 64;
            { float s1 = 0.f, s2 = 0.f;
              for (int i = 0; i < 32; ++i) { s1 += INP(F, I_LQ1)[l * 32 + i] * INP(F, I_LK1)[l * 32 + i]; s2 += INP(F, I_LQ2)[l * 32 + i] * INP(F, I_LK2)[l * 32 + i]; }
              const float lam_init = 0.8f - 0.6f * expf(-0.3f * (float)l); lam = expf(s1) - expf(s2) + lam_init; post = 1.0f - lam_init; }
#pragma unroll 1
            for (int i = 0; i < 3; ++i) {
                int b, h, NT; size_t row0, kv0;
                if (i < 2) { const int U = vcu + F.G * i; if (U >= 512) continue; const int pr = U >> 4; b = pr >> 2; h = pr & 3; row0 = (size_t)b * TB + (U & 15) * 256; kv0 = (size_t)b * TB; NT = 68; }
                else { if (last || F.bid < 32 || F.bid >= 64) continue; const int u = F.bid - 32; b = u >> 2; h = u & 3; row0 = (size_t)b * TB + SEQ; kv0 = row0; NT = 4; }
                const bf16_t* Vh = UB + kv0 * UBW + OFF_DIFF + 512 + h * 64;
                attn_body::attn_unit<8, 1, 32>(QD + row0 * 256 + (h * 2) * 32, 256, KD + kv0 * 256 + (h * 2) * 32, 256, Vh, UBW, NT, nullptr, 0, (char*)lds, 0.f, nullptr, 0.f, F.wv);
                attn_body::attn_unit<8, 2, 32>(QD + row0 * 256 + (h * 2 + 1) * 32, 256, KD + kv0 * 256 + (h * 2 + 1) * 32, 256, Vh, UBW, NT, YB + row0 * DM + 768 + h * 64, DM, (char*)lds, lam, gsub, post, F.wv);
            }
            if (!last) hyena_ctx_unit(F, l, F.bid);
            __syncthreads();
#pragma unroll 1
            for (int i = 0; i < 2; ++i) { const int U = vcu * 2 + i; if (U < 512) hyena_conv_unit(F, l, U); }
        PHASE_END
        PHASE_BEGIN
            SchedPlain S; S.init((const bf16_t*)(F.ws + WS_YB), (const bf16_t*)(F.ws + WS_WBR), NPAN, 4, DM, F.G, F.bid, last);
            EpiMerge E{(const bf16_t*)(F.ws + WS_RB), (bf16_t*)(F.ws + WS_HB)};
            pg8::gemm_phase<EpiMerge, SchedPlain, false, true>(F.lds, DM, S, E, F.wv);
        PHASE_END
        PHASE_BEGIN
            SchedPlain S; S.init((const bf16_t*)(F.ws + WS_HB), (const bf16_t*)(F.ws + WS_WOUT), NPAN, 4, DM, F.G, F.bid, last);
            EpiResid E{X, (const float*)(F.ws + WS_MODS) + (size_t)l * 9 * 6144 + 2 * DM, last, l == 0 ? INP(F, I_X) : (const float*)X.lat, l == 0 ? INP(F, I_CTX) : (const float*)X.ctx};
            pg8::gemm_phase<EpiResid, SchedPlain, false, false, false>(F.lds, DM, S, E, F.wv);
            if (!last && F.bid >= NPAN * 4 - 2 * F.G) convert_ffn_queue(F, l + 1, 1);
        PHASE_END
        PHASE_BEGIN
            norm2_rows(F, l);
        PHASE_END
        PHASE_BEGIN
            if (!moe) {
                SchedPlain S; S.init((const bf16_t*)(F.ws + WS_HB), (const bf16_t*)(F.ws + WS_WF1), NPAN, 2 * DFF / 256, DM, F.G, F.bid);
                EpiSwiGLU E{(bf16_t*)(F.ws + WS_HID), DFF};
                pg8::gemm_phase<EpiSwiGLU, SchedPlain, false, false>(F.lds, DM, S, E, F.wv);
            } else {
                LAS int* mi = (LAS int*)(misc + 16);
                __syncthreads();
                if (F.tid == 0) moe_info_build(mi, F.ctl + CW_MOE + li * NEXP * 64);
                __syncthreads();
                SchedMoeUp S; S.I.p = mi; S.nN = 2 * DFFE / 256; S.G = F.G; S.c = F.bid; S.A = (const char*)(F.ws + WS_HB); S.W = (const char*)(F.ws + WS_WM13); S.tok = (const int*)(F.ws + WS_TOK);
                S.wstride = (size_t)2 * DFFE * DM * 2; S.tstep = (size_t)256 * DM * 2;
                EpiSwiGLU E{(bf16_t*)(F.ws + WS_HID), DFFE};
                pg8::gemm_phase<EpiSwiGLU, SchedMoeUp, true, false>(F.lds, DM, S, E, F.wv);
            }
        PHASE_END
        PHASE_BEGIN
            int bgq = 0;
            if (!moe) {
                SchedPlain S; S.init((const bf16_t*)(F.ws + WS_HID), (const bf16_t*)(F.ws + WS_WF2), NPAN, 4, DFF, F.G, F.bid);
                EpiResid E{X, (const float*)(F.ws + WS_MODS) + (size_t)l * 9 * 6144 + 5 * DM, last, (const float*)X.lat, (const float*)X.ctx};
                pg8::gemm_phase<EpiResid, SchedPlain, false, false, false>(F.lds, DFF, S, E, F.wv);
                if (!last && F.bid >= NPAN * 4 - 2 * F.G) bgq = 2;
            } else {
                LAS int* mi = (LAS int*)(misc + 16);
                __syncthreads();
                if (F.tid == 0) moe_info_build(mi, F.ctl + CW_MOE + li * NEXP * 64);
                __syncthreads();
                SchedMoeDown S; S.I.p = mi; S.nN = 4; S.G = F.G; S.c = F.bid; S.A = (const char*)(F.ws + WS_HID); S.W = (const char*)(F.ws + WS_WM2);
                S.wstride = (size_t)DM * DFFE * 2; S.tstepA = (size_t)256 * DFFE * 2; S.tstepB = (size_t)256 * DFFE * 2;
                MoeInfo I2; I2.p = mi;
                EpiMoeDown E{&I2, (const int*)(F.ws + WS_TOK), (const float*)(F.ws + WS_GW), (bf16_t*)(F.ws + WS_SLOT)};
                pg8::gemm_phase<EpiMoeDown, SchedMoeDown, false, false>(F.lds, DFFE, S, E, F.wv);
                if (!last) { const int n = mi[16] * 4; const int rounds = (n + F.G - 1) / F.G; if (F.bid >= n - (rounds - 1) * F.G) bgq = 2; }
            }
            if (bgq) convert_ffn_queue(F, l + 1, bgq);
        PHASE_END
    }
__global__ void __launch_bounds__(NTHR, 2) mk_fwd(Args args) {
    extern __shared__ __attribute__((aligned(16))) unsigned char lds[];
    Frame F;
    F.lds = (LAS unsigned char*)lds; F.tid = threadIdx.x; F.lane = F.tid & 63; F.wave = __builtin_amdgcn_readfirstlane(F.tid >> 6); F.wv = F.wave;
    F.G = gridDim.x; F.bid = blockIdx.x; F.in = args.in; F.ws = args.ws; F.out = args.out; F.ctl = (unsigned*)(args.ws + WS_CTL);
    LAS unsigned* misc = (LAS unsigned*)(F.lds + MISC_OFF);
    if (F.tid < 64) misc[F.tid] = 0u;
    __syncthreads();
    XcdBarrier bar = xcd_barrier_post(F.ctl + CW_BAR, (volatile LAS unsigned*)(misc + 8));
    const int vcu = (F.G % 8 == 0) ? (F.bid % 8) * (F.G / 8) + F.bid / 8 : F.bid;
    XMap X{F.out, (float*)(F.ws + WS_XC)};

    PHASE_BEGIN
        p0_mods(F); p0_a3(F); p0_zero_rows(F);
    PHASE_END

    layer_phases<0>(F, args, bar, misc, vcu, X, lds); layer_phases<1>(F, args, bar, misc, vcu, X, lds); layer_phases<2>(F, args, bar, misc, vcu, X, lds); layer_phases<3>(F, args, bar, misc, vcu, X, lds);
    { F.tid = opaque_tid(F.wv); F.lane = F.tid & 63; F.wave = __builtin_amdgcn_readfirstlane(F.tid >> 6);
      final_rows(F); }
#undef PHASE_BEGIN
#undef PHASE_END
}

extern "C" void kernel_launch(void* const* d_in, const int* in_sizes, int n_in, void* d_out, int out_size, void* d_ws, size_t ws_size, hipStream_t stream) {
    static int grid = 0;
    if (grid == 0) {
        if (n_in != 42 || in_sizes[0] != NB * SEQ * DM || out_size != NB * SEQ * DM || ws_size < WS_END) { fprintf(stderr, "kernel_launch: unexpected shapes (n_in %d, ws %zu)\n", n_in, ws_size); grid = -1; return; }
        int dev = 0, cus = 0;
        if (hipGetDevice(&dev) != hipSuccess || hipDeviceGetAttribute(&cus, hipDeviceAttributeMultiprocessorCount, dev) != hipSuccess) { grid = -1; return; }
        if (hipFuncSetAttribute((const void*)mk_fwd, hipFuncAttributeMaxDynamicSharedMemorySize, LDS_BYTES) != hipSuccess) { fprintf(stderr, "kernel_launch: hipFuncSetAttribute failed\n"); grid = -1; return; }
        int per_cu = 0;
        if (hipOccupancyMaxActiveBlocksPerMultiprocessor(&per_cu, (const void*)mk_fwd, NTHR, LDS_BYTES) != hipSuccess || per_cu < 1) fprintf(stderr, "kernel_launch: occupancy query reports %d\n", per_cu);
        (void)hipGetLastError();
        if (cus < 256) { fprintf(stderr, "kernel_launch: built for a 256-CU device (one resident workgroup per CU), found %d\n", cus); grid = -1; return; }
        grid = 256;
    }
    if (grid < 0) return;
    if (hipMemsetAsync((char*)d_ws + WS_CTL, 0, CTL_ZERO_BYTES, stream) != hipSuccess) return;
    Args a{};
    for (int i = 0; i < 42; ++i) a.in[i] = (const float*)d_in[i];
    a.out = (float*)d_out; a.ws = (unsigned char*)d_ws;
    hipLaunchKernelGGL(mk_fwd, dim3(grid), dim3(NTHR), LDS_BYTES, stream, a);
}
```

```cpp
#include <hip/hip_runtime.h>
#include <hip/hip_bf16.h>
#include <cstdio>
#include <cstdint>
#include <cmath>

#define GAS __attribute__((address_space(1)))
#define LAS __attribute__((address_space(3)))
typedef unsigned short bf16_t;
typedef short bf16x8 __attribute__((ext_vector_type(8)));
typedef float f32x4 __attribute__((ext_vector_type(4)));
typedef float f32x2 __attribute__((ext_vector_type(2)));
typedef float f32x16 __attribute__((ext_vector_type(16)));
typedef unsigned u32x4 __attribute__((ext_vector_type(4)));
typedef unsigned u32x2 __attribute__((ext_vector_type(2)));
typedef short s16x4 __attribute__((ext_vector_type(4)));
#define RLX_AGENT __ATOMIC_RELAXED, __HIP_MEMORY_SCOPE_AGENT
#define LDS_WAIT() asm volatile("s_waitcnt lgkmcnt(0)" ::: "memory")
#define VM_WAIT() asm volatile("s_waitcnt vmcnt(0)" ::: "memory")

constexpr int DM = 1024, NB = 8, SEQ = 4096, NCTX = 256, DEPTH = 4;
constexpr int TB = SEQ + NCTX;
constexpr int MT = NB * TB;
constexpr int UBW = 2560;
constexpr int OFF_CF = 768, OFF_GQA = 1280, OFF_DIFF = 1792, OFF_GATE = 2560, D_IN = 6656;
constexpr int DFF = 2816, DFFE = 3584, NEXP = 8;
constexpr int NPAN = MT / 256;
constexpr float EPS = 1e-6f;
constexpr float LOG2E = 1.4426950408889634f;

constexpr size_t MiB = 1u << 20;
constexpr size_t WS_CTL = 0, CTL_ZERO_BYTES = 65536;
constexpr size_t WS_MODS = 1 * MiB;
constexpr size_t WS_A3 = 2 * MiB;
constexpr size_t WS_XC = 8 * MiB;
constexpr size_t WS_HB = 16 * MiB;
constexpr size_t WS_UB = 86 * MiB;
constexpr size_t WS_RB = 256 * MiB;
constexpr size_t WS_YB = 528 * MiB;
constexpr size_t WS_QG = 596 * MiB;
constexpr size_t WS_KG = 613 * MiB;
constexpr size_t WS_QD = 622 * MiB;
constexpr size_t WS_KD = 656 * MiB;
constexpr size_t WS_HT = 690 * MiB;
constexpr size_t WS_KF = 744 * MiB;
constexpr size_t WS_KC = 776 * MiB;
constexpr size_t WS_WIN = 778 * MiB;
constexpr size_t WS_WBR = 791 * MiB;
constexpr size_t WS_WOUT = 793 * MiB;
constexpr size_t WS_WF1 = 795 * MiB;
constexpr size_t WS_WF2 = 806 * MiB;
constexpr size_t WS_WM13 = 812 * MiB;
constexpr size_t WS_WM2 = 924 * MiB;
constexpr size_t WS_TOK = 980 * MiB;
constexpr size_t WS_GW = 982 * MiB;
constexpr size_t WS_END = 984 * MiB;
constexpr size_t WS_HID = WS_UB;
constexpr size_t WS_SLOT = 576 * MiB;
constexpr int CW_TMO = 0, CW_BAR = 4096, CW_MOE = 8192, CW_Q = 12288;

constexpr int LDS_BYTES = 163840, MISC_OFF = LDS_BYTES - 256;
constexpr int NWAVES = 8, NTHR = 512;

__device__ __forceinline__ unsigned f2bf(float f) { unsigned u = __builtin_bit_cast(unsigned, f); return (u + 0x7fffu + ((u >> 16) & 1u)) >> 16; }
__device__ __forceinline__ unsigned pk2(float lo, float hi) { return f2bf(lo) | (f2bf(hi) << 16); }
typedef __bf16 bf16x2_v __attribute__((ext_vector_type(2)));
__device__ __forceinline__ unsigned cvt_pk_bf16(float lo, float hi) { f32x2 v = {lo, hi}; bf16x2_v b = __builtin_convertvector(v, bf16x2_v); return __builtin_bit_cast(unsigned, b); }
__device__ __forceinline__ float bf_lo(unsigned w) { return __uint_as_float(w << 16); }
__device__ __forceinline__ float bf_hi(unsigned w) { return __uint_as_float(w & 0xffff0000u); }
__device__ __forceinline__ float bf2f(bf16_t b) { return __uint_as_float(((unsigned)b) << 16); }
template <int N> __device__ __forceinline__ float dpp_row_ror(float v) { return __builtin_bit_cast(float, __builtin_amdgcn_update_dpp(0, __builtin_bit_cast(int, v), 0x120 + N, 0xf, 0xf, false)); }
__device__ __forceinline__ float wave_sum(float v) {
    v += dpp_row_ror<1>(v); v += dpp_row_ror<2>(v); v += dpp_row_ror<4>(v); v += dpp_row_ror<8>(v);
    const int iv = __builtin_bit_cast(int, v);
    const float a = __builtin_bit_cast(float, __builtin_amdgcn_readlane(iv, 0)), b = __builtin_bit_cast(float, __builtin_amdgcn_readlane(iv, 16));
    const float c = __builtin_bit_cast(float, __builtin_amdgcn_readlane(iv, 32)), d = __builtin_bit_cast(float, __builtin_amdgcn_readlane(iv, 48));
    return (a + b) + (c + d);
}
__device__ __forceinline__ int opaque_tid(int wv) { int ln; asm volatile("v_mbcnt_lo_u32_b32 %0, -1, 0\n\tv_mbcnt_hi_u32_b32 %0, -1, %0" : "=v"(ln)); return wv * 64 + ln; }
__device__ __forceinline__ GAS unsigned char* opaque_ptr(const void* p) { const unsigned long long v = (unsigned long long)p; unsigned lo = __builtin_amdgcn_readfirstlane((unsigned)v), hi = __builtin_amdgcn_readfirstlane((unsigned)(v >> 32));
    asm volatile("" : "+s"(lo), "+s"(hi)); return (GAS unsigned char*)(((unsigned long long)hi << 32) | lo); }
#define INP(F, i) ((const float*)(const GAS float*)((F).in[i]))
__device__ __forceinline__ float fast_sigmoid(float x) { return __builtin_amdgcn_rcpf(1.0f + __builtin_amdgcn_exp2f(-x * LOG2E)); }

#define XB_TMO      128
#define XB_XCNT(j)  (256  + 64 * (j))
#define XB_XSUB(j)  (1280 + 64 * (j))
#define XB_XGEN(j)  (2304 + 64 * (j))
#define XB_TOP      3328
#define XB_TOPGEN   3392
#define XCD_BAR_WORDS 3456
#define XB_SPIN_CAP (1u << 18)
__device__ __forceinline__ unsigned xb_ld(unsigned* p)              { return __hip_atomic_load(p, __ATOMIC_RELAXED, __HIP_MEMORY_SCOPE_AGENT); }
__device__ __forceinline__ unsigned xb_add(unsigned* p, unsigned v) { return __hip_atomic_fetch_add(p, v, __ATOMIC_RELAXED, __HIP_MEMORY_SCOPE_AGENT); }
__device__ __forceinline__ unsigned xb_xcc_id() { return (unsigned)__builtin_amdgcn_s_getreg((3 << 11) | 20) & 0xFu; }
#define XB_SPIN(cond, bar) do { unsigned _sp = 0; while (cond) { __builtin_amdgcn_s_sleep(1); \
    if ((++_sp & 255u) == 0u) { if (xb_ld(&(bar)[XB_TMO])) break; if (_sp > XB_SPIN_CAP) { atomicAdd(&(bar)[XB_TMO], 1u); break; } } } } while (0)
struct XcdBarrier { unsigned* bar; unsigned x; volatile LAS unsigned* st; };
__device__ __forceinline__ XcdBarrier xcd_barrier_post(unsigned* bar, volatile LAS unsigned* st) {
    XcdBarrier b; b.bar = bar; b.x = xb_xcc_id(); b.st = st;
    if (threadIdx.x == 0) (void)xb_add(&bar[XB_XCNT(b.x)], 1u);
    return b;
}
__device__ __forceinline__ void xcd_barrier_complete(unsigned* bar, unsigned x, unsigned& nloc, unsigned& nx) {
    const unsigned G = gridDim.x * gridDim.y * gridDim.z;
    unsigned sum, cnt, mine, sp = 0u;
    for (;;) {
        sum = 0u; cnt = 0u; mine = 0u;
#pragma unroll
        for (unsigned j = 0; j < 16; ++j) { const unsigned c = xb_ld(&bar[XB_XCNT(j)]); sum += c; cnt += (c > 0u) ? 1u : 0u; mine = (j == x) ? c : mine; }
        if (sum == G) break;
        __builtin_amdgcn_s_sleep(1);
        if ((++sp & 255u) == 0u) { if (xb_ld(&bar[XB_TMO])) break; if (sp > XB_SPIN_CAP) { atomicAdd(&bar[XB_TMO], 1u); break; } }
    }
    nloc = mine > 0u ? mine : 1u; nx = cnt > 0u ? cnt : 1u;
}
__device__ __forceinline__ void xcd_barrier(const XcdBarrier& b) {
    asm volatile("s_waitcnt vmcnt(0)" ::: "memory");
    __syncthreads();
    if (threadIdx.x == 0) {
        unsigned* bar = b.bar;
        __builtin_amdgcn_s_waitcnt(0);
        unsigned nloc = b.st[0], nx = b.st[1];
        if (nloc == 0u) { xcd_barrier_complete(bar, b.x, nloc, nx); b.st[0] = nloc; b.st[1] = nx; }
        const unsigned old = xb_add(&bar[XB_XSUB(b.x)], 1u);
        const unsigned gen = old / nloc;
        if (old + 1u == (gen + 1u) * nloc) {
            __builtin_amdgcn_fence(__ATOMIC_RELEASE, "agent");
            asm volatile("s_waitcnt vmcnt(0)" ::: "memory");
            const unsigned og = xb_add(&bar[XB_TOP], 1u);
            const unsigned tg = og / nx;
            if (og + 1u == (tg + 1u) * nx) xb_add(&bar[XB_TOPGEN], 1u);
            else XB_SPIN(xb_ld(&bar[XB_TOPGEN]) == tg, bar);
            __builtin_amdgcn_fence(__ATOMIC_ACQUIRE, "agent");
            xb_add(&bar[XB_XGEN(b.x)], 1u);
            asm volatile("s_waitcnt vmcnt(0)" ::: "memory");
        } else {
            XB_SPIN(xb_ld(&bar[XB_XGEN(b.x)]) == gen, bar);
            __builtin_amdgcn_fence(__ATOMIC_ACQUIRE, "agent");
            asm volatile("s_waitcnt vmcnt(0)" ::: "memory");
        }
    }
    __syncthreads();
}

namespace pg8 {
constexpr int BM = 256, BK = 64, HALF = 128, HTB = HALF * BK * 2, STAGE_BYTES = 8 * HTB, NXCD = 8, WGM = 8;
__host__ __device__ __forceinline__ int lds_byte(int r, int c) { const int st = (r >> 4) * 2 + (c >> 5), rr = r & 15, cc = c & 31, ob = rr * 64 + cc * 2; return st * 1024 + (ob ^ (((ob >> 9) & 1) << 5)); }
__host__ __device__ __forceinline__ void stage_rc(int b, int& R, int& C) { const int st = b / 1024, sb = b % 1024, swz = sb ^ (((sb >> 9) & 1) << 5); R = (st >> 1) * 16 + swz / 64; C = (st & 1) * 32 + (swz % 64) / 2; }
__host__ __device__ __forceinline__ int perm32(int rho) { const int n = rho >> 4, i = rho & 15; return 8 * (i >> 2) + 4 * n + (i & 3); }

struct Unit { int pm, pn; const char* a; const char* b; int aux; };

struct GridOrder {
    int nM, nN, nwg, G, c;
    __device__ void init(int nM_, int nN_, int G_, int c_) { nM = nM_; nN = nN_; nwg = nM * nN; G = G_; c = c_; }
    __device__ __forceinline__ bool tile(int i, int& pm, int& pn) const {
        const long L = (long)i * G + c; if (L >= nwg) return false;
        int wgid = (int)L; { const int q = nwg / NXCD, r = nwg % NXCD, xcd = wgid % NXCD, off = wgid / NXCD; wgid = (xcd < r ? xcd * (q + 1) : r * (q + 1) + (xcd - r) * q) + off; }
        const int nig = WGM * nN, gid = wgid / nig, fm = gid * WGM, gsz = (nM - fm) < WGM ? (nM - fm) : WGM;
        pm = fm + ((wgid % nig) % gsz); pn = (wgid % nig) / gsz; return true;
    }
};

template <class Epi, class Sched, bool GATHER = false, bool HOOK = false, bool ALIGN = true>
__device__ __forceinline__ void gemm_phase(LAS unsigned char* lds, const int K, const Sched& S, const Epi& E, const int wv) {
    const int tid = opaque_tid(wv), wid = __builtin_amdgcn_readfirstlane(tid >> 6), lane = tid & 63, wr = wid >> 2, wc = wid & 3, fr = lane & 15, fq = lane >> 4;
    const int nt = K / BK;
    unsigned voffB[2], vA0[2], vA1[2], nA0[2], nA1[2];
#pragma unroll
    for (int i = 0; i < 2; ++i) { int R, C; stage_rc(tid * 16 + i * 8192, R, C); const int Rb = Epi::PERM ? ((R & ~31) + perm32(R & 31)) : R;
        vA0[i] = (unsigned)(R * K + C) * 2u; vA1[i] = 0u; voffB[i] = (unsigned)(Rb * K + C) * 2u; nA0[i] = 0u; nA1[i] = 0u; }
#define PG8_RR(i) ((((wid + 8 * (i)) >> 1) << 4) + (lane >> 2))
    const size_t kstep = (size_t)(BK * 2);
    const size_t hstep = (size_t)HALF * K * 2;
    const unsigned ldsw = (unsigned)wid * 1024u;
    const int aoff = lds_byte(wr * 64 + fr, fq * 8), boff = lds_byte(wc * 32 + fr, fq * 8);
#define PG8_SA(b, h) (((b) * 2 + (h)) * HTB)
#define PG8_SB(b, h) ((4 + (b) * 2 + (h)) * HTB)
#define PG8_STAGE(bufoff, gbase, voff) do { _Pragma("unroll") for (int _i = 0; _i < 2; ++_i) \
        __builtin_amdgcn_global_load_lds((const unsigned*)((const char*)(gbase) + (voff)[_i]), (LAS unsigned*)(lds + (bufoff) + ldsw + _i * 8192), 16, 0, 0); } while (0)
#define PG8_LDA(dst, b, h) do { _Pragma("unroll") for (int m = 0; m < 4; ++m) _Pragma("unroll") for (int k = 0; k < 2; ++k) dst[m][k] = *(const LAS bf16x8*)(lds + PG8_SA(b, h) + aoff + m * 2048 + k * 1024); } while (0)
#define PG8_LDB(dst, b, h) do { _Pragma("unroll") for (int n = 0; n < 2; ++n) _Pragma("unroll") for (int k = 0; k < 2; ++k) dst[n][k] = *(const LAS bf16x8*)(lds + PG8_SB(b, h) + boff + n * 2048 + k * 1024); } while (0)
#define PG8_MMA(ai, bj, At, Bt) do { __builtin_amdgcn_s_setprio(1); _Pragma("unroll") for (int m = 0; m < 4; ++m) _Pragma("unroll") for (int n = 0; n < 2; ++n) _Pragma("unroll") for (int k = 0; k < 2; ++k) \
        acc[ai][bj][m][n] = __builtin_amdgcn_mfma_f32_16x16x32_bf16(Bt[n][k], At[m][k], acc[ai][bj][m][n], 0, 0, 0); __builtin_amdgcn_s_setprio(0); } while (0)
#define PG8_WAIT_V(n) asm volatile("s_waitcnt vmcnt(" #n ")" ::: "memory")
#define PG8_WAIT_L(n) asm volatile("s_waitcnt lgkmcnt(" #n ")" ::: "memory")
#define PG8_BAR __builtin_amdgcn_s_barrier()
#define PG8_SCHED __builtin_amdgcn_sched_barrier(0)
    Unit cur, nxt; int ui = 0;
    if (!S.next(0, cur)) return;
    f32x4 acc[2][2][4][2];
#pragma unroll
    for (int a = 0; a < 2; ++a)
#pragma unroll
        for (int b = 0; b < 2; ++b)
#pragma unroll
            for (int m = 0; m < 4; ++m)
#pragma unroll
                for (int n = 0; n < 2; ++n) acc[a][b][m][n] = (f32x4){0.f, 0.f, 0.f, 0.f};
    bf16x8 At[4][2], B0[2][2], B1[2][2];
    const char* cA0 = cur.a; const char* cA1 = GATHER ? cur.a : cur.a + hstep; const char* cB = cur.b;
    unsigned ccol[2] = {0u, 0u};
    if constexpr (GATHER) {
#pragma unroll
        for (int i = 0; i < 2; ++i) { ccol[i] = vA0[i] - (unsigned)(PG8_RR(i) * K) * 2u; vA0[i] = S.row_off(cur, PG8_RR(i)) + ccol[i]; vA1[i] = S.row_off(cur, PG8_RR(i) + HALF) + ccol[i]; }
    }
    PG8_STAGE(PG8_SB(0, 0), cB, voffB); PG8_STAGE(PG8_SB(0, 1), cB + hstep, voffB); PG8_STAGE(PG8_SA(0, 0), cA0, vA0); if constexpr (GATHER) { PG8_STAGE(PG8_SA(0, 1), cA1, vA1); } else { PG8_STAGE(PG8_SA(0, 1), cA1, vA0); }
    if (wr == 1) PG8_BAR;
    PG8_WAIT_V(2); PG8_BAR;
    PG8_STAGE(PG8_SB(1, 0), cB + kstep, voffB); PG8_STAGE(PG8_SA(1, 0), cA0 + kstep, vA0); PG8_STAGE(PG8_SB(1, 1), cB + hstep + kstep, voffB);
    PG8_WAIT_V(6); PG8_BAR;
    for (;;) {
        const bool has_next = S.next(ui + 1, nxt);
        const char* nAp0 = has_next ? nxt.a : cA0; const char* nAp1 = has_next ? (GATHER ? nxt.a : nxt.a + hstep) : cA1; const char* nB = has_next ? nxt.b : cB;
        if constexpr (GATHER) {
            if (has_next) {
#pragma unroll
                for (int i = 0; i < 2; ++i) { nA0[i] = S.row_off(nxt, PG8_RR(i)) + ccol[i]; nA1[i] = S.row_off(nxt, PG8_RR(i) + HALF) + ccol[i]; }
            } else {
#pragma unroll
                for (int i = 0; i < 2; ++i) { nA0[i] = vA0[i]; nA1[i] = vA1[i]; }
            }
        }
        for (int t = 0; t < nt; t += 2) {
            const bool last = (t == nt - 2);
            const char* a1h1 = cA1 + (size_t)(t + 1) * kstep;
            const char* a2h0 = last ? nAp0 : cA0 + (size_t)(t + 2) * kstep; const char* a2h1 = last ? nAp1 : cA1 + (size_t)(t + 2) * kstep;
            const char* b2 = last ? nB : cB + (size_t)(t + 2) * kstep;
            const char* a3h0 = a2h0 + kstep; const char* b3 = b2 + kstep;
            unsigned w0[2], w1[2], u1[2];
#pragma unroll
            for (int i = 0; i < 2; ++i) { if constexpr (GATHER) { w0[i] = last ? nA0[i] : vA0[i]; w1[i] = last ? nA1[i] : vA1[i]; u1[i] = vA1[i]; } else { w0[i] = vA0[i]; w1[i] = vA0[i]; u1[i] = vA0[i]; } }
            PG8_LDB(B0, 0, 0); PG8_LDB(B1, 0, 1); PG8_SCHED; PG8_LDA(At, 0, 0); PG8_STAGE(PG8_SA(1, 1), a1h1, u1);
            PG8_WAIT_V(8); PG8_WAIT_L(0); PG8_BAR; PG8_MMA(0, 0, At, B0); PG8_MMA(0, 1, At, B1); PG8_BAR; PG8_SCHED;
            PG8_LDA(At, 0, 1); PG8_STAGE(PG8_SB(0, 0), b2, voffB); PG8_STAGE(PG8_SB(0, 1), b2 + hstep, voffB); PG8_STAGE(PG8_SA(0, 0), a2h0, w0);
            PG8_WAIT_V(8); PG8_WAIT_L(0); PG8_BAR; PG8_MMA(1, 0, At, B0); PG8_MMA(1, 1, At, B1); PG8_BAR; PG8_SCHED;
            PG8_LDB(B0, 1, 0); PG8_LDB(B1, 1, 1); PG8_SCHED; PG8_LDA(At, 1, 0); PG8_STAGE(PG8_SA(0, 1), a2h1, w1);
            PG8_WAIT_V(8); PG8_WAIT_L(0); PG8_BAR; PG8_MMA(0, 0, At, B0); PG8_MMA(0, 1, At, B1); PG8_BAR; PG8_SCHED;
            PG8_LDA(At, 1, 1); PG8_STAGE(PG8_SB(1, 0), b3, voffB); PG8_STAGE(PG8_SB(1, 1), b3 + hstep, voffB); PG8_STAGE(PG8_SA(1, 0), a3h0, w0);
            PG8_WAIT_V(8); PG8_WAIT_L(0); PG8_BAR; PG8_MMA(1, 0, At, B0); PG8_MMA(1, 1, At, B1); PG8_BAR; PG8_SCHED;
            if constexpr (HOOK) { if ((t & 2) && !last) E.hook(acc, cur, t >> 2, wr, wc, fr, fq); }
        }
        if constexpr (ALIGN) { if (wr == 0) PG8_BAR; }
        E(acc, cur, wr, wc, fr, fq);
        if (!has_next) break;
#pragma unroll
        for (int a = 0; a < 2; ++a)
#pragma unroll
            for (int b = 0; b < 2; ++b)
#pragma unroll
                for (int m = 0; m < 4; ++m)
#pragma unroll
                    for (int n = 0; n < 2; ++n) acc[a][b][m][n] = (f32x4){0.f, 0.f, 0.f, 0.f};
        cur = nxt; cA0 = nAp0; cA1 = nAp1; cB = nB; ++ui;
        if constexpr (GATHER) {
#pragma unroll
            for (int i = 0; i < 2; ++i) { vA0[i] = nA0[i]; vA1[i] = nA1[i]; }
        }
        if constexpr (ALIGN) { if (wr == 1) PG8_BAR; }
    }
    PG8_WAIT_V(0);
    if constexpr (!ALIGN) { if (wr == 0) PG8_BAR; }
    PG8_BAR;
#undef PG8_RR
#undef PG8_SA
#undef PG8_SB
#undef PG8_STAGE
#undef PG8_LDA
#undef PG8_LDB
#undef PG8_MMA
#undef PG8_WAIT_V
#undef PG8_WAIT_L
#undef PG8_BAR
#undef PG8_SCHED
}
}
struct XMap { float* lat; float* ctx; };
__device__ __forceinline__ float* xrow(const XMap& X, int m) { const int b = m / TB, t = m - b * TB; return t < SEQ ? X.lat + ((size_t)b * SEQ + t) * DM : X.ctx + ((size_t)b * NCTX + (t - SEQ)) * DM; }
__device__ __forceinline__ int modrow(int m) { const int b = m / TB, t = m - b * TB; return t < SEQ ? b : NB; }

struct SchedPlain {
    pg8::GridOrder O; const char* A; const char* Bt; size_t tstep; bool lat_only;
    __device__ void init(const bf16_t* A_, const bf16_t* Bt_, int nM, int nN, int K, int G, int c, bool lat_only_ = false) { lat_only = lat_only_; O.init(lat_only ? nM - nM / 17 : nM, nN, G, c); A = (const char*)A_; Bt = (const char*)Bt_; tstep = (size_t)256 * K * 2; }
    __device__ __forceinline__ bool next(int i, pg8::Unit& u) const { int pm, pn; if (!O.tile(i, pm, pn)) return false; if (lat_only) pm += pm >> 4; u.pm = pm; u.pn = pn; u.a = A + (size_t)pm * tstep; u.b = Bt + (size_t)pn * tstep; u.aux = 0; return true; }
    __device__ __forceinline__ unsigned row_off(const pg8::Unit&, int) const { return 0u; }
};
struct MoeInfo { const LAS int* p; };
__device__ __forceinline__ void moe_info_build(LAS int* p, const unsigned* cw) {
    int s = 0;
    for (int e = 0; e < NEXP; ++e) { const int c = (int)__hip_atomic_load(cw + e * 64, RLX_AGENT); p[e] = c; p[8 + e] = s; s += (c + 255) >> 8; }
    p[16] = s;
}
__device__ __forceinline__ int moe_expert_of(const MoeInfo& I, int blk) { int e = 0;
#pragma unroll
    for (int j = 1; j < NEXP; ++j) e += (blk >= I.p[8 + j]) ? 1 : 0;
    return e; }
struct SchedMoeUp {
    MoeInfo I; int nN, G, c; const char* A; const char* W; const int* tok; size_t wstride, tstep;
    __device__ __forceinline__ bool next(int i, pg8::Unit& u) const {
        const int nblk = I.p[16]; const long total = (long)nblk * nN;
        long L;
        if (G % 8 == 0) { const int per_x = G / 8; L = ((long)i * 8 + (c & 7)) * per_x + (c >> 3); } else L = (long)i * G + c;
        if (L >= total) return false;
        const int tsz = 4 * nN; const int t4 = (int)(L / tsz), q = (int)(L % tsz); const int b0 = t4 * 4, rb = (nblk - b0) < 4 ? (nblk - b0) : 4;
        const int blk = b0 + q % rb, pn = q / rb;
        const int e = moe_expert_of(I, blk);
        u.pm = blk; u.pn = pn; u.a = A; u.b = W + (size_t)e * wstride + (size_t)pn * tstep; u.aux = e * MT + (blk - I.p[8 + e]) * 256; return true;
    }
    __device__ __forceinline__ unsigned row_off(const pg8::Unit& u, int r) const {
        const int e = u.aux / MT, j0 = u.aux - e * MT; const int valid = I.p[e] - j0;
        int row = MT;
        if (r < valid) row = tok[u.aux + r] & 0x7fffffff;
        return (unsigned)row * (unsigned)(DM * 2);
    }
};
struct SchedMoeDown {
    MoeInfo I; int nN, G, c; const char* A; const char* W; size_t wstride, tstepA, tstepB;
    __device__ __forceinline__ bool next(int i, pg8::Unit& u) const {
        const long L = (long)i * G + c; const int nblk = I.p[16]; if (L >= (long)nblk * nN) return false;
        const int per = 8 * nN; const int g = (int)(L / per), r = (int)(L % per); const int g0 = g * 8, gsz = (nblk - g0) < 8 ? (nblk - g0) : 8;
        const int blk = g0 + r % gsz, pn = r / gsz;
        const int e = moe_expert_of(I, blk);
        u.pm = blk; u.pn = pn; u.a = A + (size_t)blk * tstepA; u.b = W + (size_t)e * wstride + (size_t)pn * tstepB; u.aux = e * MT + (blk - I.p[8 + e]) * 256; return true;
    }
    __device__ __forceinline__ unsigned row_off(const pg8::Unit&, int) const { return 0u; }
};

typedef f32x4 acc_t[2][2][4][2];

struct EpiInProj {
    static constexpr bool PERM = true;
    bf16_t* UB; bf16_t* RB;
    __device__ __forceinline__ void operator()(const acc_t& acc, const pg8::Unit& u, int wr, int wc, int fr, int fq) const {
        const int row0 = u.pm * 256 + wr * 64 + fr;
        if (u.pn < 10) {
            const int col0 = u.pn * 256 + wc * 32 + 8 * fq;
#pragma unroll
            for (int ai = 0; ai < 2; ++ai)
#pragma unroll
                for (int m = 0; m < 4; ++m) { bf16_t* rowp = UB + (size_t)(row0 + ai * 128 + m * 16) * UBW + col0;
#pragma unroll
                    for (int bj = 0; bj < 2; ++bj) { const f32x4 v0 = acc[ai][bj][m][0], v1 = acc[ai][bj][m][1];
                        u32x4 w; w.x = cvt_pk_bf16(v0[0], v0[1]); w.y = cvt_pk_bf16(v0[2], v0[3]); w.z = cvt_pk_bf16(v1[0], v1[1]); w.w = cvt_pk_bf16(v1[2], v1[3]);
                        *(u32x4*)(rowp + bj * 128) = w; } }
        } else {
            const int ch0 = (u.pn - 10) * 64 + wc * 16 + fq * 4;
#pragma unroll
            for (int ai = 0; ai < 2; ++ai)
#pragma unroll
                for (int m = 0; m < 4; ++m) { bf16_t* rowp = RB + (size_t)(row0 + ai * 128 + m * 16) * 4096 + ch0;
                    f32x4 e[4];
#pragma unroll
                    for (int i = 0; i < 4; ++i) { const f32x4 v = acc[ai][i >> 1][m][i & 1];
#pragma unroll
                        for (int j = 0; j < 4; ++j) { const float x = fminf(fmaxf(v[j], -30.f), 30.f); e[i][j] = __builtin_amdgcn_exp2f(-x * LOG2E); } }
#pragma unroll
                    for (int i = 0; i < 4; ++i) { f32x4 r;
#pragma unroll
                        for (int j = 0; j < 4; ++j) r[j] = (i < 3) ? (1.0f + e[i + 1][j]) * __builtin_amdgcn_rcpf(1.0f + e[i][j]) : __builtin_amdgcn_rcpf(1.0f + e[3][j]);
                        u32x2 w; w.x = cvt_pk_bf16(r[0], r[1]); w.y = cvt_pk_bf16(r[2], r[3]);
                        *(u32x2*)(rowp + i * 1024) = w; } }
        }
    }
};
struct EpiMerge {
    static constexpr bool PERM = true;
    const bf16_t* RB; bf16_t* T;
    __device__ __forceinline__ void scale(acc_t& acc, const pg8::Unit& u, int seg, int wr, int wc, int fr, int fq) const {
        asm volatile("" : "+v"(fr), "+v"(fq));
        const int row0 = u.pm * 256 + wr * 64 + fr, ch0 = u.pn * 256 + wc * 64 + fq * 16;
#pragma unroll
        for (int ai = 0; ai < 2; ++ai) { u32x4 q[4][2];
#pragma unroll
            for (int m = 0; m < 4; ++m) { const bf16_t* rp = RB + (size_t)(row0 + ai * 128 + m * 16) * 4096 + seg * 1024 + ch0;
                q[m][0] = *(const u32x4*)rp; q[m][1] = *(const u32x4*)(rp + 8); }
#pragma unroll
            for (int m = 0; m < 4; ++m)
#pragma unroll
                for (int bj = 0; bj < 2; ++bj) { const u32x4 q0 = q[m][bj];
                    acc[ai][bj][m][0] *= (f32x4){bf_lo(q0.x), bf_hi(q0.x), bf_lo(q0.y), bf_hi(q0.y)};
                    acc[ai][bj][m][1] *= (f32x4){bf_lo(q0.z), bf_hi(q0.z), bf_lo(q0.w), bf_hi(q0.w)}; }
            asm volatile("" ::: "memory"); }
    }
    __device__ __forceinline__ void hook(acc_t& acc, const pg8::Unit& u, int seg, int wr, int wc, int fr, int fq) const {
        scale(acc, u, seg, wr, wc, fr, fq);
    }
    __device__ __forceinline__ void operator()(acc_t& acc, const pg8::Unit& u, int wr, int wc, int fr, int fq) const {
        scale(acc, u, 3, wr, wc, fr, fq);
        const int row0 = u.pm * 256 + wr * 64 + fr, ch0 = u.pn * 256 + wc * 64 + fq * 16;
#pragma unroll
        for (int ai = 0; ai < 2; ++ai)
#pragma unroll
            for (int m = 0; m < 4; ++m) { bf16_t* rowp = T + (size_t)(row0 + ai * 128 + m * 16) * DM + ch0;
#pragma unroll
                for (int bj = 0; bj < 2; ++bj) { const f32x4 v0 = acc[ai][bj][m][0], v1 = acc[ai][bj][m][1];
                    u32x4 w; w.x = cvt_pk_bf16(v0[0], v0[1]); w.y = cvt_pk_bf16(v0[2], v0[3]); w.z = cvt_pk_bf16(v1[0], v1[1]); w.w = cvt_pk_bf16(v1[2], v1[3]);
                    *(u32x4*)(rowp + bj * 8) = w; } }
    }
};
struct EpiResid {
    static constexpr bool PERM = false;
    XMap X; const float* mod;
    bool skip_ctx;
    const float* rd_lat; const float* rd_ctx;
    __device__ __forceinline__ void operator()(const acc_t& acc, const pg8::Unit& u, int wr, int wc, int fr, int fq) const {
        const int m0 = u.pm * 256; const int b = m0 / TB, t0 = m0 - b * TB; const bool isctx = t0 >= SEQ;
        if (isctx && skip_ctx) return;
        float* base = isctx ? X.ctx + ((size_t)b * NCTX + (t0 - SEQ)) * DM : X.lat + ((size_t)b * SEQ + t0) * DM;
        const float* rbase = isctx ? rd_ctx + ((size_t)b * NCTX + (t0 - SEQ)) * DM : rd_lat + ((size_t)b * SEQ + t0) * DM;
        const float* mv = mod + (size_t)(isctx ? NB : b) * 6144;
        const int rl0 = wr * 64 + fr, col0 = u.pn * 256 + wc * 32 + 4 * fq;
        f32x4 mq[2][2];
#pragma unroll
        for (int bj = 0; bj < 2; ++bj)
#pragma unroll
            for (int n = 0; n < 2; ++n) mq[bj][n] = *(const f32x4*)(mv + col0 + bj * 128 + n * 16);
#pragma unroll
        for (int ai = 0; ai < 2; ++ai)
#pragma unroll
            for (int m2 = 0; m2 < 4; m2 += 2) { f32x4 xv[2][2][2];
#pragma unroll
                for (int mm = 0; mm < 2; ++mm) { const float* rowp = rbase + (size_t)(rl0 + ai * 128 + (m2 + mm) * 16) * DM + col0;
#pragma unroll
                    for (int bj = 0; bj < 2; ++bj)
#pragma unroll
                        for (int n = 0; n < 2; ++n) xv[mm][bj][n] = *(const f32x4*)(rowp + bj * 128 + n * 16); }
#pragma unroll
                for (int mm = 0; mm < 2; ++mm) { float* rowp = base + (size_t)(rl0 + ai * 128 + (m2 + mm) * 16) * DM + col0;
#pragma unroll
                    for (int bj = 0; bj < 2; ++bj)
#pragma unroll
                        for (int n = 0; n < 2; ++n) *(f32x4*)(rowp + bj * 128 + n * 16) = xv[mm][bj][n] + mq[bj][n] * acc[ai][bj][m2 + mm][n]; }
                asm volatile("" ::: "memory"); }
    }
};
struct EpiSwiGLU {
    static constexpr bool PERM = true;
    bf16_t* H; int ldh;
    __device__ __forceinline__ void operator()(const acc_t& acc, const pg8::Unit& u, int wr, int wc, int fr, int fq) const {
        const int row0 = u.pm * 256 + wr * 64 + fr, col0 = u.pn * 128 + wc * 32 + 8 * fq;
#pragma unroll
        for (int ai = 0; ai < 2; ++ai)
#pragma unroll
            for (int m = 0; m < 4; ++m) { bf16_t* rowp = H + (size_t)(row0 + ai * 128 + m * 16) * ldh + col0; float o[8];
#pragma unroll
                for (int n = 0; n < 2; ++n)
#pragma unroll
                    for (int j = 0; j < 4; ++j) { const float a = acc[ai][0][m][n][j], g = acc[ai][1][m][n][j]; o[n * 4 + j] = a * fast_sigmoid(a) * g; }
                u32x4 w; w.x = cvt_pk_bf16(o[0], o[1]); w.y = cvt_pk_bf16(o[2], o[3]); w.z = cvt_pk_bf16(o[4], o[5]); w.w = cvt_pk_bf16(o[6], o[7]);
                *(u32x4*)rowp = w; }
    }
};
struct EpiMoeDown {
    static constexpr bool PERM = true;
    const MoeInfo* I; const int* tok; const float* gw; bf16_t* slot;
    __device__ __forceinline__ void operator()(const acc_t& acc, const pg8::Unit& u, int wr, int wc, int fr, int fq) const {
        const int e = u.aux / MT, j0 = u.aux - e * MT; const int valid = I->p[e] - j0;
        const int rl0 = wr * 64 + fr, col0 = u.pn * 256 + wc * 32 + 8 * fq;
#pragma unroll
        for (int ai = 0; ai < 2; ++ai)
#pragma unroll
            for (int m = 0; m < 4; ++m) { const int r = rl0 + ai * 128 + m * 16;
                if (r < valid) { const int tk = tok[u.aux + r]; const float g = gw[u.aux + r]; const int token = tk & 0x7fffffff, k = (tk >> 31) & 1;
                    bf16_t* rowp = slot + ((size_t)token * 2 + k) * DM + col0;
#pragma unroll
                    for (int bj = 0; bj < 2; ++bj) { const f32x4 v0 = acc[ai][bj][m][0] * g, v1 = acc[ai][bj][m][1] * g;
                        u32x4 w; w.x = cvt_pk_bf16(v0[0], v0[1]); w.y = cvt_pk_bf16(v0[2], v0[3]); w.z = cvt_pk_bf16(v1[0], v1[1]); w.w = cvt_pk_bf16(v1[2], v1[3]);
                        *(u32x4*)(rowp + bj * 128) = w; } } }
    }
};
struct Frame {
    LAS unsigned char* lds;
    unsigned* ctl;
    int tid, lane, wave, G, bid, wv;
    const float* const* in;
    unsigned char* ws;
    float* out;
};
enum { I_X = 0, I_C, I_CTX, I_CCTX, I_WADA, I_BADA, I_NMIX, I_NFFN, I_WIN, I_HSW, I_HSB, I_HW1, I_HB1, I_HW2, I_HB2, I_HW3, I_HB3, I_HW4, I_HFREQ, I_HBIAS,
       I_CFW, I_CFB, I_CFG, I_CFLB, I_GQN, I_GKN, I_DQN, I_DKN, I_LQ1, I_LK1, I_LQ2, I_LK2, I_SUBLN, I_WBR, I_WOUT, I_FW1, I_FW3, I_FW2, I_ROUTER, I_MW1, I_MW3, I_MW2 };

__device__ __forceinline__ void p0_mods(Frame& F) {
    F.tid = opaque_tid(F.wv); F.lane = F.tid & 63; F.wave = __builtin_amdgcn_readfirstlane(F.tid >> 6);
    LAS float* s = (LAS float*)F.lds;
    LAS float* red = (LAS float*)(F.lds + 40960);
    const float* c = INP(F, I_C); const float* cc = INP(F, I_CCTX);
    for (int i = F.tid; i < 9 * 1024; i += NTHR) { const float v = i < 8192 ? c[i] : cc[i - 8192]; s[i] = v * fast_sigmoid(v); }
    __syncthreads();
    float* MODS = (float*)(F.ws + WS_MODS);
    for (int u = F.bid; u < 4 * 96; u += F.G) {
        const int l = u / 96, n0 = (u % 96) * 64;
        const float* w = INP(F, I_WADA) + (size_t)l * DM * 6144 + n0 + F.lane;
        float acc[9];
#pragma unroll
        for (int r = 0; r < 9; ++r) acc[r] = 0.f;
        const int k0 = F.wave * 128;
#pragma unroll 16
        for (int k = k0; k < k0 + 128; ++k) { const float wv = w[(size_t)k * 6144];
#pragma unroll
            for (int r = 0; r < 9; ++r) acc[r] += s[r * 1024 + k] * wv; }
#pragma unroll
        for (int r = 0; r < 9; ++r) red[(F.wave * 9 + r) * 64 + F.lane] = acc[r];
        __syncthreads();
        for (int i = F.tid; i < 9 * 64; i += NTHR) { const int r = i >> 6, ln = i & 63; float t = INP(F, I_BADA)[l * 6144 + n0 + ln];
#pragma unroll
            for (int w8 = 0; w8 < 8; ++w8) t += red[(w8 * 9 + r) * 64 + ln];
            const int sl6 = n0 >> 10, cl = (n0 & 1023) + ln;
            if (sl6 == 1) t = INP(F, I_NMIX)[l * DM + cl] * (1.0f + t);
            if (sl6 == 4) t = INP(F, I_NFFN)[l * DM + cl] * (1.0f + t);
            MODS[((size_t)l * 9 + r) * 6144 + n0 + ln] = t; }
        __syncthreads();
    }
}
__device__ __forceinline__ void p0_a3(Frame& F) {
    F.tid = opaque_tid(F.wv); F.lane = F.tid & 63; F.wave = __builtin_amdgcn_readfirstlane(F.tid >> 6);
    const int gw = F.bid * NWAVES + F.wave, NGW = F.G * NWAVES;
    const int l = gw & 3; const int j = F.lane;
    float w1r[33], w2r[64], w3r[64];
    const float* w1 = INP(F, I_HW1) + l * 33 * 64; const float* w2 = INP(F, I_HW2) + l * 4096; const float* w3 = INP(F, I_HW3) + l * 4096;
#pragma unroll
    for (int i = 0; i < 33; ++i) w1r[i] = w1[i * 64 + j];
#pragma unroll
    for (int i = 0; i < 64; ++i) { w2r[i] = w2[i * 64 + j]; w3r[i] = w3[i * 64 + j]; }
    const float b1 = INP(F, I_HB1)[l * 64 + j], b2 = INP(F, I_HB2)[l * 64 + j], b3 = INP(F, I_HB3)[l * 64 + j], fq = INP(F, I_HFREQ)[l * 64 + j];
    float* A3 = (float*)(F.ws + WS_A3) + (size_t)l * TB * 64;
    for (int i = gw >> 2; i < TB; i += NGW >> 2) {
        const int L = i < SEQ ? SEQ : NCTX, pos = i < SEQ ? i : i - SEQ;
        float z = 0.f;
        { const float t = (float)pos / (float)(L - 1); const float wpos = 6.283185307179586f * (float)pos / (float)L;
          const int bnd = (j >= 17) ? j - 17 : j - 1; const float fr = 1e-4f + (float)bnd * ((15.0f - 1e-4f) / 15.0f); const float ang = fr * wpos;
          z = (j == 0) ? t : (j < 17 ? cosf(ang) : (j < 33 ? -sinf(ang) : 0.f)); }
        float p = b1;
#pragma unroll
        for (int k = 0; k < 33; ++k) p += __builtin_bit_cast(float, __builtin_amdgcn_readlane(__builtin_bit_cast(int, z), k)) * w1r[k];
        float a = sinf(fq * p);
        p = b2;
#pragma unroll
        for (int k = 0; k < 64; ++k) p += __builtin_bit_cast(float, __builtin_amdgcn_readlane(__builtin_bit_cast(int, a), k)) * w2r[k];
        a = sinf(fq * p);
        p = b3;
#pragma unroll
        for (int k = 0; k < 64; ++k) p += __builtin_bit_cast(float, __builtin_amdgcn_readlane(__builtin_bit_cast(int, a), k)) * w3r[k];
        a = sinf(fq * p);
        A3[(size_t)i * 64 + j] = a;
    }
}
__device__ __forceinline__ void p0_zero_rows(Frame& F) {
    u32x4* z = (u32x4*)(F.ws + WS_HB + (size_t)MT * DM * 2);
    for (int i = F.bid * NTHR + F.tid; i < 256 * DM * 2 / 16; i += F.G * NTHR) z[i] = (u32x4){0u, 0u, 0u, 0u};
}

template <class Map>
__device__ __forceinline__ void transpose_item(const float* W, int ldw, int k0, int n0, bf16_t* WT, int ldwt, int kdst, const Map& map, LAS float* scr, int lane) {
    asm volatile("" : "+s"(ldw));
    const float* src = W + (size_t)(k0 + (lane >> 5)) * ldw + n0 + (lane & 31);
    float v[32];
#pragma unroll
    for (int i = 0; i < 32; ++i) v[i] = src[(size_t)(2 * i) * ldw];
#pragma unroll
    for (int i = 0; i < 32; ++i) scr[(2 * i + (lane >> 5)) * 33 + (lane & 31)] = v[i];
    LDS_WAIT(); asm volatile("" ::: "memory");
    const int c = lane & 7;
#pragma unroll
    for (int j = 0; j < 4; ++j) { const int n = (lane >> 3) + 8 * j; const LAS float* s = scr + (8 * c) * 33 + n;
        u32x4 o; o.x = pk2(s[0 * 33], s[1 * 33]); o.y = pk2(s[2 * 33], s[3 * 33]); o.z = pk2(s[4 * 33], s[5 * 33]); o.w = pk2(s[6 * 33], s[7 * 33]);
        *(GAS u32x4*)(WT + (size_t)map(n0 + n) * ldwt + kdst + k0 + 8 * c) = o; }
    LDS_WAIT(); asm volatile("" ::: "memory");
}
struct MapId { __device__ __forceinline__ int operator()(int n) const { return n; } };
struct MapWin {
    __device__ __forceinline__ int operator()(int n) const { if (n < OFF_GATE) return n; const int g = n - OFF_GATE, i = g >> 10, ch = g & 1023;
        return OFF_GATE + 256 * (ch >> 6) + 128 * (i >> 1) + 32 * ((ch >> 4) & 3) + 8 * ((ch >> 2) & 3) + 4 * (i & 1) + (ch & 3); } };
struct MapMerge {
    __device__ __forceinline__ int operator()(int ch) const { return (ch & ~255) + 128 * ((ch >> 3) & 1) + 32 * ((ch >> 6) & 3) + 8 * ((ch >> 4) & 3) + (ch & 7); } };
struct MapGlu {
    int half; __device__ __forceinline__ int operator()(int j) const { return 256 * (j >> 7) + 128 * half + (j & 127); } };

constexpr int CV_WIN = 16 * (D_IN / 32), CV_BR = 4 * 4 * 32, CV_OUT = 16 * 32, CV_SMALL = CV_WIN + CV_BR + CV_OUT;
constexpr int CV_F13 = 16 * (DFF / 32), CV_F2 = (DFF / 64) * 32, CV_DENSE = 2 * CV_F13 + CV_F2;
constexpr int CV_M13 = 16 * (DFFE / 32), CV_M2 = (DFFE / 64) * 32, CV_MOE1 = 2 * CV_M13 + CV_M2, CV_MOE = NEXP * CV_MOE1;
__device__ __forceinline__ int cv_ffn_total(int l) { return (l & 1) ? CV_MOE : CV_DENSE; }
__device__ __forceinline__ void convert_small_item(Frame& F, int l, int r, LAS float* scr) {
    if (r < CV_WIN) { const int nb = D_IN / 32; transpose_item(INP(F, I_WIN) + (size_t)l * DM * D_IN, D_IN, 64 * (r / nb), 32 * (r % nb), (bf16_t*)(F.ws + WS_WIN), DM, 0, MapWin{}, scr, F.lane); return; } r -= CV_WIN;
    if (r < CV_BR) { const int i = r / 128, q = r % 128; transpose_item(INP(F, I_WBR) + ((size_t)l * 4 + i) * 256 * DM, DM, 64 * (q / 32), 32 * (q % 32), (bf16_t*)(F.ws + WS_WBR), DM, 256 * i, MapMerge{}, scr, F.lane); return; } r -= CV_BR;
    transpose_item(INP(F, I_WOUT) + (size_t)l * DM * DM, DM, 64 * (r / 32), 32 * (r % 32), (bf16_t*)(F.ws + WS_WOUT), DM, 0, MapId{}, scr, F.lane);
}
__device__ __forceinline__ void convert_ffn_item(Frame& F, int l, int r, LAS float* scr) {
    const bool moe = l & 1; const int li = l >> 1;
    if (!moe) {
        if (r < 2 * CV_F13) { const int half = r / CV_F13, q = r % CV_F13, nb = DFF / 32; transpose_item(INP(F, half ? I_FW3 : I_FW1) + (size_t)li * DM * DFF, DFF, 64 * (q / nb), 32 * (q % nb), (bf16_t*)(F.ws + WS_WF1), DM, 0, MapGlu{half}, scr, F.lane); return; } r -= 2 * CV_F13;
        transpose_item(INP(F, I_FW2) + (size_t)li * DFF * DM, DM, 64 * (r / 32), 32 * (r % 32), (bf16_t*)(F.ws + WS_WF2), DFF, 0, MapId{}, scr, F.lane);
    } else {
        const int e = r / CV_MOE1; r %= CV_MOE1;
        if (r < 2 * CV_M13) { const int half = r / CV_M13, q = r % CV_M13, nb = DFFE / 32; transpose_item(INP(F, half ? I_MW3 : I_MW1) + ((size_t)li * NEXP + e) * DM * DFFE, DFFE, 64 * (q / nb), 32 * (q % nb), (bf16_t*)(F.ws + WS_WM13) + (size_t)e * 2 * DFFE * DM, DM, 0, MapGlu{half}, scr, F.lane); return; } r -= 2 * CV_M13;
        transpose_item(INP(F, I_MW2) + ((size_t)li * NEXP + e) * DFFE * DM, DM, 64 * (r / 32), 32 * (r % 32), (bf16_t*)(F.ws + WS_WM2) + (size_t)e * DM * DFFE, DFFE, 0, MapId{}, scr, F.lane);
    }
}
__device__ __forceinline__ void convert_ffn_queue(Frame& F, int l, int quota) {
    F.tid = opaque_tid(F.wv); F.lane = F.tid & 63; F.wave = __builtin_amdgcn_readfirstlane(F.tid >> 6);
    LAS float* scr = (LAS float*)(F.lds + 65536 + F.wave * 8704);
    unsigned* q = F.ctl + CW_Q + l * 64; const int total = cv_ffn_total(l);
    constexpr int BATCH = 8;
    for (int n = 0; n < quota; ++n) {
        int idx = 0; if (F.lane == 0) idx = (int)__hip_atomic_fetch_add(q, (unsigned)BATCH, RLX_AGENT);
        idx = __builtin_amdgcn_readfirstlane(idx);
        if (idx >= total) break;
        const int end = (idx + BATCH < total) ? idx + BATCH : total;
        for (int it = idx; it < end; ++it) convert_ffn_item(F, l, it, scr);
    }
}
__device__ __forceinline__ void convert_weights(Frame& F, int l) {
    F.tid = opaque_tid(F.wv); F.lane = F.tid & 63; F.wave = __builtin_amdgcn_readfirstlane(F.tid >> 6);
    LAS float* scr = (LAS float*)(F.lds + 65536 + F.wave * 8704);
    const int gw = F.bid * NWAVES + F.wave, NGW = F.G * NWAVES;
    for (int it = gw; it < CV_SMALL; it += NGW) convert_small_item(F, l, it, scr);
    convert_ffn_queue(F, l, 1 << 30);
}

#define FP(i) ((i) + ((i) >> 4))
__device__ __forceinline__ f32x2 cmul(f32x2 a, f32x2 b) { return (f32x2){a.x * b.x - a.y * b.y, a.x * b.y + a.y * b.x}; }
__device__ __forceinline__ f32x2 twid(float rev) { return (f32x2){__builtin_amdgcn_cosf(rev), __builtin_amdgcn_sinf(rev)}; }
template <int K> __device__ __forceinline__ void bfly(f32x2& a, f32x2& b) {
    constexpr float C1 = 0.9238795325112867f, S1 = 0.3826834323650898f, C2 = 0.7071067811865476f;
    const f32x2 s = a + b, d = a - b; a = s;
    if constexpr (K == 0) b = d;
    else if constexpr (K == 1) b = (f32x2){d.x * C1 + d.y * S1, d.y * C1 - d.x * S1};
    else if constexpr (K == 2) b = (f32x2){(d.x + d.y) * C2, (d.y - d.x) * C2};
    else if constexpr (K == 3) b = (f32x2){d.x * S1 + d.y * C1, d.y * S1 - d.x * C1};
    else if constexpr (K == 4) b = (f32x2){d.y, -d.x};
    else if constexpr (K == 5) b = (f32x2){d.y * C1 - d.x * S1, -d.x * C1 - d.y * S1};
    else if constexpr (K == 6) b = (f32x2){(d.y - d.x) * C2, -(d.x + d.y) * C2};
    else b = (f32x2){d.y * S1 - d.x * C1, -d.x * S1 - d.y * C1};
}
__device__ __forceinline__ void fft16(f32x2 (&v)[16]) {
    bfly<0>(v[0], v[8]); bfly<1>(v[1], v[9]); bfly<2>(v[2], v[10]); bfly<3>(v[3], v[11]); bfly<4>(v[4], v[12]); bfly<5>(v[5], v[13]); bfly<6>(v[6], v[14]); bfly<7>(v[7], v[15]);
    bfly<0>(v[0], v[4]); bfly<2>(v[1], v[5]); bfly<4>(v[2], v[6]); bfly<6>(v[3], v[7]); bfly<0>(v[8], v[12]); bfly<2>(v[9], v[13]); bfly<4>(v[10], v[14]); bfly<6>(v[11], v[15]);
    bfly<0>(v[0], v[2]); bfly<4>(v[1], v[3]); bfly<0>(v[4], v[6]); bfly<4>(v[5], v[7]); bfly<0>(v[8], v[10]); bfly<4>(v[9], v[11]); bfly<0>(v[12], v[14]); bfly<4>(v[13], v[15]);
    bfly<0>(v[0], v[1]); bfly<0>(v[2], v[3]); bfly<0>(v[4], v[5]); bfly<0>(v[6], v[7]); bfly<0>(v[8], v[9]); bfly<0>(v[10], v[11]); bfly<0>(v[12], v[13]); bfly<0>(v[14], v[15]);
    f32x2 t;
    t = v[1]; v[1] = v[8]; v[8] = t;   t = v[2]; v[2] = v[4]; v[4] = t;   t = v[3]; v[3] = v[12]; v[12] = t;
    t = v[5]; v[5] = v[10]; v[10] = t; t = v[7]; v[7] = v[14]; v[14] = t; t = v[11]; v[11] = v[13]; v[13] = t;
}
__device__ __forceinline__ void fft8192(LAS f32x2* buf, int tid) {
    constexpr int N = 8192;
#pragma unroll 1
    for (int pass = 0; pass < 3; ++pass) {
        const int Ns = pass == 0 ? 1 : (pass == 1 ? 16 : 256);
        const int j = tid;
        const int jm = j & (Ns - 1);
        const f32x2 w1 = twid(-(float)jm / (float)(Ns * 16));
        f32x2 v[16];
#pragma unroll
        for (int r = 0; r < 16; ++r) v[r] = buf[FP(j + r * (N / 16))];
        f32x2 w = w1;
#pragma unroll
        for (int r = 1; r < 16; ++r) { v[r] = cmul(v[r], w); w = cmul(w, w1); }
        fft16(v);
        __syncthreads();
        const int idx = ((j - jm) << 4) + jm;
#pragma unroll
        for (int r = 0; r < 16; ++r) buf[FP(idx + r * Ns)] = v[r];
        __syncthreads();
    }
    {
        f32x2 a[8], b[8];
#pragma unroll
        for (int q = 0; q < 8; ++q) { const int j = tid + q * NTHR; a[q] = buf[FP(j)]; b[q] = cmul(buf[FP(j + 4096)], twid(-(float)j / 8192.0f)); }
        __syncthreads();
#pragma unroll
        for (int q = 0; q < 8; ++q) { const int j = tid + q * NTHR; buf[FP(j)] = a[q] + b[q]; buf[FP(j + 4096)] = a[q] - b[q]; }
        __syncthreads();
    }
}

template <bool TW = true> __device__ __forceinline__ void fft_pass16(LAS f32x2* buf, int tid, int Ns) {
    asm volatile("" : "+v"(tid), "+s"(Ns));
    const int j = tid, jm = j & (Ns - 1);
    const f32x2 w1 = twid(-(float)jm / (float)(Ns * 16));
    f32x2 v[16];
#pragma unroll
    for (int r = 0; r < 16; ++r) v[r] = buf[FP(j + r * 512)];
    if constexpr (TW) { f32x2 w = w1;
#pragma unroll
        for (int r = 1; r < 16; ++r) { v[r] = cmul(v[r], w); w = cmul(w, w1); } }
    fft16(v);
    __syncthreads();
    const int idx = ((j - jm) << 4) + jm;
#pragma unroll
    for (int r = 0; r < 16; ++r) buf[FP(idx + r * Ns)] = v[r];
    __syncthreads();
}
__device__ __forceinline__ void fft_fwd_regs_mulK(LAS f32x2* buf, int tid, const f32x2 (&z)[8], const f32x2* __restrict__ KF) {
    asm volatile("" : "+v"(tid));
    { f32x2 v[16];
#pragma unroll
      for (int r = 0; r < 8; ++r) { v[r] = z[r]; v[r + 8] = (f32x2){0.f, 0.f}; }
      fft16(v);
#pragma unroll
      for (int r = 0; r < 16; ++r) buf[FP(tid * 16 + r)] = v[r];
      __syncthreads(); }
    fft_pass16(buf, tid, 16);
    fft_pass16(buf, tid, 256);
    asm volatile("" : "+v"(tid));
    { f32x2 a[8], b[8], k0[8], k1[8];
#pragma unroll
      for (int q = 0; q < 8; ++q) { const int j = tid + q * NTHR; k0[q] = KF[j]; k1[q] = KF[j + 4096]; }
#pragma unroll
      for (int q = 0; q < 8; ++q) { const int j = tid + q * NTHR; a[q] = buf[FP(j)]; b[q] = cmul(buf[FP(j + 4096)], twid(-(float)j / 8192.0f)); }
      __syncthreads();
#pragma unroll
      for (int q = 0; q < 8; ++q) { const int j = tid + q * NTHR; const f32x2 y0 = cmul(a[q] + b[q], k0[q]), y1 = cmul(a[q] - b[q], k1[q]);
          buf[FP(j)] = (f32x2){y0.x, -y0.y}; buf[FP(j + 4096)] = (f32x2){y1.x, -y1.y}; }
      __syncthreads(); }
}
__device__ __forceinline__ void fft_to_regs_lo(LAS f32x2* buf, int tid, f32x2 (&out)[8]) {
    fft_pass16<false>(buf, tid, 1);
    fft_pass16(buf, tid, 16);
    fft_pass16(buf, tid, 256);
    asm volatile("" : "+v"(tid));
#pragma unroll
    for (int q = 0; q < 8; ++q) { const int j = tid + q * NTHR; out[q] = buf[FP(j)] + cmul(buf[FP(j + 4096)], twid(-(float)j / 8192.0f)); }
}

template <bool TW = true> __device__ __forceinline__ void fft_pass16_x2(LAS f32x2* bufA, LAS f32x2* bufB, int tid, int Ns) {
    asm volatile("" : "+v"(tid), "+s"(Ns));
    const int j = tid, jm = j & (Ns - 1);
    const f32x2 w1 = twid(-(float)jm / (float)(Ns * 16));
    f32x2 va[16], vb[16];
#pragma unroll
    for (int r = 0; r < 16; ++r) { va[r] = bufA[FP(j + r * 512)]; vb[r] = bufB[FP(j + r * 512)]; }
    if constexpr (TW) { f32x2 w = w1;
#pragma unroll
        for (int r = 1; r < 16; ++r) { va[r] = cmul(va[r], w); vb[r] = cmul(vb[r], w); w = cmul(w, w1); } }
    fft16(va); fft16(vb);
    __syncthreads();
    const int idx = ((j - jm) << 4) + jm;
#pragma unroll
    for (int r = 0; r < 16; ++r) { bufA[FP(idx + r * Ns)] = va[r]; bufB[FP(idx + r * Ns)] = vb[r]; }
    __syncthreads();
}
__device__ __forceinline__ void fft_fwd_regs_mulK_x2(LAS f32x2* bufA, LAS f32x2* bufB, int tid, const f32x2 (&za)[8], const f32x2 (&zb)[8], const f32x2* __restrict__ KF) {
    asm volatile("" : "+v"(tid));
    { f32x2 v[16];
#pragma unroll
      for (int r = 0; r < 8; ++r) { v[r] = za[r]; v[r + 8] = (f32x2){0.f, 0.f}; }
      fft16(v);
#pragma unroll
      for (int r = 0; r < 16; ++r) bufA[FP(tid * 16 + r)] = v[r];
#pragma unroll
      for (int r = 0; r < 8; ++r) { v[r] = zb[r]; v[r + 8] = (f32x2){0.f, 0.f}; }
      fft16(v);
#pragma unroll
      for (int r = 0; r < 16; ++r) bufB[FP(tid * 16 + r)] = v[r];
      __syncthreads(); }
    fft_pass16_x2(bufA, bufB, tid, 16);
    fft_pass16_x2(bufA, bufB, tid, 256);
    asm volatile("" : "+v"(tid));
#pragma unroll
    for (int hq = 0; hq < 2; ++hq) {
      f32x2 a[4], b[4], c[4], d[4], k0[4], k1[4];
#pragma unroll
      for (int q = 0; q < 4; ++q) { const int j = tid + (hq * 4 + q) * NTHR; k0[q] = KF[j]; k1[q] = KF[j + 4096]; }
#pragma unroll
      for (int q = 0; q < 4; ++q) { const int j = tid + (hq * 4 + q) * NTHR; const f32x2 tw = twid(-(float)j / 8192.0f);
          a[q] = bufA[FP(j)]; b[q] = cmul(bufA[FP(j + 4096)], tw); c[q] = bufB[FP(j)]; d[q] = cmul(bufB[FP(j + 4096)], tw); }
#pragma unroll
      for (int q = 0; q < 4; ++q) { const int j = tid + (hq * 4 + q) * NTHR;
          const f32x2 y0 = cmul(a[q] + b[q], k0[q]), y1 = cmul(a[q] - b[q], k1[q]), y2 = cmul(c[q] + d[q], k0[q]), y3 = cmul(c[q] - d[q], k1[q]);
          bufA[FP(j)] = (f32x2){y0.x, -y0.y}; bufA[FP(j + 4096)] = (f32x2){y1.x, -y1.y}; bufB[FP(j)] = (f32x2){y2.x, -y2.y}; bufB[FP(j + 4096)] = (f32x2){y3.x, -y3.y}; }
    }
    __syncthreads();
}
__device__ __forceinline__ void fft_to_regs_lo_x2(LAS f32x2* bufA, LAS f32x2* bufB, int tid, f32x2 (&oa)[8], f32x2 (&ob)[8]) {
    fft_pass16_x2<false>(bufA, bufB, tid, 1);
    fft_pass16_x2(bufA, bufB, tid, 16);
    fft_pass16_x2(bufA, bufB, tid, 256);
    asm volatile("" : "+v"(tid));
#pragma unroll
    for (int q = 0; q < 8; ++q) { const int j = tid + q * NTHR; const f32x2 tw = twid(-(float)j / 8192.0f);
        oa[q] = bufA[FP(j)] + cmul(bufA[FP(j + 4096)], tw); ob[q] = bufB[FP(j)] + cmul(bufB[FP(j + 4096)], tw); }
}

__device__ __forceinline__ float block_sum(LAS float* red, float v, int tid, int lane, int wave) {
    v = wave_sum(v);
    __syncthreads();
    if (lane == 0) red[wave] = v;
    __syncthreads();
    float s = 0.f;
#pragma unroll
    for (int w = 0; w < NWAVES; ++w) s += red[w];
    return s;
}
__device__ __forceinline__ void hyena_filter_unit(Frame& F, int l, int c) {
    F.tid = opaque_tid(F.wv); F.lane = F.tid & 63; F.wave = __builtin_amdgcn_readfirstlane(F.tid >> 6);
    LAS f32x2* buf = (LAS f32x2*)F.lds;
    LAS float* w4c = (LAS float*)(F.lds + 73728);
    LAS float* red = (LAS float*)(F.lds + 73728 + 1024);
    const float* w4 = INP(F, I_HW4) + (size_t)l * 64 * 1024;
    __syncthreads();
    if (F.tid < 256) { const int q = F.tid >> 6, j = F.tid & 63; w4c[q * 64 + j] = w4[j * 1024 + q * 256 + c]; }
    __syncthreads();
    const float lt = -4.605170185988091f;
    const float d0 = lt / 1.5f, d1 = lt / 0.3f;
    const float delta = fabsf(d0 + (float)c * ((d1 - d0) / 255.0f));
    const float* A3 = (const float*)(F.ws + WS_A3) + (size_t)l * TB * 64;
    float ss0 = 0.f, ss1 = 0.f;
#pragma unroll 1
    for (int t = F.tid; t < SEQ; t += NTHR) {
        const f32x4* ar = (const f32x4*)(A3 + (size_t)t * 64);
        float h[4] = {0.f, 0.f, 0.f, 0.f};
        LAS float* wq = w4c; asm volatile("" : "+v"(wq));
#pragma unroll 4
        for (int j4 = 0; j4 < 16; ++j4) { const f32x4 a = ar[j4];
#pragma unroll
            for (int q = 0; q < 4; ++q) { const f32x4 w = *(const LAS f32x4*)(wq + q * 64 + 4 * j4); h[q] += (a[0] * w[0] + a[1] * w[1]) + (a[2] * w[2] + a[3] * w[3]); } }
        const float win = __expf(-((float)t / (float)(SEQ - 1)) * delta);
        const float f0 = h[0] * win, f1 = h[1] * win, b0 = h[2] * win, b1 = h[3] * win;
        buf[FP(t)] = (f32x2){f0, f1}; ss0 += f0 * f0; ss1 += f1 * f1;
        if (t >= 1) { buf[FP(2 * SEQ - t)] = (f32x2){b0, b1}; ss0 += b0 * b0; ss1 += b1 * b1; }
    }
    if (F.tid == 0) { float z0 = 0.f; asm volatile("" : "+v"(z0)); buf[FP(SEQ)] = (f32x2){z0, z0}; }
    const float t0 = block_sum(red, ss0, F.tid, F.lane, F.wave);
    const float t1 = block_sum(red, ss1, F.tid, F.lane, F.wave);
    const float s0 = 1.0f / sqrtf(t0 + EPS), s1 = 1.0f / sqrtf(t1 + EPS);
#pragma unroll 2
    for (int i = F.tid; i < 8192; i += NTHR) { f32x2 v = buf[FP(i)]; v.x *= s0; v.y *= s1; buf[FP(i)] = v; }
    __syncthreads();
    fft8192(buf, F.tid);
    f32x2* KF0 = (f32x2*)(F.ws + WS_KF) + (size_t)c * 8192; f32x2* KF1 = KF0 + (size_t)256 * 8192;
    const float sc = 0.5f / 8192.0f;
#pragma unroll 2
    for (int f = F.tid; f < 8192; f += NTHR) { const f32x2 a = buf[FP(f)], bb = buf[FP((8192 - f) & 8191)]; const f32x2 b = (f32x2){bb.x, -bb.y};
        KF0[f] = (f32x2){(a.x + b.x) * sc, (a.y + b.y) * sc}; const float dr = a.x - b.x, di = a.y - b.y; KF1[f] = (f32x2){di * sc, -dr * sc}; }
    __syncthreads();
    float* KC = (float*)(F.ws + WS_KC);
    float v[4] = {0.f, 0.f, 0.f, 0.f};
    if (F.tid < NCTX) { const int t = F.tid; const f32x4* ar = (const f32x4*)(A3 + (size_t)(SEQ + t) * 64);
#pragma unroll 4
        for (int j4 = 0; j4 < 16; ++j4) { const f32x4 a = ar[j4];
#pragma unroll
            for (int q = 0; q < 4; ++q) { const f32x4 w = *(const LAS f32x4*)(w4c + q * 64 + 4 * j4); v[q] += (a[0] * w[0] + a[1] * w[1]) + (a[2] * w[2] + a[3] * w[3]); } }
        const float win = __expf(-((float)t / (float)(NCTX - 1)) * delta);
#pragma unroll
        for (int q = 0; q < 4; ++q) v[q] *= win; }
    const bool has_b = F.tid >= 1 && F.tid < NCTX;
    const float u0 = block_sum(red, v[0] * v[0] + (has_b ? v[2] * v[2] : 0.f), F.tid, F.lane, F.wave);
    const float u1 = block_sum(red, v[1] * v[1] + (has_b ? v[3] * v[3] : 0.f), F.tid, F.lane, F.wave);
    if (F.tid < NCTX) { const int t = F.tid; const float r0 = 1.0f / sqrtf(u0 + EPS), r1 = 1.0f / sqrtf(u1 + EPS);
        KC[((size_t)0 * 256 + c) * 512 + 255 + t] = v[0] * r0; KC[((size_t)1 * 256 + c) * 512 + 255 + t] = v[1] * r1;
        if (t >= 1) { KC[((size_t)0 * 256 + c) * 512 + 255 - t] = v[2] * r0; KC[((size_t)1 * 256 + c) * 512 + 255 - t] = v[3] * r1; } }
    __syncthreads();
}

__device__ __forceinline__ void load_xrow(Frame& F, int m, int mode, f32x4 (&v)[4]) {
    const int b = m / TB, t = m - b * TB; const bool isctx = t >= SEQ;
    const float* src = isctx ? (const float*)(F.ws + WS_XC) + ((size_t)b * NCTX + (t - SEQ)) * DM : F.out + ((size_t)b * SEQ + t) * DM;
    if (mode & 1) src = isctx ? INP(F, I_CTX) + ((size_t)b * NCTX + (t - SEQ)) * DM : INP(F, I_X) + ((size_t)b * SEQ + t) * DM;
    const GAS f32x4* xr = (const GAS f32x4*)src + F.lane;
#pragma unroll
    for (int j = 0; j < 4; ++j) v[j] = __builtin_nontemporal_load(xr + 64 * j);
}
__device__ __forceinline__ void norm_row(Frame& F, int l, int m, int slice0, int mode, float (&xv)[16], bool write_h, const f32x4 (&vin)[4], int mn, f32x4 (&nx2)[4]) {
    const int b = m / TB, t = m - b * TB; const bool isctx = t >= SEQ; const int r = isctx ? NB : b;
    float* xs = isctx ? (float*)(F.ws + WS_XC) + ((size_t)b * NCTX + (t - SEQ)) * DM : F.out + ((size_t)b * SEQ + t) * DM;
    f32x4 v[4];
#pragma unroll
    for (int j = 0; j < 4; ++j) v[j] = vin[j];
    const float* MODS = (const float*)(F.ws + WS_MODS);
    const float* sh = MODS + ((size_t)l * 9 + r) * 6144 + slice0 * DM; const float* scp = sh + DM;
    f32x4 sv[4], hv[4];
#pragma unroll
    for (int j = 0; j < 4; ++j) { const int col = 4 * F.lane + 256 * j; sv[j] = *(const f32x4*)(scp + col); hv[j] = *(const f32x4*)(sh + col); }
    u32x2 s0[4], s1[4]; f32x4 mq[4];
    if (mode & 2) {
        const bf16_t* sl = (const bf16_t*)(F.ws + WS_SLOT) + (size_t)m * 2 * DM;
        const float* m5 = MODS + ((size_t)(l - 1) * 9 + r) * 6144 + 5 * DM;
#pragma unroll
        for (int j = 0; j < 4; ++j) { const int col = 4 * F.lane + 256 * j; s0[j] = *(const u32x2*)(sl + col); s1[j] = *(const u32x2*)(sl + DM + col); mq[j] = *(const f32x4*)(m5 + col); }
    }
    asm volatile("" ::: "memory");
    load_xrow(F, mn, mode, nx2);
    asm volatile("" ::: "memory");
    if (mode & 2) {
#pragma unroll
        for (int j = 0; j < 4; ++j) {
            v[j][0] += mq[j][0] * (bf_lo(s0[j].x) + bf_lo(s1[j].x)); v[j][1] += mq[j][1] * (bf_hi(s0[j].x) + bf_hi(s1[j].x));
            v[j][2] += mq[j][2] * (bf_lo(s0[j].y) + bf_lo(s1[j].y)); v[j][3] += mq[j][3] * (bf_hi(s0[j].y) + bf_hi(s1[j].y)); }
        GAS f32x4* xo = (GAS f32x4*)xs + F.lane;
#pragma unroll
        for (int j = 0; j < 4; ++j) xo[64 * j] = v[j];
    }
    float ss = 0.f;
#pragma unroll
    for (int j = 0; j < 4; ++j) ss += (v[j][0] * v[j][0] + v[j][1] * v[j][1]) + (v[j][2] * v[j][2] + v[j][3] * v[j][3]);
    const float rstd = 1.0f / sqrtf(wave_sum(ss) * (1.0f / DM) + EPS);
    bf16_t* hrow = (bf16_t*)(F.ws + WS_HB) + (size_t)m * DM;
#pragma unroll
    for (int j = 0; j < 4; ++j) { const int col = 4 * F.lane + 256 * j;
        f32x4 h;
#pragma unroll
        for (int q = 0; q < 4; ++q) { h[q] = (v[j][q] * rstd) * sv[j][q] + hv[j][q]; xv[4 * j + q] = h[q]; }
        if (write_h) { u32x2 w; w.x = pk2(h[0], h[1]); w.y = pk2(h[2], h[3]); *(u32x2*)(hrow + col) = w; } }
}
__device__ __forceinline__ void hyena_short_unit(Frame& F, int l, int unit) {
    F.tid = opaque_tid(F.wv); F.lane = F.tid & 63; F.wave = __builtin_amdgcn_readfirstlane(F.tid >> 6);
    LAS bf16_t* s = (LAS bf16_t*)F.lds;
    constexpr int LDW = 258;
    const int g = unit % 3, tt = (unit / 3) % 68, b = unit / (3 * 68);
    const int t0 = tt * 64; const bool isctx = t0 >= SEQ; const int lo = isctx ? SEQ : 0, hi = isctx ? TB : SEQ;
    const bf16_t* UB = (const bf16_t*)(F.ws + WS_UB) + (size_t)b * TB * UBW + g * 256;
    __syncthreads();
    for (int i = F.tid; i < 66 * 32; i += NTHR) { const int rr = i >> 5, ch8 = (i & 31) * 8; const int t = t0 - 1 + rr;
        u32x4 v = (u32x4){0u, 0u, 0u, 0u}; if (t >= lo && t < hi) v = *(const u32x4*)(UB + (size_t)t * UBW + ch8);
        LAS unsigned* d = (LAS unsigned*)(s + rr * LDW + ch8); d[0] = v.x; d[1] = v.y; d[2] = v.z; d[3] = v.w; }
    __syncthreads();
    const int ch = F.tid & 255, tg = F.tid >> 8;
    const float* sw = INP(F, I_HSW) + (size_t)l * 3 * 768 + g * 256 + ch;
    const float w0 = sw[0], w1 = sw[768], w2 = sw[1536], bias = INP(F, I_HSB)[l * 768 + g * 256 + ch];
    bf16_t* dst = (bf16_t*)(F.ws + WS_HT) + (((size_t)b * 3 + g) * 256 + ch) * TB + t0 + tg * 32;
    float p0 = bf2f(s[(tg * 32) * LDW + ch]), p1 = bf2f(s[(tg * 32 + 1) * LDW + ch]);
#pragma unroll
    for (int q = 0; q < 4; ++q) { unsigned w[4];
#pragma unroll
        for (int e = 0; e < 4; ++e) { const int tl = tg * 32 + q * 8 + e * 2;
            const float p2 = bf2f(s[(tl + 2) * LDW + ch]), p3 = bf2f(s[(tl + 3) * LDW + ch]);
            const float o0 = w0 * p0 + w1 * p1 + w2 * p2 + bias, o1 = w0 * p1 + w1 * p2 + w2 * p3 + bias;
            w[e] = pk2(o0, o1); p0 = p2; p1 = p3; }
        *(u32x4*)(dst + q * 8) = (u32x4){w[0], w[1], w[2], w[3]}; }
}
__device__ __forceinline__ void conformer_unit(Frame& F, int l, int unit) {
    F.tid = opaque_tid(F.wv); F.lane = F.tid & 63; F.wave = __builtin_amdgcn_readfirstlane(F.tid >> 6);
    LAS float* y = (LAS float*)F.lds;
    LAS float* o = (LAS float*)(F.lds + 62 * 256 * 4);
    const int tt = unit % 136, b = unit / 136; const int t0 = tt * 32; const bool isctx = t0 >= SEQ; const int lo = isctx ? SEQ : 0, hi = isctx ? TB : SEQ;
    const bf16_t* UB = (const bf16_t*)(F.ws + WS_UB) + (size_t)b * TB * UBW + OFF_CF;
    __syncthreads();
    for (int i = F.tid; i < 62 * 32; i += NTHR) { const int rr = i >> 5, ch8 = (i & 31) * 8; const int t = t0 - 15 + rr;
        float r[8];
        if (t >= lo && t < hi) { const u32x4 a = *(const u32x4*)(UB + (size_t)t * UBW + ch8), g = *(const u32x4*)(UB + (size_t)t * UBW + 256 + ch8);
            r[0] = bf_lo(a.x) * fast_sigmoid(bf_lo(g.x)); r[1] = bf_hi(a.x) * fast_sigmoid(bf_hi(g.x)); r[2] = bf_lo(a.y) * fast_sigmoid(bf_lo(g.y)); r[3] = bf_hi(a.y) * fast_sigmoid(bf_hi(g.y));
            r[4] = bf_lo(a.z) * fast_sigmoid(bf_lo(g.z)); r[5] = bf_hi(a.z) * fast_sigmoid(bf_hi(g.z)); r[6] = bf_lo(a.w) * fast_sigmoid(bf_lo(g.w)); r[7] = bf_hi(a.w) * fast_sigmoid(bf_hi(g.w));
        } else {
#pragma unroll
            for (int q = 0; q < 8; ++q) r[q] = 0.f; }
        *(LAS f32x4*)(y + rr * 256 + ch8) = (f32x4){r[0], r[1], r[2], r[3]}; *(LAS f32x4*)(y + rr * 256 + ch8 + 4) = (f32x4){r[4], r[5], r[6], r[7]}; }
    __syncthreads();
    { const int ch = F.tid & 255, tg = F.tid >> 8;
      const float* dw = INP(F, I_CFW) + (size_t)l * 31 * 256 + ch; const float bias = INP(F, I_CFB)[l * 256 + ch];
      float acc[16];
#pragma unroll
      for (int q = 0; q < 16; ++q) acc[q] = bias;
#pragma unroll
      for (int j = 0; j < 46; ++j) { const float v = y[(tg * 16 + j) * 256 + ch];
#pragma unroll
          for (int q = 0; q < 16; ++q) { const int tap = j - q; if (tap >= 0 && tap < 31) acc[q] += dw[tap * 256] * v; } }
#pragma unroll
      for (int q = 0; q < 16; ++q) o[(tg * 16 + q) * 256 + ch] = acc[q]; }
    __syncthreads();
    { const float* lg = INP(F, I_CFG) + l * 256; const float* lb = INP(F, I_CFLB) + l * 256;
      const f32x4 gv = *(const f32x4*)(lg + 4 * F.lane), bv = *(const f32x4*)(lb + 4 * F.lane);
      bf16_t* YB = (bf16_t*)(F.ws + WS_YB) + ((size_t)b * TB + t0) * DM + 256 + 4 * F.lane;
#pragma unroll
      for (int q = 0; q < 4; ++q) { const int tl = F.wave * 4 + q; const f32x4 v = *(const LAS f32x4*)(o + tl * 256 + 4 * F.lane);
          const float mu = wave_sum((v[0] + v[1]) + (v[2] + v[3])) * (1.0f / 256.0f);
          const f32x4 d = v - mu; const float var = wave_sum((d[0] * d[0] + d[1] * d[1]) + (d[2] * d[2] + d[3] * d[3])) * (1.0f / 256.0f);
          const float rstd = 1.0f / sqrtf(var + EPS); float z[4];
#pragma unroll
          for (int e = 0; e < 4; ++e) { const float h = d[e] * rstd * gv[e] + bv[e]; z[e] = h * fast_sigmoid(h); }
          u32x2 w; w.x = pk2(z[0], z[1]); w.y = pk2(z[2], z[3]); *(u32x2*)(YB + (size_t)tl * DM) = w; } }
}
__device__ __forceinline__ void qk_prep_tables(Frame& F) {
    LAS f32x2* cs64 = (LAS f32x2*)F.lds; LAS f32x2* cs32 = cs64 + 64 * 16;
    __syncthreads();
    for (int i = F.tid; i < 64 * 16; i += NTHR) { const int p = i >> 4, f = i & 15; const float inv = powf(10000.0f, -(float)f / 16.0f); const float a = (float)p * inv; cs64[i] = (f32x2){cosf(a), sinf(a)}; }
    for (int i = F.tid; i < 64 * 8; i += NTHR) { const int p = i >> 3, f = i & 7; const float inv = powf(10000.0f, -(float)f / 8.0f); const float a = (float)p * inv; cs32[i] = (f32x2){cosf(a), sinf(a)}; }
    __syncthreads();
}
__device__ __forceinline__ void qk_prep_items(Frame& F, int l) {
    F.tid = opaque_tid(F.wv); F.lane = F.tid & 63; F.wave = __builtin_amdgcn_readfirstlane(F.tid >> 6);
    LAS f32x2* cs64 = (LAS f32x2*)F.lds; LAS f32x2* cs32 = cs64 + 64 * 16;
    const bf16_t* UB = (const bf16_t*)(F.ws + WS_UB);
    const float C2G = 0.125f * LOG2E, C2D = 0.17677669529663687f * LOG2E;
    const int T = F.bid * NTHR + F.tid, NT = F.G * NTHR;
    {
        const int rows_per_sweep = NT / 6; const int q = T % 6; const bool isq = q < 4; const int h = isq ? q : q - 4;
        const float* gn = INP(F, isq ? I_GQN : I_GKN) + l * 64; float g[64];
#pragma unroll
        for (int d = 0; d < 64; ++d) g[d] = gn[d];
        const float sc = isq ? C2G : 1.0f;
        if (T < rows_per_sweep * 6)
        for (int m = T / 6; m < MT; m += rows_per_sweep) {
            const int b = m / TB, t = m - b * TB; const bool lat = t < SEQ; const int prow = t >> 6, pcol = t & 63;
            const bf16_t* src = UB + (size_t)m * UBW + OFF_GQA + (isq ? 0 : 256) + h * 64;
            float v[64]; float ss = 0.f;
#pragma unroll
            for (int c8 = 0; c8 < 8; ++c8) { const u32x4 w = *(const u32x4*)(src + c8 * 8);
                v[c8 * 8 + 0] = bf_lo(w.x); v[c8 * 8 + 1] = bf_hi(w.x); v[c8 * 8 + 2] = bf_lo(w.y); v[c8 * 8 + 3] = bf_hi(w.y); v[c8 * 8 + 4] = bf_lo(w.z); v[c8 * 8 + 5] = bf_hi(w.z); v[c8 * 8 + 6] = bf_lo(w.w); v[c8 * 8 + 7] = bf_hi(w.w); }
#pragma unroll
            for (int d = 0; d < 64; ++d) ss += v[d] * v[d];
            const float rstd = 1.0f / sqrtf(ss * (1.0f / 64.0f) + EPS);
#pragma unroll
            for (int d = 0; d < 64; ++d) v[d] = v[d] * rstd * g[d];
            if (lat) {
#pragma unroll
                for (int hf = 0; hf < 2; ++hf) { const int p = hf ? pcol : prow;
#pragma unroll
                    for (int f = 0; f < 16; ++f) { const f32x2 cs = cs64[p * 16 + f]; const float x1 = v[hf * 32 + f], x2 = v[hf * 32 + 16 + f];
                        v[hf * 32 + f] = x1 * cs.x - x2 * cs.y; v[hf * 32 + 16 + f] = x2 * cs.x + x1 * cs.y; } }
            }
            bf16_t* dst = isq ? (bf16_t*)(F.ws + WS_QG) + (size_t)m * 256 + h * 64 : (bf16_t*)(F.ws + WS_KG) + (size_t)m * 128 + h * 64;
#pragma unroll
            for (int c8 = 0; c8 < 8; ++c8) { u32x4 w; w.x = pk2(v[c8 * 8] * sc, v[c8 * 8 + 1] * sc); w.y = pk2(v[c8 * 8 + 2] * sc, v[c8 * 8 + 3] * sc); w.z = pk2(v[c8 * 8 + 4] * sc, v[c8 * 8 + 5] * sc); w.w = pk2(v[c8 * 8 + 6] * sc, v[c8 * 8 + 7] * sc);
                *(u32x4*)(dst + c8 * 8) = w; }
        }
    }
    {
        const int rows_per_sweep = NT / 16; const int q = T % 16; const bool isq = q < 8; const int hm = q & 7; const int mm = hm & 1;
        const float* gn = INP(F, isq ? I_DQN : I_DKN) + l * 64 + mm * 32; float g[32];
#pragma unroll
        for (int d = 0; d < 32; ++d) g[d] = gn[d];
        const float sc = isq ? C2D : 1.0f;
        for (int m0 = T / 16; m0 < MT; m0 += 2 * rows_per_sweep) {
            float v[2][32]; bool ok[2];
#pragma unroll
            for (int u = 0; u < 2; ++u) { const int m = m0 + u * rows_per_sweep; ok[u] = m < MT; const int mc = ok[u] ? m : m0;
                const bf16_t* src = UB + (size_t)mc * UBW + OFF_DIFF + (isq ? 0 : 256) + hm * 32;
#pragma unroll
                for (int c8 = 0; c8 < 4; ++c8) { const u32x4 w = *(const u32x4*)(src + c8 * 8);
                    v[u][c8 * 8 + 0] = bf_lo(w.x); v[u][c8 * 8 + 1] = bf_hi(w.x); v[u][c8 * 8 + 2] = bf_lo(w.y); v[u][c8 * 8 + 3] = bf_hi(w.y); v[u][c8 * 8 + 4] = bf_lo(w.z); v[u][c8 * 8 + 5] = bf_hi(w.z); v[u][c8 * 8 + 6] = bf_lo(w.w); v[u][c8 * 8 + 7] = bf_hi(w.w); } }
#pragma unroll
            for (int u = 0; u < 2; ++u) { const int m = m0 + u * rows_per_sweep; if (!ok[u]) continue;
                const int b = m / TB, t = m - b * TB; const bool lat = t < SEQ; const int prow = t >> 6, pcol = t & 63;
                float ss = 0.f;
#pragma unroll
                for (int d = 0; d < 32; ++d) ss += v[u][d] * v[u][d];
                const float rstd = 1.0f / sqrtf(ss * (1.0f / 32.0f) + EPS);
#pragma unroll
                for (int d = 0; d < 32; ++d) v[u][d] = v[u][d] * rstd * g[d];
                if (lat) {
#pragma unroll
                    for (int hf = 0; hf < 2; ++hf) { const int p = hf ? pcol : prow;
#pragma unroll
                        for (int f = 0; f < 8; ++f) { const f32x2 cs = cs32[p * 8 + f]; const float x1 = v[u][hf * 16 + f], x2 = v[u][hf * 16 + 8 + f];
                            v[u][hf * 16 + f] = x1 * cs.x - x2 * cs.y; v[u][hf * 16 + 8 + f] = x2 * cs.x + x1 * cs.y; } }
                }
                bf16_t* dst = (bf16_t*)(F.ws + (isq ? WS_QD : WS_KD)) + (size_t)m * 256 + hm * 32;
#pragma unroll
                for (int c8 = 0; c8 < 4; ++c8) { u32x4 w; w.x = pk2(v[u][c8 * 8] * sc, v[u][c8 * 8 + 1] * sc); w.y = pk2(v[u][c8 * 8 + 2] * sc, v[u][c8 * 8 + 3] * sc); w.z = pk2(v[u][c8 * 8 + 4] * sc, v[u][c8 * 8 + 5] * sc); w.w = pk2(v[u][c8 * 8 + 6] * sc, v[u][c8 * 8 + 7] * sc);
                    *(u32x4*)(dst + c8 * 8) = w; } }
        }
    }
}

__device__ __forceinline__ void hyena_conv_unit(Frame& F, int l, int unit) {
    F.tid = opaque_tid(F.wv); F.lane = F.tid & 63; F.wave = __builtin_amdgcn_readfirstlane(F.tid >> 6);
    LAS f32x2* bufA = (LAS f32x2*)F.lds; LAS f32x2* bufB = (LAS f32x2*)(F.lds + 69632);
    const int c = unit >> 1, hb = unit & 1; const int b0 = 4 * hb, b1 = b0 + 1, b2 = b0 + 2, b3 = b0 + 3;
    const bf16_t* HT = (const bf16_t*)(F.ws + WS_HT);
    const size_t bstr = (size_t)3 * 256 * TB;
    const bf16_t* x1p = HT + ((size_t)b0 * 3 * 256 + 0 * 256 + c) * TB; const bf16_t* x2p = HT + ((size_t)b0 * 3 * 256 + 1 * 256 + c) * TB; const bf16_t* vp = HT + ((size_t)b0 * 3 * 256 + 2 * 256 + c) * TB;
    const f32x2* KF0 = (const f32x2*)(F.ws + WS_KF) + (size_t)c * 8192; const f32x2* KF1 = KF0 + (size_t)256 * 8192;
    const float bias0 = INP(F, I_HBIAS)[(l * 2 + 0) * 256 + c], bias1 = INP(F, I_HBIAS)[(l * 2 + 1) * 256 + c];
    f32x2 za[8], zb[8];
    __syncthreads();
#pragma unroll
    for (int q = 0; q < 8; ++q) { const int t = F.tid + NTHR * q; za[q] = (f32x2){bf2f(vp[t]), bf2f(vp[bstr + t])}; zb[q] = (f32x2){bf2f(vp[2 * bstr + t]), bf2f(vp[3 * bstr + t])}; }
#pragma unroll 1
    for (int o = 0; o < 2; ++o) {
        fft_fwd_regs_mulK_x2(bufA, bufB, F.tid, za, zb, o ? KF1 : KF0);
        f32x2 ra[8], rb[8];
        fft_to_regs_lo_x2(bufA, bufB, F.tid, ra, rb);
        const bf16_t* gp = o ? x2p : x1p; const float bias = o ? bias1 : bias0;
#pragma unroll
        for (int q = 0; q < 8; ++q) { const int t = F.tid + NTHR * q;
            za[q] = (f32x2){bf2f(gp[t]) * (ra[q].x + bias * za[q].x), bf2f(gp[bstr + t]) * (-ra[q].y + bias * za[q].y)};
            zb[q] = (f32x2){bf2f(gp[2 * bstr + t]) * (rb[q].x + bias * zb[q].x), bf2f(gp[3 * bstr + t]) * (-rb[q].y + bias * zb[q].y)}; }
        __syncthreads();
    }
    bf16_t* YB = (bf16_t*)(F.ws + WS_YB);
#pragma unroll
    for (int q = 0; q < 8; ++q) { const int t = F.tid + NTHR * q;
        YB[((size_t)b0 * TB + t) * DM + c] = (bf16_t)f2bf(za[q].x); YB[((size_t)b1 * TB + t) * DM + c] = (bf16_t)f2bf(za[q].y);
        YB[((size_t)b2 * TB + t) * DM + c] = (bf16_t)f2bf(zb[q].x); YB[((size_t)b3 * TB + t) * DM + c] = (bf16_t)f2bf(zb[q].y); }
}
__device__ __forceinline__ void hyena_ctx_unit(Frame& F, int l, int unit) {
    F.tid = opaque_tid(F.wv); F.lane = F.tid & 63; F.wave = __builtin_amdgcn_readfirstlane(F.tid >> 6);
    LAS float* zs = (LAS float*)F.lds;
    LAS float* Gs = (LAS float*)(F.lds + 8192);
    const int b = unit >> 5, c0 = (unit & 31) * 8; const int ch = F.tid & 7, tg = F.tid >> 3; const int c = c0 + ch;
    const bf16_t* HT = (const bf16_t*)(F.ws + WS_HT);
    const bf16_t* x1 = HT + (((size_t)b * 3 + 0) * 256 + c) * TB + SEQ; const bf16_t* x2 = HT + (((size_t)b * 3 + 1) * 256 + c) * TB + SEQ; const bf16_t* vv = HT + (((size_t)b * 3 + 2) * 256 + c) * TB + SEQ;
    const float* KC = (const float*)(F.ws + WS_KC);
    const int t0 = tg * 4;
    float z[4];
#pragma unroll
    for (int q = 0; q < 4; ++q) z[q] = bf2f(vv[t0 + q]);
#pragma unroll 1
    for (int o = 0; o < 2; ++o) {
        __syncthreads();
#pragma unroll
        for (int q = 0; q < 4; ++q) zs[(t0 + q) * 8 + ch] = z[q];
        for (int i = F.tid; i < 512 * 8; i += NTHR) { const int d = i >> 3, cc = i & 7; Gs[i] = d < 511 ? KC[((size_t)o * 256 + c0 + cc) * 512 + d] : 0.f; }
        __syncthreads();
        float acc[4] = {0.f, 0.f, 0.f, 0.f};
#pragma unroll 1
        for (int s0 = 0; s0 < 256; s0 += 16) {
            float tw[19];
#pragma unroll
            for (int i = 0; i < 19; ++i) tw[i] = Gs[(t0 - s0 - 15 + i + 255) * 8 + ch];
#pragma unroll
            for (int k = 0; k < 16; ++k) { const float zv = zs[(s0 + k) * 8 + ch];
#pragma unroll
                for (int q = 0; q < 4; ++q) acc[q] += zv * tw[q - k + 15]; }
        }
        const bf16_t* g = o ? x2 : x1; const float bias = INP(F, I_HBIAS)[(l * 2 + o) * 256 + c];
#pragma unroll
        for (int q = 0; q < 4; ++q) z[q] = bf2f(g[t0 + q]) * (acc[q] + bias * z[q]);
    }
    bf16_t* YB = (bf16_t*)(F.ws + WS_YB) + ((size_t)b * TB + SEQ) * DM + c;
#pragma unroll
    for (int q = 0; q < 4; ++q) YB[(size_t)(t0 + q) * DM] = (bf16_t)f2bf(z[q]);
}
namespace attn_body {
constexpr int D = 64, NW = 8, QBLK = 32, QB = QBLK * NW, KVBLK = 64;
__device__ __forceinline__ int crow(int r, int hi) { return (r & 3) + 8 * (r >> 2) + 4 * hi; }
#define SBAR() __builtin_amdgcn_sched_barrier(0)
constexpr int NSLOT = 3, SLOTB = 8192;
constexpr int LDS_K = 0, LDS_V = NSLOT * SLOTB, LDS_WS = 2 * NSLOT * SLOTB, LDS_OST = LDS_WS + NW * 64 * 4, LDS_O1 = LDS_OST + NW * 4096, LDS_BYTES_ATTN = LDS_O1 + NW * 8192;
__device__ __forceinline__ void glds16(const void* gsrc, unsigned lds_dst) { unsigned keep;
  asm volatile("s_mov_b32 %0, m0\n\ts_mov_b32 m0, %2\n\ts_nop 0\n\tglobal_load_lds_dwordx4 %1, off\n\ts_mov_b32 m0, %0" : "=&s"(keep) : "v"(gsrc), "s"(lds_dst) : "memory"); }
__device__ __forceinline__ float max3f(float a, float b, float c) { float r; asm("v_max3_f32 %0, %1, %2, %3" : "=v"(r) : "v"(a), "v"(b), "v"(c)); return r; }
__device__ __forceinline__ float max2f(float a, float b) { float r; asm("v_max_f32_e32 %0, %1, %2" : "=v"(r) : "v"(a), "v"(b)); return r; }
__device__ __forceinline__ float fadd_s(float a, float b) { float r; asm("v_add_f32_e32 %0, %1, %2" : "=v"(r) : "v"(a), "v"(b)); return r; }
__device__ __forceinline__ float fsub_s(float a, float b) { float r; asm("v_sub_f32_e32 %0, %1, %2" : "=v"(r) : "v"(a), "v"(b)); return r; }
typedef float f32x2_t __attribute__((ext_vector_type(2))); typedef __bf16 bf16x2_t __attribute__((ext_vector_type(2)));
__device__ __forceinline__ unsigned cvtpk_s(float lo, float hi) { f32x2_t v = {lo, hi}; bf16x2_t b = __builtin_convertvector(v, bf16x2_t); return __builtin_bit_cast(unsigned, b); }
#define WAIT_BAR(N) asm volatile("s_waitcnt vmcnt(" #N ") lgkmcnt(0)\n\ts_barrier" ::: "memory")
template <int ND0> __device__ __forceinline__ void qkt(f32x16& p0, f32x16& p1, const char* Kslot, const bf16x8* qr, const f32x16& negm, int r32, int hi) {
  const char* kb = Kslot + hi * 1024 + r32 * 16;
  #pragma unroll
  for (int d0 = 0; d0 < ND0; ++d0) {
    const bf16x8 b0 = *reinterpret_cast<const bf16x8*>(kb + d0 * 2048);
    const bf16x8 b1 = *reinterpret_cast<const bf16x8*>(kb + d0 * 2048 + 512);
    if (d0 == 0) { p0 = __builtin_amdgcn_mfma_f32_32x32x16_bf16(b0, qr[0], negm, 0, 0, 0); p1 = __builtin_amdgcn_mfma_f32_32x32x16_bf16(b1, qr[0], negm, 0, 0, 0); }
    else { p0 = __builtin_amdgcn_mfma_f32_32x32x16_bf16(b0, qr[d0], p0, 0, 0, 0); p1 = __builtin_amdgcn_mfma_f32_32x32x16_bf16(b1, qr[d0], p1, 0, 0, 0); } }
}
typedef __attribute__((address_space(3))) const char* lds_cptr;
typedef short v4i16_t __attribute__((ext_vector_type(4)));
template <int ND0> __device__ __forceinline__ void kload8(bf16x8* kf, lds_cptr kp) {
  kf[0] = *(const __attribute__((address_space(3))) bf16x8*)(kp);        kf[1] = *(const __attribute__((address_space(3))) bf16x8*)(kp + 512);
  kf[2] = *(const __attribute__((address_space(3))) bf16x8*)(kp + 2048); kf[3] = *(const __attribute__((address_space(3))) bf16x8*)(kp + 2560);
  if constexpr (ND0 == 4) {
  kf[4] = *(const __attribute__((address_space(3))) bf16x8*)(kp + 4096); kf[5] = *(const __attribute__((address_space(3))) bf16x8*)(kp + 4608);
  kf[6] = *(const __attribute__((address_space(3))) bf16x8*)(kp + 6144); kf[7] = *(const __attribute__((address_space(3))) bf16x8*)(kp + 6656); }
}
__device__ __forceinline__ void kload2(bf16x8* kf, lds_cptr kp, int j) { kf[2 * j] = *(const __attribute__((address_space(3))) bf16x8*)(kp + j * 2048); kf[2 * j + 1] = *(const __attribute__((address_space(3))) bf16x8*)(kp + j * 2048 + 512); }
__device__ __forceinline__ s16x4 vtr(lds_cptr p) { return __builtin_bit_cast(s16x4, __builtin_amdgcn_ds_read_tr16_b64_v4i16((__attribute__((address_space(3))) v4i16_t*)p)); }
__device__ __forceinline__ float rowmax(const f32x16& p0, const f32x16& p1) {
  float a = max3f(p0[0], p0[1], p1[0]), b = max3f(p0[2], p0[3], p1[1]); a = max3f(a, p1[2], p1[3]);
  #pragma unroll
  for (int r = 4; r < 16; r += 4) { a = max3f(a, p0[r], p0[r + 1]); b = max3f(b, p0[r + 2], p0[r + 3]); a = max3f(a, p1[r], p1[r + 1]); b = max3f(b, p1[r + 2], p1[r + 3]); }
  const float m = max2f(a, b);
  auto rr = __builtin_amdgcn_permlane32_swap(__float_as_uint(m), __float_as_uint(m), false, false);
  return max2f(__uint_as_float(rr[0]), __uint_as_float(rr[1]));
}
__device__ __forceinline__ void pv(f32x16* o, int vb, bf16x8 pa0, bf16x8 pa1, bf16x8 pa2, bf16x8 pa3) {
  #pragma unroll
  for (int d0 = 0; d0 < 2; ++d0) { s16x4 lo[4], hi[4];
    #pragma unroll
    for (int ks = 0; ks < 4; ++ks) {
      asm volatile("ds_read_b64_tr_b16 %0,%1 offset:%c2" : "=&v"(lo[ks]) : "v"(vb), "i"(d0 * 4096 + ks * 1024) : "memory");
      asm volatile("ds_read_b64_tr_b16 %0,%1 offset:%c2" : "=&v"(hi[ks]) : "v"(vb), "i"(d0 * 4096 + ks * 1024 + 512) : "memory"); }
    asm volatile("s_waitcnt lgkmcnt(0)" ::: "memory"); SBAR();
    #define PK(k) (bf16x8){lo[k][0], lo[k][1], lo[k][2], lo[k][3], hi[k][0], hi[k][1], hi[k][2], hi[k][3]}
    o[d0] = __builtin_amdgcn_mfma_f32_32x32x16_bf16(pa0, PK(0), o[d0], 0, 0, 0);
    o[d0] = __builtin_amdgcn_mfma_f32_32x32x16_bf16(pa1, PK(1), o[d0], 0, 0, 0);
    o[d0] = __builtin_amdgcn_mfma_f32_32x32x16_bf16(pa2, PK(2), o[d0], 0, 0, 0);
    o[d0] = __builtin_amdgcn_mfma_f32_32x32x16_bf16(pa3, PK(3), o[d0], 0, 0, 0);
    #undef PK
  }
}
template <int THRL, int MODE, int DQ = 64> __device__ __forceinline__ void attn_unit(const bf16_t* Qw0, int qp, const bf16_t* __restrict__ Kh, int kp, const bf16_t* __restrict__ Vh, int vp, int NT, bf16_t* Ow0, int op, char* shm, float lam, const float* gsub, float post, const int wv) {
  const int tid = opaque_tid(wv), lane = tid & 63, r32 = lane & 31, hi = lane >> 5; const int wid = __builtin_amdgcn_readfirstlane(tid >> 6);
  const bf16_t* Qw = Qw0 + (long)wid * QBLK * qp;
  const unsigned lds0 = (unsigned)(uintptr_t)shm;
  float* wsf = (float*)(shm + LDS_WS) + wid * 64;
  constexpr int ND0 = DQ / 16;
  const int kch = (DQ == 32) ? (wid & 3) : wid;
  const bf16_t* ksrc = Kh + (long)lane * kp + kch * 8;
  const bf16_t* vsrc = Vh + (long)(16 * (wid & 3) + (lane >> 2)) * vp + (wid >> 2) * 32 + (lane & 3) * 8;
  const unsigned kdst = lds0 + LDS_K + kch * 1024, vdst = lds0 + LDS_V + wid * 1024;
  #define DMA_K(t, slot) glds16(ksrc + (long)(t) * KVBLK * kp, (unsigned)__builtin_amdgcn_readfirstlane(kdst + (slot)))
  #define DMA_V(t, slot) glds16(vsrc + (long)(t) * KVBLK * vp, (unsigned)__builtin_amdgcn_readfirstlane(vdst + (slot)))
  const int vb0 = (int)(lds0 + LDS_V) + ((lane >> 4) & 1) * 32 + (lane & 3) * 8 + (4 * hi + ((lane & 15) >> 2)) * 64;
  const char* Kbase = shm + LDS_K; bf16x8 kf[8];
  const lds_cptr shm3 = (lds_cptr)shm; const lds_cptr kp0 = shm3 + LDS_K + hi * 1024 + r32 * 16; const lds_cptr vp0 = shm3 + LDS_V + ((lane >> 4) & 1) * 32 + (lane & 3) * 8 + (4 * hi + ((lane & 15) >> 2)) * 64;
  DMA_K(0, 0); DMA_V(0, 0); DMA_K(1, SLOTB);
  bf16x8 qr[4];
  #pragma unroll
  for (int d0 = 0; d0 < ND0; ++d0) qr[d0] = *reinterpret_cast<const bf16x8*>(&Qw[(long)r32 * qp + d0 * 16 + hi * 8]);
  float mhat = 0.f, l_reg = 0.f; f32x16 o[2]; o[0] = f32x16{}; o[1] = f32x16{}; f32x16 negm = f32x16{}; asm volatile("" : "+v"(negm));
  bool resc = false;
  #define START(P0, P1) do { const float rm = rowmax(P0, P1); resc = false; \
    { const float dl = rm; mhat = fadd_s(mhat, dl); \
      _Pragma("unroll") for (int r = 0; r < 16; ++r) { P0[r] = fsub_s(P0[r], dl); P1[r] = fsub_s(P1[r], dl); } \
      _Pragma("unroll") for (int r = 0; r < 16; ++r) negm[r] = -mhat; asm volatile("" : "+v"(negm)); } \
    _Pragma("unroll") for (int r = 0; r < 16; ++r) P0[r] = __builtin_amdgcn_exp2f(P0[r]); } while (0)
  #define RESC() do { if (resc) { asm volatile("s_waitcnt lgkmcnt(0)" ::: "memory"); \
      _Pragma("unroll") for (int d_ = 0; d_ < 2; ++d_) _Pragma("unroll") for (int r = 0; r < 16; ++r) o[d_][r] *= wsf[crow(r, hi)]; } } while (0)
  f32x16 pA0, pA1, pB0, pB1;
  int sl_prev = 0, sl_cur = 0, sl_next = SLOTB;
  #define ROT() do { sl_prev = sl_cur; sl_cur = sl_next; sl_next = (sl_next == (NSLOT - 1) * SLOTB) ? 0 : sl_next + SLOTB; } while (0)
  DMA_K(2, 2 * SLOTB);
  WAIT_BAR(3);
  qkt<ND0>(pA0, pA1, Kbase, qr, negm, r32, hi); asm volatile("s_nop 15\n\ts_nop 7" : "+v"(pA0), "+v"(pA1));
  START(pA0, pA1);
  _Pragma("unroll") for (int r = 0; r < 16; ++r) pA1[r] = __builtin_amdgcn_exp2f(pA1[r]);
  WAIT_BAR(0);
  DMA_K(3, 0); DMA_V(1, SLOTB);
  ROT();
  kload8<ND0>(kf, kp0 + sl_cur);
  WAIT_BAR(2);
  s16x4 vlo[8], vhi[8]; u32x4 pw0, pw1, pw2, pw3;
  #define PKW(P, B) cvtpk_s(P[B], P[B + 1])
  #define PAF(k) __builtin_bit_cast(bf16x8, pw##k)
  #define VFR(i) (bf16x8){vlo[i][0], vlo[i][1], vlo[i][2], vlo[i][3], vhi[i][0], vhi[i][1], vhi[i][2], vhi[i][3]}
  #define PIN(x) asm volatile("" : "+v"(x))
  #define MX3(a, b, c) __builtin_fmaxf(__builtin_fmaxf((a), (b)), (c))
  #define GAPA(MF, A0, A1, A2, A3, W0, W1, PW) do { MF; sacc += A0; sacc += A1; sacc += A2; sacc += A3; PIN(sacc); W0; W1; PIN(PW); SBAR(); } while (0)
  #define EX(v) __builtin_amdgcn_exp2f(v)
  #define GAPB(MF, X, B) do { MF; X[B] = EX(X[B]); X[B + 1] = EX(X[B + 1]); X[B + 2] = EX(X[B + 2]); X[B + 3] = EX(X[B + 3]); PIN(X); SBAR(); } while (0)
  #define VRD(i) do { vlo[i] = vtr(vp_ + (((i) >> 2) * 4096 + ((i) & 3) * 1024)); vhi[i] = vtr(vp_ + (((i) >> 2) * 4096 + ((i) & 3) * 1024 + 512)); } while (0)
  #define KRD(G, j) do { if ((j) < ND0 && (G)) { kload2(kf, kp0 + sl_next, j); SBAR(); } } while (0)
  #define QKX(C, k, q) do { if constexpr (ND0 == 4) { C = __builtin_amdgcn_mfma_f32_32x32x16_bf16(kf[k], qr[q], C, 0, 0, 0); } } while (0)
  #define STEP(C0, C1, P0, P1, t, GK, GV, GL) do { SBAR(); \
    const lds_cptr vp_ = vp0 + sl_prev; \
    VRD(0); SBAR(); float sacc = (P0[0] + P0[1]); \
    GAPA(C0 = __builtin_amdgcn_mfma_f32_32x32x16_bf16(kf[0], qr[0], negm, 0, 0, 0), P0[2], P0[3], P0[4], P0[5],     pw0[0] = PKW(P0, 0), pw0[1] = PKW(P0, 2), pw0); \
    VRD(4); SBAR(); GAPA(C1 = __builtin_amdgcn_mfma_f32_32x32x16_bf16(kf[1], qr[0], negm, 0, 0, 0), P0[6], P0[7], P0[8], P0[9],     pw0[2] = PKW(P0, 4), pw0[3] = PKW(P0, 6), pw0); \
    VRD(1); SBAR(); GAPA(C0 = __builtin_amdgcn_mfma_f32_32x32x16_bf16(kf[2], qr[1], C0, 0, 0, 0),   P0[10], P0[11], P0[12], P0[13], pw1[0] = PKW(P0, 8), pw1[1] = PKW(P0, 10), pw1); \
    VRD(5); SBAR(); GAPA(C1 = __builtin_amdgcn_mfma_f32_32x32x16_bf16(kf[3], qr[1], C1, 0, 0, 0),   P0[14], P0[15], P1[0], P1[1],   pw1[2] = PKW(P0, 12), pw1[3] = PKW(P0, 14), pw1); \
    VRD(2); SBAR(); GAPA(QKX(C0, 4, 2),   P1[2], P1[3], P1[4], P1[5],     pw2[0] = PKW(P1, 0), pw2[1] = PKW(P1, 2), pw2); \
    VRD(6); SBAR(); GAPA(QKX(C1, 5, 2),   P1[6], P1[7], P1[8], P1[9],     pw2[2] = PKW(P1, 4), pw2[3] = PKW(P1, 6), pw2); \
    VRD(3); SBAR(); GAPA(QKX(C0, 6, 3),   P1[10], P1[11], P1[12], P1[13], pw3[0] = PKW(P1, 8), pw3[1] = PKW(P1, 10), pw3); \
    VRD(7); SBAR(); GAPA(QKX(C1, 7, 3),   P1[14], P1[15], 0.f, 0.f,       pw3[2] = PKW(P1, 12), pw3[3] = PKW(P1, 14), pw3); \
    l_reg += sacc; \
    if (GK) { DMA_K((t) + 3, sl_cur); } if (GV) { DMA_V((t) + 1, sl_next); } \
    { float a = MX3(C0[0], C0[1], C1[0]), b = MX3(C0[2], C0[3], C1[1]); a = MX3(a, C1[2], C1[3]); \
      _Pragma("unroll") for (int r = 4; r < 16; r += 4) { a = MX3(a, C0[r], C0[r + 1]); b = MX3(b, C0[r + 2], C0[r + 3]); a = MX3(a, C1[r], C1[r + 1]); b = MX3(b, C1[r + 2], C1[r + 3]); } \
      float rm = __builtin_fmaxf(a, b); { auto rr = __builtin_amdgcn_permlane32_swap(__float_as_uint(rm), __float_as_uint(rm), false, false); rm = __builtin_fmaxf(__uint_as_float(rr[0]), __uint_as_float(rr[1])); } \
      resc = false; \
      if (__builtin_expect(__any(rm > (float)THRL), 0)) { const float dl = __builtin_fmaxf(rm, 0.f); mhat += dl; \
        _Pragma("unroll") for (int r = 0; r < 16; ++r) { C0[r] -= dl; C1[r] -= dl; } \
        _Pragma("unroll") for (int r = 0; r < 16; ++r) negm[r] = -mhat; asm volatile("" : "+v"(negm)); \
        const float f = __builtin_amdgcn_exp2f(-dl); l_reg *= f; if (hi == 0) wsf[r32] = f; resc = true; } } \
    SBAR(); \
    GAPB(o[0] = __builtin_amdgcn_mfma_f32_32x32x16_bf16(PAF(0), VFR(0), o[0], 0, 0, 0), C0, 0); \
    GAPB(o[1] = __builtin_amdgcn_mfma_f32_32x32x16_bf16(PAF(0), VFR(4), o[1], 0, 0, 0), C0, 4); \
    KRD(GL, 0); GAPB(o[0] = __builtin_amdgcn_mfma_f32_32x32x16_bf16(PAF(1), VFR(1), o[0], 0, 0, 0), C0, 8); \
    KRD(GL, 1); GAPB(o[1] = __builtin_amdgcn_mfma_f32_32x32x16_bf16(PAF(1), VFR(5), o[1], 0, 0, 0), C0, 12); \
    KRD(GL, 2); GAPB(o[0] = __builtin_amdgcn_mfma_f32_32x32x16_bf16(PAF(2), VFR(2), o[0], 0, 0, 0), C1, 0); \
    KRD(GL, 3); GAPB(o[1] = __builtin_amdgcn_mfma_f32_32x32x16_bf16(PAF(2), VFR(6), o[1], 0, 0, 0), C1, 4); \
    GAPB(o[0] = __builtin_amdgcn_mfma_f32_32x32x16_bf16(PAF(3), VFR(3), o[0], 0, 0, 0), C1, 8); \
    GAPB(o[1] = __builtin_amdgcn_mfma_f32_32x32x16_bf16(PAF(3), VFR(7), o[1], 0, 0, 0), C1, 12); \
    } while (0)
  int t = 1;
  for (; t + 5 < NT; t += 2) {
    STEP(pB0, pB1, pA0, pA1, t, true, true, true);     WAIT_BAR(2); RESC(); ROT();
    STEP(pA0, pA1, pB0, pB1, t + 1, true, true, true); WAIT_BAR(2); RESC(); ROT();
  }
  #define ENDW(tt) do { if ((tt) + 3 < NT) { WAIT_BAR(2); } else if ((tt) + 2 < NT) { WAIT_BAR(1); } else { WAIT_BAR(0); } } while (0)
  for (; t + 1 < NT; t += 2) {
    STEP(pB0, pB1, pA0, pA1, t, (t + 3 < NT), (t + 1 < NT), (t + 1 < NT));         ENDW(t);     RESC(); ROT();
    STEP(pA0, pA1, pB0, pB1, t + 1, (t + 4 < NT), (t + 2 < NT), (t + 2 < NT));     ENDW(t + 1); RESC(); ROT();
  }
  STEP(pB0, pB1, pA0, pA1, NT - 1, false, false, false); RESC();
  { float sacc = pB0[0] + pB0[1]; _Pragma("unroll") for (int r = 2; r < 16; ++r) sacc += pB0[r]; _Pragma("unroll") for (int r = 0; r < 16; ++r) sacc += pB1[r]; l_reg += sacc;
    pw0 = (u32x4){PKW(pB0, 0), PKW(pB0, 2), PKW(pB0, 4), PKW(pB0, 6)}; pw1 = (u32x4){PKW(pB0, 8), PKW(pB0, 10), PKW(pB0, 12), PKW(pB0, 14)}; pw2 = (u32x4){PKW(pB1, 0), PKW(pB1, 2), PKW(pB1, 4), PKW(pB1, 6)}; pw3 = (u32x4){PKW(pB1, 8), PKW(pB1, 10), PKW(pB1, 12), PKW(pB1, 14)};
    SBAR(); pv(o, vb0 + sl_cur, PAF(0), PAF(1), PAF(2), PAF(3)); }
  #undef PKW
  #undef PAF
  #undef VFR
  #undef PIN
  #undef MX3
  #undef GAPA
  #undef GAPB
  #undef EX
  #undef VRD
  #undef KRD
  #undef QKX
  #undef STEP
  #undef ENDW
  { auto rr = __builtin_amdgcn_permlane32_swap(__float_as_uint(l_reg), __float_as_uint(l_reg), false, false); l_reg = __uint_as_float(rr[0]) + __uint_as_float(rr[1]); }
  if (hi == 0) wsf[32 + r32] = l_reg; asm volatile("s_waitcnt lgkmcnt(0)" ::: "memory");
  float rli[16];
  #pragma unroll
  for (int r = 0; r < 16; ++r) rli[r] = __builtin_amdgcn_rcpf(wsf[32 + crow(r, hi)]);
  bf16_t* Ow = Ow0 + (long)wid * QBLK * op;
  float* o1s = (float*)(shm + LDS_O1) + wid * 2048;
  if constexpr (MODE == 0) {
    bf16_t* stg = (bf16_t*)(shm + LDS_OST) + wid * 2048;
    #pragma unroll
    for (int r = 0; r < 16; ++r) { const int orow = crow(r, hi);
      #pragma unroll
      for (int d0 = 0; d0 < 2; ++d0) stg[orow * 64 + d0 * 32 + r32] = (bf16_t)f2bf(o[d0][r] * rli[r]); }
    asm volatile("s_waitcnt lgkmcnt(0)" ::: "memory");
    #pragma unroll
    for (int i = 0; i < 4; ++i) { const int row = i * 8 + (lane >> 3), ch = lane & 7; const u32x4 v = *(const u32x4*)(stg + row * 64 + ch * 8); *(u32x4*)(Ow + (long)row * op + ch * 8) = v; }
  } else if constexpr (MODE == 1) {
    #pragma unroll
    for (int r = 0; r < 16; ++r) { const int orow = crow(r, hi);
      #pragma unroll
      for (int d0 = 0; d0 < 2; ++d0) o1s[orow * 64 + d0 * 32 + r32] = o[d0][r] * rli[r]; }
  } else {
    #pragma unroll
    for (int r = 0; r < 16; ++r) { const int orow = crow(r, hi);
      #pragma unroll
      for (int d0 = 0; d0 < 2; ++d0) { const int ix = orow * 64 + d0 * 32 + r32; o1s[ix] = o1s[ix] - lam * (o[d0][r] * rli[r]); } }
    asm volatile("s_waitcnt lgkmcnt(0)" ::: "memory");
    #pragma unroll
    for (int i = 0; i < 4; ++i) { const int row = i * 8 + (lane >> 3), ch = lane & 7;
      const f32x4 a = *(const f32x4*)(o1s + row * 64 + ch * 8), b = *(const f32x4*)(o1s + row * 64 + ch * 8 + 4);
      float ss = (a[0] * a[0] + a[1] * a[1]) + (a[2] * a[2] + a[3] * a[3]) + (b[0] * b[0] + b[1] * b[1]) + (b[2] * b[2] + b[3] * b[3]);
      ss += __builtin_bit_cast(float, __builtin_amdgcn_update_dpp(0, __builtin_bit_cast(int, ss), 0xB1, 0xf, 0xf, false));
      ss += __builtin_bit_cast(float, __builtin_amdgcn_update_dpp(0, __builtin_bit_cast(int, ss), 0x4E, 0xf, 0xf, false));
      ss += __builtin_bit_cast(float, __builtin_amdgcn_update_dpp(0, __builtin_bit_cast(int, ss), 0x141, 0xf, 0xf, false));
      const float rs = post / sqrtf(ss * (1.0f / 64.0f) + EPS);
      const f32x4 g0 = *(const f32x4*)(gsub + ch * 8), g1 = *(const f32x4*)(gsub + ch * 8 + 4);
      u32x4 v; v.x = pk2(a[0] * rs * g0[0], a[1] * rs * g0[1]); v.y = pk2(a[2] * rs * g0[2], a[3] * rs * g0[3]); v.z = pk2(b[0] * rs * g1[0], b[1] * rs * g1[1]); v.w = pk2(b[2] * rs * g1[2], b[3] * rs * g1[3]);
      *(u32x4*)(Ow + (long)row * op + ch * 8) = v; }
  }
  asm volatile("s_waitcnt lgkmcnt(0)\n\ts_barrier" ::: "memory");
  #undef DMA_K
  #undef DMA_V
  #undef START
  #undef RESC
  #undef ROT
}
#undef SBAR
#undef WAIT_BAR
}
__device__ __forceinline__ void norm2_rows(Frame& F, int l) {
    F.tid = opaque_tid(F.wv); F.lane = F.tid & 63; F.wave = __builtin_amdgcn_readfirstlane(F.tid >> 6);
    const int gw = F.bid * NWAVES + F.wave, NGW = F.G * NWAVES;
    const bool moe = l & 1, last = l == DEPTH - 1; const int li = l >> 1;
    const float* gain = INP(F, I_NFFN) + l * DM;
    const float* wr = INP(F, I_ROUTER) + (size_t)li * DM * NEXP;
    unsigned* cw = F.ctl + CW_MOE + li * NEXP * 64;
    int* TOK = (int*)(F.ws + WS_TOK); float* GWT = (float*)(F.ws + WS_GW);
    LAS int* lcnt = (LAS int*)F.lds;
    LAS int* lbase = lcnt + 8;
    LAS int* nrec = lcnt + 16;
    LAS int* rec_m = lcnt + 32;
    LAS int* rec_e = rec_m + 1024;
    LAS float* rec_g = (LAS float*)(rec_e + 1024);
    f32x4 wreg[16][2];
    if (moe) { __syncthreads(); if (F.tid < 17) lcnt[F.tid] = 0; __syncthreads();
#pragma unroll
        for (int j = 0; j < 4; ++j)
#pragma unroll
            for (int q = 0; q < 4; ++q) { const int col = 4 * F.lane + 256 * j + q; wreg[4 * j + q][0] = *(const f32x4*)(wr + (size_t)col * NEXP); wreg[4 * j + q][1] = *(const f32x4*)(wr + (size_t)col * NEXP + 4); } }
    f32x4 cur[4], nxt[4], nx2[4]; load_xrow(F, gw, 0, cur); load_xrow(F, (gw + NGW < MT) ? gw + NGW : gw, 0, nxt);
    for (int m = gw; m < MT; m += NGW) {
        const int mn = (m + 2 * NGW < MT) ? m + 2 * NGW : m;
        float h[16];
        const bool skip = last && (m % TB) >= SEQ;
        if (!skip) norm_row(F, l, m, 3, 0, h, true, cur, mn, nx2); else load_xrow(F, mn, 0, nx2);
#pragma unroll
        for (int j = 0; j < 4; ++j) { cur[j] = nxt[j]; nxt[j] = nx2[j]; }
        if (skip) continue;
        if (moe) {
            float lg[NEXP];
#pragma unroll
            for (int e = 0; e < NEXP; ++e) lg[e] = 0.f;
#pragma unroll
            for (int j = 0; j < 4; ++j)
#pragma unroll
                for (int q = 0; q < 4; ++q) { const f32x4 w0 = wreg[4 * j + q][0], w1 = wreg[4 * j + q][1]; const float hv = h[4 * j + q];
                    lg[0] += hv * w0[0]; lg[1] += hv * w0[1]; lg[2] += hv * w0[2]; lg[3] += hv * w0[3]; lg[4] += hv * w1[0]; lg[5] += hv * w1[1]; lg[6] += hv * w1[2]; lg[7] += hv * w1[3]; }
#pragma unroll
            for (int e = 0; e < NEXP; ++e) lg[e] = wave_sum(lg[e]);
            int e1 = 0; float v1 = lg[0];
#pragma unroll
            for (int e = 1; e < NEXP; ++e) if (lg[e] > v1) { v1 = lg[e]; e1 = e; }
            int e2 = -1; float v2 = -INFINITY;
#pragma unroll
            for (int e = 0; e < NEXP; ++e) if (e != e1 && lg[e] > v2) { v2 = lg[e]; e2 = e; }
            const float g1 = 1.0f / (1.0f + __expf(v2 - v1)), g2 = 1.0f - g1;
            if (F.lane < 2) { const int e = F.lane ? e2 : e1; const float g = F.lane ? g2 : g1;
                const int rank = __hip_atomic_fetch_add(lcnt + e, 1, __ATOMIC_RELAXED, __HIP_MEMORY_SCOPE_WORKGROUP);
                const int slot = __hip_atomic_fetch_add(nrec, 1, __ATOMIC_RELAXED, __HIP_MEMORY_SCOPE_WORKGROUP);
                rec_m[slot] = (int)((unsigned)m | ((unsigned)F.lane << 31)); rec_e[slot] = (e << 16) | rank; rec_g[slot] = g; }
        }
    }
    if (moe) {
        __syncthreads();
        if (F.tid < NEXP) lbase[F.tid] = (int)__hip_atomic_fetch_add(cw + F.tid * 64, (unsigned)lcnt[F.tid], RLX_AGENT);
        __syncthreads();
        const int n = nrec[0];
        for (int i = F.tid; i < n; i += NTHR) { const int er = rec_e[i], e = er >> 16, pos = lbase[e] + (er & 0xffff);
            TOK[(size_t)e * MT + pos] = rec_m[i]; GWT[(size_t)e * MT + pos] = rec_g[i]; }
        __syncthreads();
    }
}
__device__ __forceinline__ void final_rows(Frame& F) {
    F.tid = opaque_tid(F.wv); F.lane = F.tid & 63; F.wave = __builtin_amdgcn_readfirstlane(F.tid >> 6);
    const int gw = F.bid * NWAVES + F.wave, NGW = F.G * NWAVES; const int l = DEPTH - 1;
    const float* MODS = (const float*)(F.ws + WS_MODS);
    for (int i = gw; i < NB * SEQ; i += NGW) { const int b = i / SEQ, t = i - b * SEQ; const int m = b * TB + t;
        GAS f32x4* xr = (GAS f32x4*)(F.out + (size_t)i * DM) + F.lane;
        const bf16_t* sl = (const bf16_t*)(F.ws + WS_SLOT) + (size_t)m * 2 * DM; const float* m5 = MODS + ((size_t)l * 9 + b) * 6144 + 5 * DM;
#pragma unroll
        for (int j = 0; j < 4; ++j) { const int col = 4 * F.lane + 256 * j; f32x4 v = xr[64 * j];
            const u32x2 s0 = *(const u32x2*)(sl + col), s1 = *(const u32x2*)(sl + DM + col); const f32x4 mq = *(const f32x4*)(m5 + col);
            v[0] += mq[0] * (bf_lo(s0.x) + bf_lo(s1.x)); v[1] += mq[1] * (bf_hi(s0.x) + bf_hi(s1.x)); v[2] += mq[2] * (bf_lo(s0.y) + bf_lo(s1.y)); v[3] += mq[3] * (bf_hi(s0.y) + bf_hi(s1.y));
            xr[64 * j] = v; } }
}

struct Args { const float* in[42]; float* out; unsigned char* ws; };

#define PHASE_BEGIN { F.tid = opaque_tid(F.wv); F.lane = F.tid & 63; F.wave = __builtin_amdgcn_readfirstlane(F.tid >> 6); \
    F.ws = (unsigned char*)opaque_ptr(args.ws); F.ctl = (unsigned*)(F.ws + WS_CTL); F.out = (float*)(GAS float*)opaque_ptr(args.out);
#define PHASE_END   { XcdBarrier b2_ = bar; b2_.bar = (unsigned*)opaque_ptr(F.ctl + CW_BAR); unsigned x_ = __builtin_amdgcn_readfirstlane(bar.x); asm volatile("" : "+s"(x_)); b2_.x = x_; xcd_barrier(b2_); } }
template <int l> __device__ __forceinline__ void layer_phases(Frame& F, const Args& args, const XcdBarrier& bar, LAS unsigned* misc, const int vcu, const XMap& X, unsigned char* lds) {
        constexpr bool last = l == DEPTH - 1, moe = l & 1; constexpr int li = l >> 1;

        PHASE_BEGIN
            __syncthreads();
            for (int c = F.bid; c < 256; c += F.G) hyena_filter_unit(F, l, c);
            __syncthreads();
            convert_weights(F, l);
            { const int gw = F.bid * NWAVES + F.wave, NGW = F.G * NWAVES; const float* gain = INP(F, I_NMIX) + l * DM; const int mode = (l == 0) ? 1 : ((l & 1) ? 0 : 2); float h[16];
              f32x4 cur[4], nxt[4], nx2[4]; load_xrow(F, gw, mode, cur); load_xrow(F, (gw + NGW < MT) ? gw + NGW : gw, mode, nxt);
              for (int m = gw; m < MT; m += NGW) { const int mn = (m + 2 * NGW < MT) ? m + 2 * NGW : m;
                  norm_row(F, l, m, 0, mode, h, true, cur, mn, nx2);
#pragma unroll
                  for (int j = 0; j < 4; ++j) { cur[j] = nxt[j]; nxt[j] = nx2[j]; } } }
        PHASE_END
        PHASE_BEGIN
            SchedPlain S; S.init((const bf16_t*)(F.ws + WS_HB), (const bf16_t*)(F.ws + WS_WIN), NPAN, D_IN / 256, DM, F.G, F.bid);
            EpiInProj E{(bf16_t*)(F.ws + WS_UB), (bf16_t*)(F.ws + WS_RB)};
            pg8::gemm_phase<EpiInProj, SchedPlain, false, false>(F.lds, DM, S, E, F.wv);
        PHASE_END
        PHASE_BEGIN
            for (int u = F.bid; u < NB * 68 * 3; u += F.G) hyena_short_unit(F, l, u);
            for (int u = F.bid; u < NB * 136; u += F.G) conformer_unit(F, l, u);
            qk_prep_tables(F);
            qk_prep_items(F, l);
        PHASE_END
        PHASE_BEGIN
            __syncthreads();
            const bf16_t* QG = (const bf16_t*)(F.ws + WS_QG); const bf16_t* KG = (const bf16_t*)(F.ws + WS_KG); const bf16_t* QD = (const bf16_t*)(F.ws + WS_QD); const bf16_t* KD = (const bf16_t*)(F.ws + WS_KD);
            const bf16_t* UB = (const bf16_t*)(F.ws + WS_UB); bf16_t* YB = (bf16_t*)(F.ws + WS_YB);
#pragma unroll 1
            for (int i = 0; i < 3; ++i) {
                int b, hq, kvh, NT; size_t row0, kv0;
                if (i < 2) { const int U = vcu + F.G * i; if (U >= 512) continue; const int pr = U >> 5, w = U & 31; b = pr >> 1; kvh = pr & 1; hq = kvh * 2 + (w >> 4); row0 = (size_t)b * TB + (w & 15) * 256; kv0 = (size_t)b * TB; NT = 68; }
                else { if (last || F.bid >= 32) continue; b = F.bid >> 2; hq = F.bid & 3; kvh = hq >> 1; row0 = (size_t)b * TB + SEQ; kv0 = row0; NT = 4; }
                attn_body::attn_unit<8, 0>(QG + row0 * 256 + hq * 64, 256, KG + kv0 * 128 + kvh * 64, 128, UB + kv0 * UBW + OFF_GQA + 384 + kvh * 64, UBW, NT,
                                           YB + row0 * DM + 512 + hq * 64, DM, (char*)lds, 0.f, nullptr, 0.f, F.wv);
            }
            float lam, post; const float* gsub = INP(F, I_SUBLN) + l * 64;
            { float s1 = 0.f, s2 = 0.f;
              for (int i = 0; i < 32; ++i) { s1 += INP(F, I_LQ1)[l * 32 + i] * INP(F, I_LK1)[l * 32 + i]; s2 += INP(F, I_LQ2)[l * 32 + i] * INP(F, I_LK2)[l * 32 + i]; }
              const float lam_init = 0.8f - 0.6f * expf(-0.3f * (float)l); lam = expf(s1) - expf(s2) + lam_init; post = 1.0f - lam_init; }
#pragma unroll 1
            for (int i = 0; i < 3; ++i) {
                int b, h, NT; size_t row0, kv0;
                if (i < 2) { const int U = vcu + F.G * i; if (U >= 512) continue; const int pr = U >> 4; b = pr >> 2; h = pr & 3; row0 = (size_t)b * TB + (U & 15) * 256; kv0 = (size_t)b * TB; NT = 68; }
                else { if (last || F.bid < 32 || F.bid >= 64) continue; const int u = F.bid - 32; b = u >> 2; h = u & 3; row0 = (size_t)b * TB + SEQ; kv0 = row0; NT = 4; }
                const bf16_t* Vh = UB + kv0 * UBW + OFF_DIFF + 512 + h * 64;
                attn_body::attn_unit<8, 1, 32>(QD + row0 * 256 + (h * 2) * 32, 256, KD + kv0 * 256 + (h * 2) * 32, 256, Vh, UBW, NT, nullptr, 0, (char*)lds, 0.f, nullptr, 0.f, F.wv);
                attn_body::attn_unit<8, 2, 32>(QD + row0 * 256 + (h * 2 + 1) * 32, 256, KD + kv0 * 256 + (h * 2 + 1) * 32, 256, Vh, UBW, NT, YB + row0 * DM + 768 + h * 64, DM, (char*)lds, lam, gsub, post, F.wv);
            }
            if (!last) hyena_ctx_unit(F, l, F.bid);
            __syncthreads();
#pragma unroll 1
            for (int i = 0; i < 2; ++i) { const int U = vcu * 2 + i; if (U < 512) hyena_conv_unit(F, l, U); }
        PHASE_END
        PHASE_BEGIN
            SchedPlain S; S.init((const bf16_t*)(F.ws + WS_YB), (const bf16_t*)(F.ws + WS_WBR), NPAN, 4, DM, F.G, F.bid, last);
            EpiMerge E{(const bf16_t*)(F.ws + WS_RB), (bf16_t*)(F.ws + WS_HB)};
            pg8::gemm_phase<EpiMerge, SchedPlain, false, true>(F.lds, DM, S, E, F.wv);
        PHASE_END
        PHASE_BEGIN
            SchedPlain S; S.init((const bf16_t*)(F.ws + WS_HB), (const bf16_t*)(F.ws + WS_WOUT), NPAN, 4, DM, F.G, F.bid, last);
            EpiResid E{X, (const float*)(F.ws + WS_MODS) + (size_t)l * 9 * 6144 + 2 * DM, last, l == 0 ? INP(F, I_X) : (const float*)X.lat, l == 0 ? INP(F, I_CTX) : (const float*)X.ctx};
            pg8::gemm_phase<EpiResid, SchedPlain, false, false, false>(F.lds, DM, S, E, F.wv);
            if (!last && F.bid >= NPAN * 4 - 2 * F.G) convert_ffn_queue(F, l + 1, 1);
        PHASE_END
        PHASE_BEGIN
            norm2_rows(F, l);
        PHASE_END
        PHASE_BEGIN
            if (!moe) {
                SchedPlain S; S.init((const bf16_t*)(F.ws + WS_HB), (const bf16_t*)(F.ws + WS_WF1), NPAN, 2 * DFF / 256, DM, F.G, F.bid);
                EpiSwiGLU E{(bf16_t*)(F.ws + WS_HID), DFF};
                pg8::gemm_phase<EpiSwiGLU, SchedPlain, false, false>(F.lds, DM, S, E, F.wv);
            } else {
                LAS int* mi = (LAS int*)(misc + 16);
                __syncthreads();
                if (F.tid == 0) moe_info_build(mi, F.ctl + CW_MOE + li * NEXP * 64);
                __syncthreads();
                SchedMoeUp S; S.I.p = mi; S.nN = 2 * DFFE / 256; S.G = F.G; S.c = F.bid; S.A = (const char*)(F.ws + WS_HB); S.W = (const char*)(F.ws + WS_WM13); S.tok = (const int*)(F.ws + WS_TOK);
                S.wstride = (size_t)2 * DFFE * DM * 2; S.tstep = (size_t)256 * DM * 2;
                EpiSwiGLU E{(bf16_t*)(F.ws + WS_HID), DFFE};
                pg8::gemm_phase<EpiSwiGLU, SchedMoeUp, true, false>(F.lds, DM, S, E, F.wv);
            }
        PHASE_END
        PHASE_BEGIN
            int bgq = 0;
            if (!moe) {
                SchedPlain S; S.init((const bf16_t*)(F.ws + WS_HID), (const bf16_t*)(F.ws + WS_WF2), NPAN, 4, DFF, F.G, F.bid);
                EpiResid E{X, (const float*)(F.ws + WS_MODS) + (size_t)l * 9 * 6144 + 5 * DM, last, (const float*)X.lat, (const float*)X.ctx};
                pg8::gemm_phase<EpiResid, SchedPlain, false, false, false>(F.lds, DFF, S, E, F.wv);
                if (!last && F.bid >= NPAN * 4 - 2 * F.G) bgq = 2;
            } else {
                LAS int* mi = (LAS int*)(misc + 16);
                __syncthreads();
                if (F.tid == 0) moe_info_build(mi, F.ctl + CW_MOE + li * NEXP * 64);
                __syncthreads();
                SchedMoeDown S; S.I.p = mi; S.nN = 4; S.G = F.G; S.c = F.bid; S.A = (const char*)(F.ws + WS_HID); S.W = (const char*)(F.ws + WS_WM2);
                S.wstride = (size_t)DM * DFFE * 2; S.tstepA = (size_t)256 * DFFE * 2; S.tstepB = (size_t)256 * DFFE * 2;
                MoeInfo I2; I2.p = mi;
                EpiMoeDown E{&I2, (const int*)(F.ws + WS_TOK), (const float*)(F.ws + WS_GW), (bf16_t*)(F.ws + WS_SLOT)};
                pg8::gemm_phase<EpiMoeDown, SchedMoeDown, false, false>(F.lds, DFFE, S, E, F.wv);
                if (!last) { const int n = mi[16] * 4; const int rounds = (n + F.G - 1) / F.G; if (F.bid >= n - (rounds - 1) * F.G) bgq = 2; }
            }
            if (bgq) convert_ffn_queue(F, l + 1, bgq);
        PHASE_END
    }
__global__ void __launch_bounds__(NTHR, 2) mk_fwd(Args args) {
    extern __shared__ __attribute__((aligned(16))) unsigned char lds[];
    Frame F;
    F.lds = (LAS unsigned char*)lds; F.tid = threadIdx.x; F.lane = F.tid & 63; F.wave = __builtin_amdgcn_readfirstlane(F.tid >> 6); F.wv = F.wave;
    F.G = gridDim.x; F.bid = blockIdx.x; F.in = args.in; F.ws = args.ws; F.out = args.out; F.ctl = (unsigned*)(args.ws + WS_CTL);
    LAS unsigned* misc = (LAS unsigned*)(F.lds + MISC_OFF);
    if (F.tid < 64) misc[F.tid] = 0u;
    __syncthreads();
    XcdBarrier bar = xcd_barrier_post(F.ctl + CW_BAR, (volatile LAS unsigned*)(misc + 8));
    const int vcu = (F.G % 8 == 0) ? (F.bid % 8) * (F.G / 8) + F.bid / 8 : F.bid;
    XMap X{F.out, (float*)(F.ws + WS_XC)};

    PHASE_BEGIN
        p0_mods(F); p0_a3(F); p0_zero_rows(F);
    PHASE_END

    layer_phases<0>(F, args, bar, misc, vcu, X, lds); layer_phases<1>(F, args, bar, misc, vcu, X, lds); layer_phases<2>(F, args, bar, misc, vcu, X, lds); layer_phases<3>(F, args, bar, misc, vcu, X, lds);
    { F.tid = opaque_tid(F.wv); F.lane = F.tid & 63; F.wave = __builtin_amdgcn_readfirstlane(F.tid >> 6);
      final_rows(F); }
#undef PHASE_BEGIN
#undef PHASE_END
}

extern "C" void kernel_launch(void* const* d_in, const int* in_sizes, int n_in, void* d_out, int out_size, void* d_ws, size_t ws_size, hipStream_t stream) {
    static int grid = 0;
    if (grid == 0) {
        if (n_in != 42 || in_sizes[0] != NB * SEQ * DM || out_size != NB * SEQ * DM || ws_size < WS_END) { fprintf(stderr, "kernel_launch: unexpected shapes (n_in %d, ws %zu)\n", n_in, ws_size); grid = -1; return; }
        int dev = 0, cus = 0;
        if (hipGetDevice(&dev) != hipSuccess || hipDeviceGetAttribute(&cus, hipDeviceAttributeMultiprocessorCount, dev) != hipSuccess) { grid = -1; return; }
        if (hipFuncSetAttribute((const void*)mk_fwd, hipFuncAttributeMaxDynamicSharedMemorySize, LDS_BYTES) != hipSuccess) { fprintf(stderr, "kernel_launch: hipFuncSetAttribute failed\n"); grid = -1; return; }
        int per_cu = 0;
        if (hipOccupancyMaxActiveBlocksPerMultiprocessor(&per_cu, (const void*)mk_fwd, NTHR, LDS_BYTES) != hipSuccess || per_cu < 1) fprintf(stderr, "kernel_launch: occupancy query reports %d\n", per_cu);
        (void)hipGetLastError();
        if (cus < 256) { fprintf(stderr, "kernel_launch: built for a 256-CU device (one resident workgroup per CU), found %d\n", cus); grid = -1; return; }
        grid = 256;
    }
    if (grid < 0) return;
    if (hipMemsetAsync((char*)d_ws + WS_CTL, 0, CTL_ZERO_BYTES, stream) != hipSuccess) return;
    Args a{};
    for (int i = 0; i < 42; ++i) a.in[i] = (const float*)d_in[i];
    a.out = (float*)d_out; a.ws = (unsigned char*)d_ws;
    hipLaunchKernelGGL(mk_fwd, dim3(grid), dim3(NTHR), LDS_BYTES, stream, a);
}
```

```cpp
#include <hip/hip_runtime.h>
#include <hip/hip_bf16.h>
#include <cstdio>
#include <cstdint>
#include <cmath>

#define GAS __attribute__((address_space(1)))
#define LAS __attribute__((address_space(3)))
typedef unsigned short bf16_t;
typedef short bf16x8 __attribute__((ext_vector_type(8)));
typedef float f32x4 __attribute__((ext_vector_type(4)));
typedef float f32x2 __attribute__((ext_vector_type(2)));
typedef float f32x16 __attribute__((ext_vector_type(16)));
typedef unsigned u32x4 __attribute__((ext_vector_type(4)));
typedef unsigned u32x2 __attribute__((ext_vector_type(2)));
typedef short s16x4 __attribute__((ext_vector_type(4)));
#define RLX_AGENT __ATOMIC_RELAXED, __HIP_MEMORY_SCOPE_AGENT
#define LDS_WAIT() asm volatile("s_waitcnt lgkmcnt(0)" ::: "memory")
#define VM_WAIT() asm volatile("s_waitcnt vmcnt(0)" ::: "memory")

constexpr int DM = 1024, NB = 8, SEQ = 4096, NCTX = 256, DEPTH = 4;
constexpr int TB = SEQ + NCTX;
constexpr int MT = NB * TB;
constexpr int UBW = 2560;
constexpr int OFF_CF = 768, OFF_GQA = 1280, OFF_DIFF = 1792, OFF_GATE = 2560, D_IN = 6656;
constexpr int DFF = 2816, DFFE = 3584, NEXP = 8;
constexpr int NPAN = MT / 256;
constexpr float EPS = 1e-6f;
constexpr float LOG2E = 1.4426950408889634f;

constexpr size_t MiB = 1u << 20;
constexpr size_t WS_CTL = 0, CTL_ZERO_BYTES = 65536;
constexpr size_t WS_MODS = 1 * MiB;
constexpr size_t WS_A3 = 2 * MiB;
constexpr size_t WS_XC = 8 * MiB;
constexpr size_t WS_HB = 16 * MiB;
constexpr size_t WS_UB = 86 * MiB;
constexpr size_t WS_RB = 256 * MiB;
constexpr size_t WS_YB = 528 * MiB;
constexpr size_t WS_QG = 596 * MiB;
constexpr size_t WS_KG = 613 * MiB;
constexpr size_t WS_QD = 622 * MiB;
constexpr size_t WS_KD = 656 * MiB;
constexpr size_t WS_HT = 690 * MiB;
constexpr size_t WS_KF = 744 * MiB;
constexpr size_t WS_KC = 776 * MiB;
constexpr size_t WS_WIN = 778 * MiB;
constexpr size_t WS_WBR = 791 * MiB;
constexpr size_t WS_WOUT = 793 * MiB;
constexpr size_t WS_WF1 = 795 * MiB;
constexpr size_t WS_WF2 = 806 * MiB;
constexpr size_t WS_WM13 = 812 * MiB;
constexpr size_t WS_WM2 = 924 * MiB;
constexpr size_t WS_TOK = 980 * MiB;
constexpr size_t WS_GW = 982 * MiB;
constexpr size_t WS_END = 984 * MiB;
constexpr size_t WS_HID = WS_UB;
constexpr size_t WS_SLOT = 576 * MiB;
constexpr int CW_TMO = 0, CW_BAR = 4096, CW_MOE = 8192, CW_Q = 12288;

constexpr int LDS_BYTES = 163840, MISC_OFF = LDS_BYTES - 256;
constexpr int NWAVES = 8, NTHR = 512;

__device__ __forceinline__ unsigned f2bf(float f) { unsigned u = __builtin_bit_cast(unsigned, f); return (u + 0x7fffu + ((u >> 16) & 1u)) >> 16; }
__device__ __forceinline__ unsigned pk2(float lo, float hi) { return f2bf(lo) | (f2bf(hi) << 16); }
typedef __bf16 bf16x2_v __attribute__((ext_vector_type(2)));
__device__ __forceinline__ unsigned cvt_pk_bf16(float lo, float hi) { f32x2 v = {lo, hi}; bf16x2_v b = __builtin_convertvector(v, bf16x2_v); return __builtin_bit_cast(unsigned, b); }
__device__ __forceinline__ float bf_lo(unsigned w) { return __uint_as_float(w << 16); }
__device__ __forceinline__ float bf_hi(unsigned w) { return __uint_as_float(w & 0xffff0000u); }
__device__ __forceinline__ float bf2f(bf16_t b) { return __uint_as_float(((unsigned)b) << 16); }
template <int N> __device__ __forceinline__ float dpp_row_ror(float v) { return __builtin_bit_cast(float, __builtin_amdgcn_update_dpp(0, __builtin_bit_cast(int, v), 0x120 + N, 0xf, 0xf, false)); }
__device__ __forceinline__ float wave_sum(float v) {
    v += dpp_row_ror<1>(v); v += dpp_row_ror<2>(v); v += dpp_row_ror<4>(v); v += dpp_row_ror<8>(v);
    const int iv = __builtin_bit_cast(int, v);
    const float a = __builtin_bit_cast(float, __builtin_amdgcn_readlane(iv, 0)), b = __builtin_bit_cast(float, __builtin_amdgcn_readlane(iv, 16));
    const float c = __builtin_bit_cast(float, __builtin_amdgcn_readlane(iv, 32)), d = __builtin_bit_cast(float, __builtin_amdgcn_readlane(iv, 48));
    return (a + b) + (c + d);
}
__device__ __forceinline__ int opaque_tid(int wv) { int ln; asm volatile("v_mbcnt_lo_u32_b32 %0, -1, 0\n\tv_mbcnt_hi_u32_b32 %0, -1, %0" : "=v"(ln)); return wv * 64 + ln; }
__device__ __forceinline__ GAS unsigned char* opaque_ptr(const void* p) { const unsigned long long v = (unsigned long long)p; unsigned lo = __builtin_amdgcn_readfirstlane((unsigned)v), hi = __builtin_amdgcn_readfirstlane((unsigned)(v >> 32));
    asm volatile("" : "+s"(lo), "+s"(hi)); return (GAS unsigned char*)(((unsigned long long)hi << 32) | lo); }
#define INP(F, i) ((const float*)(const GAS float*)((F).in[i]))
__device__ __forceinline__ float fast_sigmoid(float x) { return __builtin_amdgcn_rcpf(1.0f + __builtin_amdgcn_exp2f(-x * LOG2E)); }

#define XB_TMO      128
#define XB_XCNT(j)  (256  + 64 * (j))
#define XB_XSUB(j)  (1280 + 64 * (j))
#define XB_XGEN(j)  (2304 + 64 * (j))
#define XB_TOP      3328
#define XB_TOPGEN   3392
#define XCD_BAR_WORDS 3456
#define XB_SPIN_CAP (1u << 18)
__device__ __forceinline__ unsigned xb_ld(unsigned* p)              { return __hip_atomic_load(p, __ATOMIC_RELAXED, __HIP_MEMORY_SCOPE_AGENT); }
__device__ __forceinline__ unsigned xb_add(unsigned* p, unsigned v) { return __hip_atomic_fetch_add(p, v, __ATOMIC_RELAXED, __HIP_MEMORY_SCOPE_AGENT); }
__device__ __forceinline__ unsigned xb_xcc_id() { return (unsigned)__builtin_amdgcn_s_getreg((3 << 11) | 20) & 0xFu; }
#define XB_SPIN(cond, bar) do { unsigned _sp = 0; while (cond) { __builtin_amdgcn_s_sleep(1); \
    if ((++_sp & 255u) == 0u) { if (xb_ld(&(bar)[XB_TMO])) break; if (_sp > XB_SPIN_CAP) { atomicAdd(&(bar)[XB_TMO], 1u); break; } } } } while (0)
struct XcdBarrier { unsigned* bar; unsigned x; volatile LAS unsigned* st; };
__device__ __forceinline__ XcdBarrier xcd_barrier_post(unsigned* bar, volatile LAS unsigned* st) {
    XcdBarrier b; b.bar = bar; b.x = xb_xcc_id(); b.st = st;
    if (threadIdx.x == 0) (void)xb_add(&bar[XB_XCNT(b.x)], 1u);
    return b;
}
__device__ __forceinline__ void xcd_barrier_complete(unsigned* bar, unsigned x, unsigned& nloc, unsigned& nx) {
    const unsigned G = gridDim.x * gridDim.y * gridDim.z;
    unsigned sum, cnt, mine, sp = 0u;
    for (;;) {
        sum = 0u; cnt = 0u; mine = 0u;
#pragma unroll
        for (unsigned j = 0; j < 16; ++j) { const unsigned c = xb_ld(&bar[XB_XCNT(j)]); sum += c; cnt += (c > 0u) ? 1u : 0u; mine = (j == x) ? c : mine; }
        if (sum == G) break;
        __builtin_amdgcn_s_sleep(1);
        if ((++sp & 255u) == 0u) { if (xb_ld(&bar[XB_TMO])) break; if (sp > XB_SPIN_CAP) { atomicAdd(&bar[XB_TMO], 1u); break; } }
    }
    nloc = mine > 0u ? mine : 1u; nx = cnt > 0u ? cnt : 1u;
}
__device__ __forceinline__ void xcd_barrier(const XcdBarrier& b) {
    asm volatile("s_waitcnt vmcnt(0)" ::: "memory");
    __syncthreads();
    if (threadIdx.x == 0) {
        unsigned* bar = b.bar;
        __builtin_amdgcn_s_waitcnt(0);
        unsigned nloc = b.st[0], nx = b.st[1];
        if (nloc == 0u) { xcd_barrier_complete(bar, b.x, nloc, nx); b.st[0] = nloc; b.st[1] = nx; }
        const unsigned old = xb_add(&bar[XB_XSUB(b.x)], 1u);
        const unsigned gen = old / nloc;
        if (old + 1u == (gen + 1u) * nloc) {
            __builtin_amdgcn_fence(__ATOMIC_RELEASE, "agent");
            asm volatile("s_waitcnt vmcnt(0)" ::: "memory");
            const unsigned og = xb_add(&bar[XB_TOP], 1u);
            const unsigned tg = og / nx;
            if (og + 1u == (tg + 1u) * nx) xb_add(&bar[XB_TOPGEN], 1u);
            else XB_SPIN(xb_ld(&bar[XB_TOPGEN]) == tg, bar);
            __builtin_amdgcn_fence(__ATOMIC_ACQUIRE, "agent");
            xb_add(&bar[XB_XGEN(b.x)], 1u);
            asm volatile("s_waitcnt vmcnt(0)" ::: "memory");
        } else {
            XB_SPIN(xb_ld(&bar[XB_XGEN(b.x)]) == gen, bar);
            __builtin_amdgcn_fence(__ATOMIC_ACQUIRE, "agent");
            asm volatile("s_waitcnt vmcnt(0)" ::: "memory");
        }
    }
    __syncthreads();
}

namespace pg8 {
constexpr int BM = 256, BK = 64, HALF = 128, HTB = HALF * BK * 2, STAGE_BYTES = 8 * HTB, NXCD = 8, WGM = 8;
__host__ __device__ __forceinline__ int lds_byte(int r, int c) { const int st = (r >> 4) * 2 + (c >> 5), rr = r & 15, cc = c & 31, ob = rr * 64 + cc * 2; return st * 1024 + (ob ^ (((ob >> 9) & 1) << 5)); }
__host__ __device__ __forceinline__ void stage_rc(int b, int& R, int& C) { const int st = b / 1024, sb = b % 1024, swz = sb ^ (((sb >> 9) & 1) << 5); R = (st >> 1) * 16 + swz / 64; C = (st & 1) * 32 + (swz % 64) / 2; }
__host__ __device__ __forceinline__ int perm32(int rho) { const int n = rho >> 4, i = rho & 15; return 8 * (i >> 2) + 4 * n + (i & 3); }

struct Unit { int pm, pn; const char* a; const char* b; int aux; };

struct GridOrder {
    int nM, nN, nwg, G, c;
    __device__ void init(int nM_, int nN_, int G_, int c_) { nM = nM_; nN = nN_; nwg = nM * nN; G = G_; c = c_; }
    __device__ __forceinline__ bool tile(int i, int& pm, int& pn) const {
        const long L = (long)i * G + c; if (L >= nwg) return false;
        int wgid = (int)L; { const int q = nwg / NXCD, r = nwg % NXCD, xcd = wgid % NXCD, off = wgid / NXCD; wgid = (xcd < r ? xcd * (q + 1) : r * (q + 1) + (xcd - r) * q) + off; }
        const int nig = WGM * nN, gid = wgid / nig, fm = gid * WGM, gsz = (nM - fm) < WGM ? (nM - fm) : WGM;
        pm = fm + ((wgid % nig) % gsz); pn = (wgid % nig) / gsz; return true;
    }
};

template <class Epi, class Sched, bool GATHER = false, bool HOOK = false, bool ALIGN = true>
__device__ __forceinline__ void gemm_phase(LAS unsigned char* lds, const int K, const Sched& S, const Epi& E, const int wv) {
    const int tid = opaque_tid(wv), wid = __builtin_amdgcn_readfirstlane(tid >> 6), lane = tid & 63, wr = wid >> 2, wc = wid & 3, fr = lane & 15, fq = lane >> 4;
    const int nt = K / BK;
    unsigned voffB[2], vA0[2], vA1[2], nA0[2], nA1[2];
#pragma unroll
    for (int i = 0; i < 2; ++i) { int R, C; stage_rc(tid * 16 + i * 8192, R, C); const int Rb = Epi::PERM ? ((R & ~31) + perm32(R & 31)) : R;
        vA0[i] = (unsigned)(R * K + C) * 2u; vA1[i] = 0u; voffB[i] = (unsigned)(Rb * K + C) * 2u; nA0[i] = 0u; nA1[i] = 0u; }
#define PG8_RR(i) ((((wid + 8 * (i)) >> 1) << 4) + (lane >> 2))
    const size_t kstep = (size_t)(BK * 2);
    const size_t hstep = (size_t)HALF * K * 2;
    const unsigned ldsw = (unsigned)wid * 1024u;
    const int aoff = lds_byte(wr * 64 + fr, fq * 8), boff = lds_byte(wc * 32 + fr, fq * 8);
#define PG8_SA(b, h) (((b) * 2 + (h)) * HTB)
#define PG8_SB(b, h) ((4 + (b) * 2 + (h)) * HTB)
#define PG8_STAGE(bufoff, gbase, voff) do { _Pragma("unroll") for (int _i = 0; _i < 2; ++_i) \
        __builtin_amdgcn_global_load_lds((const unsigned*)((const char*)(gbase) + (voff)[_i]), (LAS unsigned*)(lds + (bufoff) + ldsw + _i * 8192), 16, 0, 0); } while (0)
#define PG8_LDA(dst, b, h) do { _Pragma("unroll") for (int m = 0; m < 4; ++m) _Pragma("unroll") for (int k = 0; k < 2; ++k) dst[m][k] = *(const LAS bf16x8*)(lds + PG8_SA(b, h) + aoff + m * 2048 + k * 1024); } while (0)
#define PG8_LDB(dst, b, h) do { _Pragma("unroll") for (int n = 0; n < 2; ++n) _Pragma("unroll") for (int k = 0; k < 2; ++k) dst[n][k] = *(const LAS bf16x8*)(lds + PG8_SB(b, h) + boff + n * 2048 + k * 1024); } while (0)
#define PG8_MMA(ai, bj, At, Bt) do { __builtin_amdgcn_s_setprio(1); _Pragma("unroll") for (int m = 0; m < 4; ++m) _Pragma("unroll") for (int n = 0; n < 2; ++n) _Pragma("unroll") for (int k = 0; k < 2; ++k) \
        acc[ai][bj][m][n] = __builtin_amdgcn_mfma_f32_16x16x32_bf16(Bt[n][k], At[m][k], acc[ai][bj][m][n], 0, 0, 0); __builtin_amdgcn_s_setprio(0); } while (0)
#define PG8_WAIT_V(n) asm volatile("s_waitcnt vmcnt(" #n ")" ::: "memory")
#define PG8_WAIT_L(n) asm volatile("s_waitcnt lgkmcnt(" #n ")" ::: "memory")
#define PG8_BAR __builtin_amdgcn_s_barrier()
#define PG8_SCHED __builtin_amdgcn_sched_barrier(0)
    Unit cur, nxt; int ui = 0;
    if (!S.next(0, cur)) return;
    f32x4 acc[2][2][4][2];
#pragma unroll
    for (int a = 0; a < 2; ++a)
#pragma unroll
        for (int b = 0; b < 2; ++b)
#pragma unroll
            for (int m = 0; m < 4; ++m)
#pragma unroll
                for (int n = 0; n < 2; ++n) acc[a][b][m][n] = (f32x4){0.f, 0.f, 0.f, 0.f};
    bf16x8 At[4][2], B0[2][2], B1[2][2];
    const char* cA0 = cur.a; const char* cA1 = GATHER ? cur.a : cur.a + hstep; const char* cB = cur.b;
    unsigned ccol[2] = {0u, 0u};
    if constexpr (GATHER) {
#pragma unroll
        for (int i = 0; i < 2; ++i) { ccol[i] = vA0[i] - (unsigned)(PG8_RR(i) * K) * 2u; vA0[i] = S.row_off(cur, PG8_RR(i)) + ccol[i]; vA1[i] = S.row_off(cur, PG8_RR(i) + HALF) + ccol[i]; }
    }
    PG8_STAGE(PG8_SB(0, 0), cB, voffB); PG8_STAGE(PG8_SB(0, 1), cB + hstep, voffB); PG8_STAGE(PG8_SA(0, 0), cA0, vA0); if constexpr (GATHER) { PG8_STAGE(PG8_SA(0, 1), cA1, vA1); } else { PG8_STAGE(PG8_SA(0, 1), cA1, vA0); }
    if (wr == 1) PG8_BAR;
    PG8_WAIT_V(2); PG8_BAR;
    PG8_STAGE(PG8_SB(1, 0), cB + kstep, voffB); PG8_STAGE(PG8_SA(1, 0), cA0 + kstep, vA0); PG8_STAGE(PG8_SB(1, 1), cB + hstep + kstep, voffB);
    PG8_WAIT_V(6); PG8_BAR;
    for (;;) {
        const bool has_next = S.next(ui + 1, nxt);
        const char* nAp0 = has_next ? nxt.a : cA0; const char* nAp1 = has_next ? (GATHER ? nxt.a : nxt.a + hstep) : cA1; const char* nB = has_next ? nxt.b : cB;
        if constexpr (GATHER) {
            if (has_next) {
#pragma unroll
                for (int i = 0; i < 2; ++i) { nA0[i] = S.row_off(nxt, PG8_RR(i)) + ccol[i]; nA1[i] = S.row_off(nxt, PG8_RR(i) + HALF) + ccol[i]; }
            } else {
#pragma unroll
                for (int i = 0; i < 2; ++i) { nA0[i] = vA0[i]; nA1[i] = vA1[i]; }
            }
        }
        for (int t = 0; t < nt; t += 2) {
            const bool last = (t == nt - 2);
            const char* a1h1 = cA1 + (size_t)(t + 1) * kstep;
            const char* a2h0 = last ? nAp0 : cA0 + (size_t)(t + 2) * kstep; const char* a2h1 = last ? nAp1 : cA1 + (size_t)(t + 2) * kstep;
            const char* b2 = last ? nB : cB + (size_t)(t + 2) * kstep;
            const char* a3h0 = a2h0 + kstep; const char* b3 = b2 + kstep;
            unsigned w0[2], w1[2], u1[2];
#pragma unroll
            for (int i = 0; i < 2; ++i) { if constexpr (GATHER) { w0[i] = last ? nA0[i] : vA0[i]; w1[i] = last ? nA1[i] : vA1[i]; u1[i] = vA1[i]; } else { w0[i] = vA0[i]; w1[i] = vA0[i]; u1[i] = vA0[i]; } }
            PG8_LDB(B0, 0, 0); PG8_LDB(B1, 0, 1); PG8_SCHED; PG8_LDA(At, 0, 0); PG8_STAGE(PG8_SA(1, 1), a1h1, u1);
            PG8_WAIT_V(8); PG8_WAIT_L(0); PG8_BAR; PG8_MMA(0, 0, At, B0); PG8_MMA(0, 1, At, B1); PG8_BAR; PG8_SCHED;
            PG8_LDA(At, 0, 1); PG8_STAGE(PG8_SB(0, 0), b2, voffB); PG8_STAGE(PG8_SB(0, 1), b2 + hstep, voffB); PG8_STAGE(PG8_SA(0, 0), a2h0, w0);
            PG8_WAIT_V(8); PG8_WAIT_L(0); PG8_BAR; PG8_MMA(1, 0, At, B0); PG8_MMA(1, 1, At, B1); PG8_BAR; PG8_SCHED;
            PG8_LDB(B0, 1, 0); PG8_LDB(B1, 1, 1); PG8_SCHED; PG8_LDA(At, 1, 0); PG8_STAGE(PG8_SA(0, 1), a2h1, w1);
            PG8_WAIT_V(8); PG8_WAIT_L(0); PG8_BAR; PG8_MMA(0, 0, At, B0); PG8_MMA(0, 1, At, B1); PG8_BAR; PG8_SCHED;
            PG8_LDA(At, 1, 1); PG8_STAGE(PG8_SB(1, 0), b3, voffB); PG8_STAGE(PG8_SB(1, 1), b3 + hstep, voffB); PG8_STAGE(PG8_SA(1, 0), a3h0, w0);
            PG8_WAIT_V(8); PG8_WAIT_L(0); PG8_BAR; PG8_MMA(1, 0, At, B0); PG8_MMA(1, 1, At, B1); PG8_BAR; PG8_SCHED;
            if constexpr (HOOK) { if ((t & 2) && !last) E.hook(acc, cur, t >> 2, wr, wc, fr, fq); }
        }
        if constexpr (ALIGN) { if (wr == 0) PG8_BAR; }
        E(acc, cur, wr, wc, fr, fq);
        if (!has_next) break;
#pragma unroll
        for (int a = 0; a < 2; ++a)
#pragma unroll
            for (int b = 0; b < 2; ++b)
#pragma unroll
                for (int m = 0; m < 4; ++m)
#pragma unroll
                    for (int n = 0; n < 2; ++n) acc[a][b][m][n] = (f32x4){0.f, 0.f, 0.f, 0.f};
        cur = nxt; cA0 = nAp0; cA1 = nAp1; cB = nB; ++ui;
        if constexpr (GATHER) {
#pragma unroll
            for (int i = 0; i < 2; ++i) { vA0[i] = nA0[i]; vA1[i] = nA1[i]; }
        }
        if constexpr (ALIGN) { if (wr == 1) PG8_BAR; }
    }
    PG8_WAIT_V(0);
    if constexpr (!ALIGN) { if (wr == 0) PG8_BAR; }
    PG8_BAR;
#undef PG8_RR
#undef PG8_SA
#undef PG8_SB
#undef PG8_STAGE
#undef PG8_LDA
#undef PG8_LDB
#undef PG8_MMA
#undef PG8_WAIT_V
#undef PG8_WAIT_L
#undef PG8_BAR
#undef PG8_SCHED
}
}
struct XMap { float* lat; float* ctx; };
__device__ __forceinline__ float* xrow(const XMap& X, int m) { const int b = m / TB, t = m - b * TB; return t < SEQ ? X.lat + ((size_t)b * SEQ + t) * DM : X.ctx + ((size_t)b * NCTX + (t - SEQ)) * DM; }
__device__ __forceinline__ int modrow(int m) { const int b = m / TB, t = m - b * TB; return t < SEQ ? b : NB; }

struct SchedPlain {
    pg8::GridOrder O; const char* A; const char* Bt; size_t tstep; bool lat_only;
    __device__ void init(const bf16_t* A_, const bf16_t* Bt_, int nM, int nN, int K, int G, int c, bool lat_only_ = false) { lat_only = lat_only_; O.init(lat_only ? nM - nM / 17 : nM, nN, G, c); A = (const char*)A_; Bt = (const char*)Bt_; tstep = (size_t)256 * K * 2; }
    __device__ __forceinline__ bool next(int i, pg8::Unit& u) const { int pm, pn; if (!O.tile(i, pm, pn)) return false; if (lat_only) pm += pm >> 4; u.pm = pm; u.pn = pn; u.a = A + (size_t)pm * tstep; u.b = Bt + (size_t)pn * tstep; u.aux = 0; return true; }
    __device__ __forceinline__ unsigned row_off(const pg8::Unit&, int) const { return 0u; }
};
struct MoeInfo { const LAS int* p; };
__device__ __forceinline__ void moe_info_build(LAS int* p, const unsigned* cw) {
    int s = 0;
    for (int e = 0; e < NEXP; ++e) { const int c = (int)__hip_atomic_load(cw + e * 64, RLX_AGENT); p[e] = c; p[8 + e] = s; s += (c + 255) >> 8; }
    p[16] = s;
}
__device__ __forceinline__ int moe_expert_of(const MoeInfo& I, int blk) { int e = 0;
#pragma unroll
    for (int j = 1; j < NEXP; ++j) e += (blk >= I.p[8 + j]) ? 1 : 0;
    return e; }
struct SchedMoeUp {
    MoeInfo I; int nN, G, c; const char* A; const char* W; const int* tok; size_t wstride, tstep;
    __device__ __forceinline__ bool next(int i, pg8::Unit& u) const {
        const int nblk = I.p[16]; const long total = (long)nblk * nN;
        long L;
        if (G % 8 == 0) { const int per_x = G / 8; L = ((long)i * 8 + (c & 7)) * per_x + (c >> 3); } else L = (long)i * G + c;
        if (L >= total) return false;
        const int tsz = 4 * nN; const int t4 = (int)(L / tsz), q = (int)(L % tsz); const int b0 = t4 * 4, rb = (nblk - b0) < 4 ? (nblk - b0) : 4;
        const int blk = b0 + q % rb, pn = q / rb;
        const int e = moe_expert_of(I, blk);
        u.pm = blk; u.pn = pn; u.a = A; u.b = W + (size_t)e * wstride + (size_t)pn * tstep; u.aux = e * MT + (blk - I.p[8 + e]) * 256; return true;
    }
    __device__ __forceinline__ unsigned row_off(const pg8::Unit& u, int r) const {
        const int e = u.aux / MT, j0 = u.aux - e * MT; const int valid = I.p[e] - j0;
        int row = MT;
        if (r < valid) row = tok[u.aux + r] & 0x7fffffff;
        return (unsigned)row * (unsigned)(DM * 2);
    }
};
struct SchedMoeDown {
    MoeInfo I; int nN, G, c; const char* A; const char* W; size_t wstride, tstepA, tstepB;
    __device__ __forceinline__ bool next(int i, pg8::Unit& u) const {
        const long L = (long)i * G + c; const int nblk = I.p[16]; if (L >= (long)nblk * nN) return false;
        const int per = 8 * nN; const int g = (int)(L / per), r = (int)(L % per); const int g0 = g * 8, gsz = (nblk - g0) < 8 ? (nblk - g0) : 8;
        const int blk = g0 + r % gsz, pn = r / gsz;
        const int e = moe_expert_of(I, blk);
        u.pm = blk; u.pn = pn; u.a = A + (size_t)blk * tstepA; u.b = W + (size_t)e * wstride + (size_t)pn * tstepB; u.aux = e * MT + (blk - I.p[8 + e]) * 256; return true;
    }
    __device__ __forceinline__ unsigned row_off(const pg8::Unit&, int) const { return 0u; }
};

typedef f32x4 acc_t[2][2][4][2];

struct EpiInProj {
    static constexpr bool PERM = true;
    bf16_t* UB; bf16_t* RB;
    __device__ __forceinline__ void operator()(const acc_t& acc, const pg8::Unit& u, int wr, int wc, int fr, int fq) const {
        const int row0 = u.pm * 256 + wr * 64 + fr;
        if (u.pn < 10) {
            const int col0 = u.pn * 256 + wc * 32 + 8 * fq;
#pragma unroll
            for (int ai = 0; ai < 2; ++ai)
#pragma unroll
                for (int m = 0; m < 4; ++m) { bf16_t* rowp = UB + (size_t)(row0 + ai * 128 + m * 16) * UBW + col0;
#pragma unroll
                    for (int bj = 0; bj < 2; ++bj) { const f32x4 v0 = acc[ai][bj][m][0], v1 = acc[ai][bj][m][1];
                        u32x4 w; w.x = cvt_pk_bf16(v0[0], v0[1]); w.y = cvt_pk_bf16(v0[2], v0[3]); w.z = cvt_pk_bf16(v1[0], v1[1]); w.w = cvt_pk_bf16(v1[2], v1[3]);
                        *(u32x4*)(rowp + bj * 128) = w; } }
        } else {
            const int ch0 = (u.pn - 10) * 64 + wc * 16 + fq * 4;
#pragma unroll
            for (int ai = 0; ai < 2; ++ai)
#pragma unroll
                for (int m = 0; m < 4; ++m) { bf16_t* rowp = RB + (size_t)(row0 + ai * 128 + m * 16) * 4096 + ch0;
                    f32x4 e[4];
#pragma unroll
                    for (int i = 0; i < 4; ++i) { const f32x4 v = acc[ai][i >> 1][m][i & 1];
#pragma unroll
                        for (int j = 0; j < 4; ++j) { const float x = fminf(fmaxf(v[j], -30.f), 30.f); e[i][j] = __builtin_amdgcn_exp2f(-x * LOG2E); } }
#pragma unroll
                    for (int i = 0; i < 4; ++i) { f32x4 r;
#pragma unroll
                        for (int j = 0; j < 4; ++j) r[j] = (i < 3) ? (1.0f + e[i + 1][j]) * __builtin_amdgcn_rcpf(1.0f + e[i][j]) : __builtin_amdgcn_rcpf(1.0f + e[3][j]);
                        u32x2 w; w.x = cvt_pk_bf16(r[0], r[1]); w.y = cvt_pk_bf16(r[2], r[3]);
                        *(u32x2*)(rowp + i * 1024) = w; } }
        }
    }
};
struct EpiMerge {
    static constexpr bool PERM = true;
    const bf16_t* RB; bf16_t* T;
    __device__ __forceinline__ void scale(acc_t& acc, const pg8::Unit& u, int seg, int wr, int wc, int fr, int fq) const {
        asm volatile("" : "+v"(fr), "+v"(fq));
        const int row0 = u.pm * 256 + wr * 64 + fr, ch0 = u.pn * 256 + wc * 64 + fq * 16;
#pragma unroll
        for (int ai = 0; ai < 2; ++ai) { u32x4 q[4][2];
#pragma unroll
            for (int m = 0; m < 4; ++m) { const bf16_t* rp = RB + (size_t)(row0 + ai * 128 + m * 16) * 4096 + seg * 1024 + ch0;
                q[m][0] = *(const u32x4*)rp; q[m][1] = *(const u32x4*)(rp + 8); }
#pragma unroll
            for (int m = 0; m < 4; ++m)
#pragma unroll
                for (int bj = 0; bj < 2; ++bj) { const u32x4 q0 = q[m][bj];
                    acc[ai][bj][m][0] *= (f32x4){bf_lo(q0.x), bf_hi(q0.x), bf_lo(q0.y), bf_hi(q0.y)};
                    acc[ai][bj][m][1] *= (f32x4){bf_lo(q0.z), bf_hi(q0.z), bf_lo(q0.w), bf_hi(q0.w)}; }
            asm volatile("" ::: "memory"); }
    }
    __device__ __forceinline__ void hook(acc_t& acc, const pg8::Unit& u, int seg, int wr, int wc, int fr, int fq) const {
        scale(acc, u, seg, wr, wc, fr, fq);
    }
    __device__ __forceinline__ void operator()(acc_t& acc, const pg8::Unit& u, int wr, int wc, int fr, int fq) const {
        scale(acc, u, 3, wr, wc, fr, fq);
        const int row0 = u.pm * 256 + wr * 64 + fr, ch0 = u.pn * 256 + wc * 64 + fq * 16;
#pragma unroll
        for (int ai = 0; ai < 2; ++ai)
#pragma unroll
            for (int m = 0; m < 4; ++m) { bf16_t* rowp = T + (size_t)(row0 + ai * 128 + m * 16) * DM + ch0;
#pragma unroll
                for (int bj = 0; bj < 2; ++bj) { const f32x4 v0 = acc[ai][bj][m][0], v1 = acc[ai][bj][m][1];
                    u32x4 w; w.x = cvt_pk_bf16(v0[0], v0[1]); w.y = cvt_pk_bf16(v0[2], v0[3]); w.z = cvt_pk_bf16(v1[0], v1[1]); w.w = cvt_pk_bf16(v1[2], v1[3]);
                    *(u32x4*)(rowp + bj * 8) = w; } }
    }
};
struct EpiResid {
    static constexpr bool PERM = false;
    XMap X; const float* mod;
    bool skip_ctx;
    const float* rd_lat; const float* rd_ctx;
    __device__ __forceinline__ void operator()(const acc_t& acc, const pg8::Unit& u, int wr, int wc, int fr, int fq) const {
        const int m0 = u.pm * 256; const int b = m0 / TB, t0 = m0 - b * TB; const bool isctx = t0 >= SEQ;
        if (isctx && skip_ctx) return;
        float* base = isctx ? X.ctx + ((size_t)b * NCTX + (t0 - SEQ)) * DM : X.lat + ((size_t)b * SEQ + t0) * DM;
        const float* rbase = isctx ? rd_ctx + ((size_t)b * NCTX + (t0 - SEQ)) * DM : rd_lat + ((size_t)b * SEQ + t0) * DM;
        const float* mv = mod + (size_t)(isctx ? NB : b) * 6144;
        const int rl0 = wr * 64 + fr, col0 = u.pn * 256 + wc * 32 + 4 * fq;
        f32x4 mq[2][2];
#pragma unroll
        for (int bj = 0; bj < 2; ++bj)
#pragma unroll
            for (int n = 0; n < 2; ++n) mq[bj][n] = *(const f32x4*)(mv + col0 + bj * 128 + n * 16);
#pragma unroll
        for (int ai = 0; ai < 2; ++ai)
#pragma unroll
            for (int m2 = 0; m2 < 4; m2 += 2) { f32x4 xv[2][2][2];
#pragma unroll
                for (int mm = 0; mm < 2; ++mm) { const float* rowp = rbase + (size_t)(rl0 + ai * 128 + (m2 + mm) * 16) * DM + col0;
#pragma unroll
                    for (int bj = 0; bj < 2; ++bj)
#pragma unroll
                        for (int n = 0; n < 2; ++n) xv[mm][bj][n] = *(const f32x4*)(rowp + bj * 128 + n * 16); }
#pragma unroll
                for (int mm = 0; mm < 2; ++mm) { float* rowp = base + (size_t)(rl0 + ai * 128 + (m2 + mm) * 16) * DM + col0;
#pragma unroll
                    for (int bj = 0; bj < 2; ++bj)
#pragma unroll
                        for (int n = 0; n < 2; ++n) *(f32x4*)(rowp + bj * 128 + n * 16) = xv[mm][bj][n] + mq[bj][n] * acc[ai][bj][m2 + mm][n]; }
                asm volatile("" ::: "memory"); }
    }
};
struct EpiSwiGLU {
    static constexpr bool PERM = true;
    bf16_t* H; int ldh;
    __device__ __forceinline__ void operator()(const acc_t& acc, const pg8::Unit& u, int wr, int wc, int fr, int fq) const {
        const int row0 = u.pm * 256 + wr * 64 + fr, col0 = u.pn * 128 + wc * 32 + 8 * fq;
#pragma unroll
        for (int ai = 0; ai < 2; ++ai)
#pragma unroll
            for (int m = 0; m < 4; ++m) { bf16_t* rowp = H + (size_t)(row0 + ai * 128 + m * 16) * ldh + col0; float o[8];
#pragma unroll
                for (int n = 0; n < 2; ++n)
#pragma unroll
                    for (int j = 0; j < 4; ++j) { const float a = acc[ai][0][m][n][j], g = acc[ai][1][m][n][j]; o[n * 4 + j] = a * fast_sigmoid(a) * g; }
                u32x4 w; w.x = cvt_pk_bf16(o[0], o[1]); w.y = cvt_pk_bf16(o[2], o[3]); w.z = cvt_pk_bf16(o[4], o[5]); w.w = cvt_pk_bf16(o[6], o[7]);
                *(u32x4*)rowp = w; }
    }
};
struct EpiMoeDown {
    static constexpr bool PERM = true;
    const MoeInfo* I; const int* tok; const float* gw; bf16_t* slot;
    __device__ __forceinline__ void operator()(const acc_t& acc, const pg8::Unit& u, int wr, int wc, int fr, int fq) const {
        const int e = u.aux / MT, j0 = u.aux - e * MT; const int valid = I->p[e] - j0;
        const int rl0 = wr * 64 + fr, col0 = u.pn * 256 + wc * 32 + 8 * fq;
#pragma unroll
        for (int ai = 0; ai < 2; ++ai)
#pragma unroll
            for (int m = 0; m < 4; ++m) { const int r = rl0 + ai * 128 + m * 16;
                if (r < valid) { const int tk = tok[u.aux + r]; const float g = gw[u.aux + r]; const int token = tk & 0x7fffffff, k = (tk >> 31) & 1;
                    bf16_t* rowp = slot + ((size_t)token * 2 + k) * DM + col0;
#pragma unroll
                    for (int bj = 0; bj < 2; ++bj) { const f32x4 v0 = acc[ai][bj][m][0] * g, v1 = acc[ai][bj][m][1] * g;
                        u32x4 w; w.x = cvt_pk_bf16(v0[0], v0[1]); w.y = cvt_pk_bf16(v0[2], v0[3]); w.z = cvt_pk_bf16(v1[0], v1[1]); w.w = cvt_pk_bf16(v1[2], v1[3]);
                        *(u32x4*)(rowp + bj * 128) = w; } } }
    }
};
struct Frame {
    LAS unsigned char* lds;
    unsigned* ctl;
    int tid, lane, wave, G, bid, wv;
    const float* const* in;
    unsigned char* ws;
    float* out;
};
enum { I_X = 0, I_C, I_CTX, I_CCTX, I_WADA, I_BADA, I_NMIX, I_NFFN, I_WIN, I_HSW, I_HSB, I_HW1, I_HB1, I_HW2, I_HB2, I_HW3, I_HB3, I_HW4, I_HFREQ, I_HBIAS,
       I_CFW, I_CFB, I_CFG, I_CFLB, I_GQN, I_GKN, I_DQN, I_DKN, I_LQ1, I_LK1, I_LQ2, I_LK2, I_SUBLN, I_WBR, I_WOUT, I_FW1, I_FW3, I_FW2, I_ROUTER, I_MW1, I_MW3, I_MW2 };

__device__ __forceinline__ void p0_mods(Frame& F) {
    F.tid = opaque_tid(F.wv); F.lane = F.tid & 63; F.wave = __builtin_amdgcn_readfirstlane(F.tid >> 6);
    LAS float* s = (LAS float*)F.lds;
    LAS float* red = (LAS float*)(F.lds + 40960);
    const float* c = INP(F, I_C); const float* cc = INP(F, I_CCTX);
    for (int i = F.tid; i < 9 * 1024; i += NTHR) { const float v = i < 8192 ? c[i] : cc[i - 8192]; s[i] = v * fast_sigmoid(v); }
    __syncthreads();
    float* MODS = (float*)(F.ws + WS_MODS);
    for (int u = F.bid; u < 4 * 96; u += F.G) {
        const int l = u / 96, n0 = (u % 96) * 64;
        const float* w = INP(F, I_WADA) + (size_t)l * DM * 6144 + n0 + F.lane;
        float acc[9];
#pragma unroll
        for (int r = 0; r < 9; ++r) acc[r] = 0.f;
        const int k0 = F.wave * 128;
#pragma unroll 16
        for (int k = k0; k < k0 + 128; ++k) { const float wv = w[(size_t)k * 6144];
#pragma unroll
            for (int r = 0; r < 9; ++r) acc[r] += s[r * 1024 + k] * wv; }
#pragma unroll
        for (int r = 0; r < 9; ++r) red[(F.wave * 9 + r) * 64 + F.lane] = acc[r];
        __syncthreads();
        for (int i = F.tid; i < 9 * 64; i += NTHR) { const int r = i >> 6, ln = i & 63; float t = INP(F, I_BADA)[l * 6144 + n0 + ln];
#pragma unroll
            for (int w8 = 0; w8 < 8; ++w8) t += red[(w8 * 9 + r) * 64 + ln];
            const int sl6 = n0 >> 10, cl = (n0 & 1023) + ln;
            if (sl6 == 1) t = INP(F, I_NMIX)[l * DM + cl] * (1.0f + t);
            if (sl6 == 4) t = INP(F, I_NFFN)[l * DM + cl] * (1.0f + t);
            MODS[((size_t)l * 9 + r) * 6144 + n0 + ln] = t; }
        __syncthreads();
    }
}
__device__ __forceinline__ void p0_a3(Frame& F) {
    F.tid = opaque_tid(F.wv); F.lane = F.tid & 63; F.wave = __builtin_amdgcn_readfirstlane(F.tid >> 6);
    const int gw = F.bid * NWAVES + F.wave, NGW = F.G * NWAVES;
    const int l = gw & 3; const int j = F.lane;
    float w1r[33], w2r[64], w3r[64];
    const float* w1 = INP(F, I_HW1) + l * 33 * 64; const float* w2 = INP(F, I_HW2) + l * 4096; const float* w3 = INP(F, I_HW3) + l * 4096;
#pragma unroll
    for (int i = 0; i < 33; ++i) w1r[i] = w1[i * 64 + j];
#pragma unroll
    for (int i = 0; i < 64; ++i) { w2r[i] = w2[i * 64 + j]; w3r[i] = w3[i * 64 + j]; }
    const float b1 = INP(F, I_HB1)[l * 64 + j], b2 = INP(F, I_HB2)[l * 64 + j], b3 = INP(F, I_HB3)[l * 64 + j], fq = INP(F, I_HFREQ)[l * 64 + j];
    float* A3 = (float*)(F.ws + WS_A3) + (size_t)l * TB * 64;
    for (int i = gw >> 2; i < TB; i += NGW >> 2) {
        const int L = i < SEQ ? SEQ : NCTX, pos = i < SEQ ? i : i - SEQ;
        float z = 0.f;
        { const float t = (float)pos / (float)(L - 1); const float wpos = 6.283185307179586f * (float)pos / (float)L;
          const int bnd = (j >= 17) ? j - 17 : j - 1; const float fr = 1e-4f + (float)bnd * ((15.0f - 1e-4f) / 15.0f); const float ang = fr * wpos;
          z = (j == 0) ? t : (j < 17 ? cosf(ang) : (j < 33 ? -sinf(ang) : 0.f)); }
        float p = b1;
#pragma unroll
        for (int k = 0; k < 33; ++k) p += __builtin_bit_cast(float, __builtin_amdgcn_readlane(__builtin_bit_cast(int, z), k)) * w1r[k];
        float a = sinf(fq * p);
        p = b2;
#pragma unroll
        for (int k = 0; k < 64; ++k) p += __builtin_bit_cast(float, __builtin_amdgcn_readlane(__builtin_bit_cast(int, a), k)) * w2r[k];
        a = sinf(fq * p);
        p = b3;
#pragma unroll
        for (int k = 0; k < 64; ++k) p += __builtin_bit_cast(float, __builtin_amdgcn_readlane(__builtin_bit_cast(int, a), k)) * w3r[k];
        a = sinf(fq * p);
        A3[(size_t)i * 64 + j] = a;
    }
}
__device__ __forceinline__ void p0_zero_rows(Frame& F) {
    u32x4* z = (u32x4*)(F.ws + WS_HB + (size_t)MT * DM * 2);
    for (int i = F.bid * NTHR + F.tid; i < 256 * DM * 2 / 16; i += F.G * NTHR) z[i] = (u32x4){0u, 0u, 0u, 0u};
}

template <class Map>
__device__ __forceinline__ void transpose_item(const float* W, int ldw, int k0, int n0, bf16_t* WT, int ldwt, int kdst, const Map& map, LAS float* scr, int lane) {
    asm volatile("" : "+s"(ldw));
    const float* src = W + (size_t)(k0 + (lane >> 5)) * ldw + n0 + (lane & 31);
    float v[32];
#pragma unroll
    for (int i = 0; i < 32; ++i) v[i] = src[(size_t)(2 * i) * ldw];
#pragma unroll
    for (int i = 0; i < 32; ++i) scr[(2 * i + (lane >> 5)) * 33 + (lane & 31)] = v[i];
    LDS_WAIT(); asm volatile("" ::: "memory");
    const int c = lane & 7;
#pragma unroll
    for (int j = 0; j < 4; ++j) { const int n = (lane >> 3) + 8 * j; const LAS float* s = scr + (8 * c) * 33 + n;
        u32x4 o; o.x = pk2(s[0 * 33], s[1 * 33]); o.y = pk2(s[2 * 33], s[3 * 33]); o.z = pk2(s[4 * 33], s[5 * 33]); o.w = pk2(s[6 * 33], s[7 * 33]);
        *(GAS u32x4*)(WT + (size_t)map(n0 + n) * ldwt + kdst + k0 + 8 * c) = o; }
    LDS_WAIT(); asm volatile("" ::: "memory");
}
struct MapId { __device__ __forceinline__ int operator()(int n) const { return n; } };
struct MapWin {
    __device__ __forceinline__ int operator()(int n) const { if (n < OFF_GATE) return n; const int g = n - OFF_GATE, i = g >> 10, ch = g & 1023;
        return OFF_GATE + 256 * (ch >> 6) + 128 * (i >> 1) + 32 * ((ch >> 4) & 3) + 8 * ((ch >> 2) & 3) + 4 * (i & 1) + (ch & 3); } };
struct MapMerge {
    __device__ __forceinline__ int operator()(int ch) const { return (ch & ~255) + 128 * ((ch >> 3) & 1) + 32 * ((ch >> 6) & 3) + 8 * ((ch >> 4) & 3) + (ch & 7); } };
struct MapGlu {
    int half; __device__ __forceinline__ int operator()(int j) const { return 256 * (j >> 7) + 128 * half + (j & 127); } };

constexpr int CV_WIN = 16 * (D_IN / 32), CV_BR = 4 * 4 * 32, CV_OUT = 16 * 32, CV_SMALL = CV_WIN + CV_BR + CV_OUT;
constexpr int CV_F13 = 16 * (DFF / 32), CV_F2 = (DFF / 64) * 32, CV_DENSE = 2 * CV_F13 + CV_F2;
constexpr int CV_M13 = 16 * (DFFE / 32), CV_M2 = (DFFE / 64) * 32, CV_MOE1 = 2 * CV_M13 + CV_M2, CV_MOE = NEXP * CV_MOE1;
__device__ __forceinline__ int cv_ffn_total(int l) { return (l & 1) ? CV_MOE : CV_DENSE; }
__device__ __forceinline__ void convert_small_item(Frame& F, int l, int r, LAS float* scr) {
    if (r < CV_WIN) { const int nb = D_IN / 32; transpose_item(INP(F, I_WIN) + (size_t)l * DM * D_IN, D_IN, 64 * (r / nb), 32 * (r % nb), (bf16_t*)(F.ws + WS_WIN), DM, 0, MapWin{}, scr, F.lane); return; } r -= CV_WIN;
    if (r < CV_BR) { const int i = r / 128, q = r % 128; transpose_item(INP(F, I_WBR) + ((size_t)l * 4 + i) * 256 * DM, DM, 64 * (q / 32), 32 * (q % 32), (bf16_t*)(F.ws + WS_WBR), DM, 256 * i, MapMerge{}, scr, F.lane); return; } r -= CV_BR;
    transpose_item(INP(F, I_WOUT) + (size_t)l * DM * DM, DM, 64 * (r / 32), 32 * (r % 32), (bf16_t*)(F.ws + WS_WOUT), DM, 0, MapId{}, scr, F.lane);
}
__device__ __forceinline__ void convert_ffn_item(Frame& F, int l, int r, LAS float* scr) {
    const bool moe = l & 1; const int li = l >> 1;
    if (!moe) {
        if (r < 2 * CV_F13) { const int half = r / CV_F13, q = r % CV_F13, nb = DFF / 32; transpose_item(INP(F, half ? I_FW3 : I_FW1) + (size_t)li * DM * DFF, DFF, 64 * (q / nb), 32 * (q % nb), (bf16_t*)(F.ws + WS_WF1), DM, 0, MapGlu{half}, scr, F.lane); return; } r -= 2 * CV_F13;
        transpose_item(INP(F, I_FW2) + (size_t)li * DFF * DM, DM, 64 * (r / 32), 32 * (r % 32), (bf16_t*)(F.ws + WS_WF2), DFF, 0, MapId{}, scr, F.lane);
    } else {
        const int e = r / CV_MOE1; r %= CV_MOE1;
        if (r < 2 * CV_M13) { const int half = r / CV_M13, q = r % CV_M13, nb = DFFE / 32; transpose_item(INP(F, half ? I_MW3 : I_MW1) + ((size_t)li * NEXP + e) * DM * DFFE, DFFE, 64 * (q / nb), 32 * (q % nb), (bf16_t*)(F.ws + WS_WM13) + (size_t)e * 2 * DFFE * DM, DM, 0, MapGlu{half}, scr, F.lane); return; } r -= 2 * CV_M13;
        transpose_item(INP(F, I_MW2) + ((size_t)li * NEXP + e) * DFFE * DM, DM, 64 * (r / 32), 32 * (r % 32), (bf16_t*)(F.ws + WS_WM2) + (size_t)e * DM * DFFE, DFFE, 0, MapId{}, scr, F.lane);
    }
}
__device__ __forceinline__ void convert_ffn_queue(Frame& F, int l, int quota) {
    F.tid = opaque_tid(F.wv); F.lane = F.tid & 63; F.wave = __builtin_amdgcn_readfirstlane(F.tid >> 6);
    LAS float* scr = (LAS float*)(F.lds + 65536 + F.wave * 8704);
    unsigned* q = F.ctl + CW_Q + l * 64; const int total = cv_ffn_total(l);
    constexpr int BATCH = 8;
    for (int n = 0; n < quota; ++n) {
        int idx = 0; if (F.lane == 0) idx = (int)__hip_atomic_fetch_add(q, (unsigned)BATCH, RLX_AGENT);
        idx = __builtin_amdgcn_readfirstlane(idx);
        if (idx >= total) break;
        const int end = (idx + BATCH < total) ? idx + BATCH : total;
        for (int it = idx; it < end; ++it) convert_ffn_item(F, l, it, scr);
    }
}
__device__ __forceinline__ void convert_weights(Frame& F, int l) {
    F.tid = opaque_tid(F.wv); F.lane = F.tid & 63; F.wave = __builtin_amdgcn_readfirstlane(F.tid >> 6);
    LAS float* scr = (LAS float*)(F.lds + 65536 + F.wave * 8704);
    const int gw = F.bid * NWAVES + F.wave, NGW = F.G * NWAVES;
    for (int it = gw; it < CV_SMALL; it += NGW) convert_small_item(F, l, it, scr);
    convert_ffn_queue(F, l, 1 << 30);
}

#define FP(i) ((i) + ((i) >> 4))
__device__ __forceinline__ f32x2 cmul(f32x2 a, f32x2 b) { return (f32x2){a.x * b.x - a.y * b.y, a.x * b.y + a.y * b.x}; }
__device__ __forceinline__ f32x2 twid(float rev) { return (f32x2){__builtin_amdgcn_cosf(rev), __builtin_amdgcn_sinf(rev)}; }
template <int K> __device__ __forceinline__ void bfly(f32x2& a, f32x2& b) {
    constexpr float C1 = 0.9238795325112867f, S1 = 0.3826834323650898f, C2 = 0.7071067811865476f;
    const f32x2 s = a + b, d = a - b; a = s;
    if constexpr (K == 0) b = d;
    else if constexpr (K == 1) b = (f32x2){d.x * C1 + d.y * S1, d.y * C1 - d.x * S1};
    else if constexpr (K == 2) b = (f32x2){(d.x + d.y) * C2, (d.y - d.x) * C2};
    else if constexpr (K == 3) b = (f32x2){d.x * S1 + d.y * C1, d.y * S1 - d.x * C1};
    else if constexpr (K == 4) b = (f32x2){d.y, -d.x};
    else if constexpr (K == 5) b = (f32x2){d.y * C1 - d.x * S1, -d.x * C1 - d.y * S1};
    else if constexpr (K == 6) b = (f32x2){(d.y - d.x) * C2, -(d.x + d.y) * C2};
    else b = (f32x2){d.y * S1 - d.x * C1, -d.x * S1 - d.y * C1};
}
__device__ __forceinline__ void fft16(f32x2 (&v)[16]) {
    bfly<0>(v[0], v[8]); bfly<1>(v[1], v[9]); bfly<2>(v[2], v[10]); bfly<3>(v[3], v[11]); bfly<4>(v[4], v[12]); bfly<5>(v[5], v[13]); bfly<6>(v[6], v[14]); bfly<7>(v[7], v[15]);
    bfly<0>(v[0], v[4]); bfly<2>(v[1], v[5]); bfly<4>(v[2], v[6]); bfly<6>(v[3], v[7]); bfly<0>(v[8], v[12]); bfly<2>(v[9], v[13]); bfly<4>(v[10], v[14]); bfly<6>(v[11], v[15]);
    bfly<0>(v[0], v[2]); bfly<4>(v[1], v[3]); bfly<0>(v[4], v[6]); bfly<4>(v[5], v[7]); bfly<0>(v[8], v[10]); bfly<4>(v[9], v[11]); bfly<0>(v[12], v[14]); bfly<4>(v[13], v[15]);
    bfly<0>(v[0], v[1]); bfly<0>(v[2], v[3]); bfly<0>(v[4], v[5]); bfly<0>(v[6], v[7]); bfly<0>(v[8], v[9]); bfly<0>(v[10], v[11]); bfly<0>(v[12], v[13]); bfly<0>(v[14], v[15]);
    f32x2 t;
    t = v[1]; v[1] = v[8]; v[8] = t;   t = v[2]; v[2] = v[4]; v[4] = t;   t = v[3]; v[3] = v[12]; v[12] = t;
    t = v[5]; v[5] = v[10]; v[10] = t; t = v[7]; v[7] = v[14]; v[14] = t; t = v[11]; v[11] = v[13]; v[13] = t;
}
__device__ __forceinline__ void fft8192(LAS f32x2* buf, int tid) {
    constexpr int N = 8192;
#pragma unroll 1
    for (int pass = 0; pass < 3; ++pass) {
        const int Ns = pass == 0 ? 1 : (pass == 1 ? 16 : 256);
        const int j = tid;
        const int jm = j & (Ns - 1);
        const f32x2 w1 = twid(-(float)jm / (float)(Ns * 16));
        f32x2 v[16];
#pragma unroll
        for (int r = 0; r < 16; ++r) v[r] = buf[FP(j + r * (N / 16))];
        f32x2 w = w1;
#pragma unroll
        for (int r = 1; r < 16; ++r) { v[r] = cmul(v[r], w); w = cmul(w, w1); }
        fft16(v);
        __syncthreads();
        const int idx = ((j - jm) << 4) + jm;
#pragma unroll
        for (int r = 0; r < 16; ++r) buf[FP(idx + r * Ns)] = v[r];
        __syncthreads();
    }
    {
        f32x2 a[8], b[8];
#pragma unroll
        for (int q = 0; q < 8; ++q) { const int j = tid + q * NTHR; a[q] = buf[FP(j)]; b[q] = cmul(buf[FP(j + 4096)], twid(-(float)j / 8192.0f)); }
        __syncthreads();
#pragma unroll
        for (int q = 0; q < 8; ++q) { const int j = tid + q * NTHR; buf[FP(j)] = a[q] + b[q]; buf[FP(j + 4096)] = a[q] - b[q]; }
        __syncthreads();
    }
}

template <bool TW = true> __device__ __forceinline__ void fft_pass16(LAS f32x2* buf, int tid, int Ns) {
    asm volatile("" : "+v"(tid), "+s"(Ns));
    const int j = tid, jm = j & (Ns - 1);
    const f32x2 w1 = twid(-(float)jm / (float)(Ns * 16));
    f32x2 v[16];
#pragma unroll
    for (int r = 0; r < 16; ++r) v[r] = buf[FP(j + r * 512)];
    if constexpr (TW) { f32x2 w = w1;
#pragma unroll
        for (int r = 1; r < 16; ++r) { v[r] = cmul(v[r], w); w = cmul(w, w1); } }
    fft16(v);
    __syncthreads();
    const int idx = ((j - jm) << 4) + jm;
#pragma unroll
    for (int r = 0; r < 16; ++r) buf[FP(idx + r * Ns)] = v[r];
    __syncthreads();
}
__device__ __forceinline__ void fft_fwd_regs_mulK(LAS f32x2* buf, int tid, const f32x2 (&z)[8], const f32x2* __restrict__ KF) {
    asm volatile("" : "+v"(tid));
    { f32x2 v[16];
#pragma unroll
      for (int r = 0; r < 8; ++r) { v[r] = z[r]; v[r + 8] = (f32x2){0.f, 0.f}; }
      fft16(v);
#pragma unroll
      for (int r = 0; r < 16; ++r) buf[FP(tid * 16 + r)] = v[r];
      __syncthreads(); }
    fft_pass16(buf, tid, 16);
    fft_pass16(buf, tid, 256);
    asm volatile("" : "+v"(tid));
    { f32x2 a[8], b[8], k0[8], k1[8];
#pragma unroll
      for (int q = 0; q < 8; ++q) { const int j = tid + q * NTHR; k0[q] = KF[j]; k1[q] = KF[j + 4096]; }
#pragma unroll
      for (int q = 0; q < 8; ++q) { const int j = tid + q * NTHR; a[q] = buf[FP(j)]; b[q] = cmul(buf[FP(j + 4096)], twid(-(float)j / 8192.0f)); }
      __syncthreads();
#pragma unroll
      for (int q = 0; q < 8; ++q) { const int j = tid + q * NTHR; const f32x2 y0 = cmul(a[q] + b[q], k0[q]), y1 = cmul(a[q] - b[q], k1[q]);
          buf[FP(j)] = (f32x2){y0.x, -y0.y}; buf[FP(j + 4096)] = (f32x2){y1.x, -y1.y}; }
      __syncthreads(); }
}
__device__ __forceinline__ void fft_to_regs_lo(LAS f32x2* buf, int tid, f32x2 (&out)[8]) {
    fft_pass16<false>(buf, tid, 1);
    fft_pass16(buf, tid, 16);
    fft_pass16(buf, tid, 256);
    asm volatile("" : "+v"(tid));
#pragma unroll
    for (int q = 0; q < 8; ++q) { const int j = tid + q * NTHR; out[q] = buf[FP(j)] + cmul(buf[FP(j + 4096)], twid(-(float)j / 8192.0f)); }
}

template <bool TW = true> __device__ __forceinline__ void fft_pass16_x2(LAS f32x2* bufA, LAS f32x2* bufB, int tid, int Ns) {
    asm volatile("" : "+v"(tid), "+s"(Ns));
    const int j = tid, jm = j & (Ns - 1);
    const f32x2 w1 = twid(-(float)jm / (float)(Ns * 16));
    f32x2 va[16], vb[16];
#pragma unroll
    for (int r = 0; r < 16; ++r) { va[r] = bufA[FP(j + r * 512)]; vb[r] = bufB[FP(j + r * 512)]; }
    if constexpr (TW) { f32x2 w = w1;
#pragma unroll
        for (int r = 1; r < 16; ++r) { va[r] = cmul(va[r], w); vb[r] = cmul(vb[r], w); w = cmul(w, w1); } }
    fft16(va); fft16(vb);
    __syncthreads();
    const int idx = ((j - jm) << 4) + jm;
#pragma unroll
    for (int r = 0; r < 16; ++r) { bufA[FP(idx + r * Ns)] = va[r]; bufB[FP(idx + r * Ns)] = vb[r]; }
    __syncthreads();
}
__device__ __forceinline__ void fft_fwd_regs_mulK_x2(LAS f32x2* bufA, LAS f32x2* bufB, int tid, const f32x2 (&za)[8], const f32x2 (&zb)[8], const f32x2* __restrict__ KF) {
    asm volatile("" : "+v"(tid));
    { f32x2 v[16];
#pragma unroll
      for (int r = 0; r < 8; ++r) { v[r] = za[r]; v[r + 8] = (f32x2){0.f, 0.f}; }
      fft16(v);
#pragma unroll
      for (int r = 0; r < 16; ++r) bufA[FP(tid * 16 + r)] = v[r];
#pragma unroll
      for (int r = 0; r < 8; ++r) { v[r] = zb[r]; v[r + 8] = (f32x2){0.f, 0.f}; }
      fft16(v);
#pragma unroll
      for (int r = 0; r < 16; ++r) bufB[FP(tid * 16 + r)] = v[r];
      __syncthreads(); }
    fft_pass16_x2(bufA, bufB, tid, 16);
    fft_pass16_x2(bufA, bufB, tid, 256);
    asm volatile("" : "+v"(tid));
#pragma unroll
    for (int hq = 0; hq < 2; ++hq) {
      f32x2 a[4], b[4], c[4], d[4], k0[4], k1[4];
#pragma unroll
      for (int q = 0; q < 4; ++q) { const int j = tid + (hq * 4 + q) * NTHR; k0[q] = KF[j]; k1[q] = KF[j + 4096]; }
#pragma unroll
      for (int q = 0; q < 4; ++q) { const int j = tid + (hq * 4 + q) * NTHR; const f32x2 tw = twid(-(float)j / 8192.0f);
          a[q] = bufA[FP(j)]; b[q] = cmul(bufA[FP(j + 4096)], tw); c[q] = bufB[FP(j)]; d[q] = cmul(bufB[FP(j + 4096)], tw); }
#pragma unroll
      for (int q = 0; q < 4; ++q) { const int j = tid + (hq * 4 + q) * NTHR;
          const f32x2 y0 = cmul(a[q] + b[q], k0[q]), y1 = cmul(a[q] - b[q], k1[q]), y2 = cmul(c[q] + d[q], k0[q]), y3 = cmul(c[q] - d[q], k1[q]);
          bufA[FP(j)] = (f32x2){y0.x, -y0.y}; bufA[FP(j + 4096)] = (f32x2){y1.x, -y1.y}; bufB[FP(j)] = (f32x2){y2.x, -y2.y}; bufB[FP(j + 4096)] = (f32x2){y3.x, -y3.y}; }
    }
    __syncthreads();
}
__device__ __forceinline__ void fft_to_regs_lo_x2(LAS f32x2* bufA, LAS f32x2* bufB, int tid, f32x2 (&oa)[8], f32x2 (&ob)[8]) {
    fft_pass16_x2<false>(bufA, bufB, tid, 1);
    fft_pass16_x2(bufA, bufB, tid, 16);
    fft_pass16_x2(bufA, bufB, tid, 256);
    asm volatile("" : "+v"(tid));
#pragma unroll
    for (int q = 0; q < 8; ++q) { const int j = tid + q * NTHR; const f32x2 tw = twid(-(float)j / 8192.0f);
        oa[q] = bufA[FP(j)] + cmul(bufA[FP(j + 4096)], tw); ob[q] = bufB[FP(j)] + cmul(bufB[FP(j + 4096)], tw); }
}

__device__ __forceinline__ float block_sum(LAS float* red, float v, int tid, int lane, int wave) {
    v = wave_sum(v);
    __syncthreads();
    if (lane == 0) red[wave] = v;
    __syncthreads();
    float s = 0.f;
#pragma unroll
    for (int w = 0; w < NWAVES; ++w) s += red[w];
    return s;
}
__device__ __forceinline__ void hyena_filter_unit(Frame& F, int l, int c) {
    F.tid = opaque_tid(F.wv); F.lane = F.tid & 63; F.wave = __builtin_amdgcn_readfirstlane(F.tid >> 6);
    LAS f32x2* buf = (LAS f32x2*)F.lds;
    LAS float* w4c = (LAS float*)(F.lds + 73728);
    LAS float* red = (LAS float*)(F.lds + 73728 + 1024);
    const float* w4 = INP(F, I_HW4) + (size_t)l * 64 * 1024;
    __syncthreads();
    if (F.tid < 256) { const int q = F.tid >> 6, j = F.tid & 63; w4c[q * 64 + j] = w4[j * 1024 + q * 256 + c]; }
    __syncthreads();
    const float lt = -4.605170185988091f;
    const float d0 = lt / 1.5f, d1 = lt / 0.3f;
    const float delta = fabsf(d0 + (float)c * ((d1 - d0) / 255.0f));
    const float* A3 = (const float*)(F.ws + WS_A3) + (size_t)l * TB * 64;
    float ss0 = 0.f, ss1 = 0.f;
#pragma unroll 1
    for (int t = F.tid; t < SEQ; t += NTHR) {
        const f32x4* ar = (const f32x4*)(A3 + (size_t)t * 64);
        float h[4] = {0.f, 0.f, 0.f, 0.f};
        LAS float* wq = w4c; asm volatile("" : "+v"(wq));
#pragma unroll 4
        for (int j4 = 0; j4 < 16; ++j4) { const f32x4 a = ar[j4];
#pragma unroll
            for (int q = 0; q < 4; ++q) { const f32x4 w = *(const LAS f32x4*)(wq + q * 64 + 4 * j4); h[q] += (a[0] * w[0] + a[1] * w[1]) + (a[2] * w[2] + a[3] * w[3]); } }
        const float win = __expf(-((float)t / (float)(SEQ - 1)) * delta);
        const float f0 = h[0] * win, f1 = h[1] * win, b0 = h[2] * win, b1 = h[3] * win;
        buf[FP(t)] = (f32x2){f0, f1}; ss0 += f0 * f0; ss1 += f1 * f1;
        if (t >= 1) { buf[FP(2 * SEQ - t)] = (f32x2){b0, b1}; ss0 += b0 * b0; ss1 += b1 * b1; }
    }
    if (F.tid == 0) { float z0 = 0.f; asm volatile("" : "+v"(z0)); buf[FP(SEQ)] = (f32x2){z0, z0}; }
    const float t0 = block_sum(red, ss0, F.tid, F.lane, F.wave);
    const float t1 = block_sum(red, ss1, F.tid, F.lane, F.wave);
    const float s0 = 1.0f / sqrtf(t0 + EPS), s1 = 1.0f / sqrtf(t1 + EPS);
#pragma unroll 2
    for (int i = F.tid; i < 8192; i += NTHR) { f32x2 v = buf[FP(i)]; v.x *= s0; v.y *= s1; buf[FP(i)] = v; }
    __syncthreads();
    fft8192(buf, F.tid);
    f32x2* KF0 = (f32x2*)(F.ws + WS_KF) + (size_t)c * 8192; f32x2* KF1 = KF0 + (size_t)256 * 8192;
    const float sc = 0.5f / 8192.0f;
#pragma unroll 2
    for (int f = F.tid; f < 8192; f += NTHR) { const f32x2 a = buf[FP(f)], bb = buf[FP((8192 - f) & 8191)]; const f32x2 b = (f32x2){bb.x, -bb.y};
        KF0[f] = (f32x2){(a.x + b.x) * sc, (a.y + b.y) * sc}; const float dr = a.x - b.x, di = a.y - b.y; KF1[f] = (f32x2){di * sc, -dr * sc}; }
    __syncthreads();
    float* KC = (float*)(F.ws + WS_KC);
    float v[4] = {0.f, 0.f, 0.f, 0.f};
    if (F.tid < NCTX) { const int t = F.tid; const f32x4* ar = (const f32x4*)(A3 + (size_t)(SEQ + t) * 64);
#pragma unroll 4
        for (int j4 = 0; j4 < 16; ++j4) { const f32x4 a = ar[j4];
#pragma unroll
            for (int q = 0; q < 4; ++q) { const f32x4 w = *(const LAS f32x4*)(w4c + q * 64 + 4 * j4); v[q] += (a[0] * w[0] + a[1] * w[1]) + (a[2] * w[2] + a[3] * w[3]); } }
        const float win = __expf(-((float)t / (float)(NCTX - 1)) * delta);
#pragma unroll
        for (int q = 0; q < 4; ++q) v[q] *= win; }
    const bool has_b = F.tid >= 1 && F.tid < NCTX;
    const float u0 = block_sum(red, v[0] * v[0] + (has_b ? v[2] * v[2] : 0.f), F.tid, F.lane, F.wave);
    const float u1 = block_sum(red, v[1] * v[1] + (has_b ? v[3] * v[3] : 0.f), F.tid, F.lane, F.wave);
    if (F.tid < NCTX) { const int t = F.tid; const float r0 = 1.0f / sqrtf(u0 + EPS), r1 = 1.0f / sqrtf(u1 + EPS);
        KC[((size_t)0 * 256 + c) * 512 + 255 + t] = v[0] * r0; KC[((size_t)1 * 256 + c) * 512 + 255 + t] = v[1] * r1;
        if (t >= 1) { KC[((size_t)0 * 256 + c) * 512 + 255 - t] = v[2] * r0; KC[((size_t)1 * 256 + c) * 512 + 255 - t] = v[3] * r1; } }
    __syncthreads();
}

__device__ __forceinline__ void load_xrow(Frame& F, int m, int mode, f32x4 (&v)[4]) {
    const int b = m / TB, t = m - b * TB; const bool isctx = t >= SEQ;
    const float* src = isctx ? (const float*)(F.ws + WS_XC) + ((size_t)b * NCTX + (t - SEQ)) * DM : F.out + ((size_t)b * SEQ + t) * DM;
    if (mode & 1) src = isctx ? INP(F, I_CTX) + ((size_t)b * NCTX + (t - SEQ)) * DM : INP(F, I_X) + ((size_t)b * SEQ + t) * DM;
    const GAS f32x4* xr = (const GAS f32x4*)src + F.lane;
#pragma unroll
    for (int j = 0; j < 4; ++j) v[j] = xr[64 * j];
}
__device__ __forceinline__ void norm_row(Frame& F, int l, int m, int slice0, int mode, float (&xv)[16], bool write_h, const f32x4 (&vin)[4], int mn, f32x4 (&nx2)[4]) {
    const int b = m / TB, t = m - b * TB; const bool isctx = t >= SEQ; const int r = isctx ? NB : b;
    float* xs = isctx ? (float*)(F.ws + WS_XC) + ((size_t)b * NCTX + (t - SEQ)) * DM : F.out + ((size_t)b * SEQ + t) * DM;
    f32x4 v[4];
#pragma unroll
    for (int j = 0; j < 4; ++j) v[j] = vin[j];
    const float* MODS = (const float*)(F.ws + WS_MODS);
    const float* sh = MODS + ((size_t)l * 9 + r) * 6144 + slice0 * DM; const float* scp = sh + DM;
    f32x4 sv[4], hv[4];
#pragma unroll
    for (int j = 0; j < 4; ++j) { const int col = 4 * F.lane + 256 * j; sv[j] = *(const f32x4*)(scp + col); hv[j] = *(const f32x4*)(sh + col); }
    u32x2 s0[4], s1[4]; f32x4 mq[4];
    if (mode & 2) {
        const bf16_t* sl = (const bf16_t*)(F.ws + WS_SLOT) + (size_t)m * 2 * DM;
        const float* m5 = MODS + ((size_t)(l - 1) * 9 + r) * 6144 + 5 * DM;
#pragma unroll
        for (int j = 0; j < 4; ++j) { const int col = 4 * F.lane + 256 * j; s0[j] = *(const u32x2*)(sl + col); s1[j] = *(const u32x2*)(sl + DM + col); mq[j] = *(const f32x4*)(m5 + col); }
    }
    asm volatile("" ::: "memory");
    load_xrow(F, mn, mode, nx2);
    asm volatile("" ::: "memory");
    if (mode & 2) {
#pragma unroll
        for (int j = 0; j < 4; ++j) {
            v[j][0] += mq[j][0] * (bf_lo(s0[j].x) + bf_lo(s1[j].x)); v[j][1] += mq[j][1] * (bf_hi(s0[j].x) + bf_hi(s1[j].x));
            v[j][2] += mq[j][2] * (bf_lo(s0[j].y) + bf_lo(s1[j].y)); v[j][3] += mq[j][3] * (bf_hi(s0[j].y) + bf_hi(s1[j].y)); }
        GAS f32x4* xo = (GAS f32x4*)xs + F.lane;
#pragma unroll
        for (int j = 0; j < 4; ++j) xo[64 * j] = v[j];
    }
    float ss = 0.f;
#pragma unroll
    for (int j = 0; j < 4; ++j) ss += (v[j][0] * v[j][0] + v[j][1] * v[j][1]) + (v[j][2] * v[j][2] + v[j][3] * v[j][3]);
    const float rstd = 1.0f / sqrtf(wave_sum(ss) * (1.0f / DM) + EPS);
    bf16_t* hrow = (bf16_t*)(F.ws + WS_HB) + (size_t)m * DM;
#pragma unroll
    for (int j = 0; j < 4; ++j) { const int col = 4 * F.lane + 256 * j;
        f32x4 h;
#pragma unroll
        for (int q = 0; q < 4; ++q) { h[q] = (v[j][q] * rstd) * sv[j][q] + hv[j][q]; xv[4 * j + q] = h[q]; }
        if (write_h) { u32x2 w; w.x = pk2(h[0], h[1]); w.y = pk2(h[2], h[3]); *(u32x2*)(hrow + col) = w; } }
}
__device__ __forceinline__ void hyena_short_unit(Frame& F, int l, int unit) {
    F.tid = opaque_tid(F.wv); F.lane = F.tid & 63; F.wave = __builtin_amdgcn_readfirstlane(F.tid >> 6);
    LAS bf16_t* s = (LAS bf16_t*)F.lds;
    constexpr int LDW = 258;
    const int g = unit % 3, tt = (unit / 3) % 68, b = unit / (3 * 68);
    const int t0 = tt * 64; const bool isctx = t0 >= SEQ; const int lo = isctx ? SEQ : 0, hi = isctx ? TB : SEQ;
    const bf16_t* UB = (const bf16_t*)(F.ws + WS_UB) + (size_t)b * TB * UBW + g * 256;
    __syncthreads();
    for (int i = F.tid; i < 66 * 32; i += NTHR) { const int rr = i >> 5, ch8 = (i & 31) * 8; const int t = t0 - 1 + rr;
        u32x4 v = (u32x4){0u, 0u, 0u, 0u}; if (t >= lo && t < hi) v = *(const u32x4*)(UB + (size_t)t * UBW + ch8);
        LAS unsigned* d = (LAS unsigned*)(s + rr * LDW + ch8); d[0] = v.x; d[1] = v.y; d[2] = v.z; d[3] = v.w; }
    __syncthreads();
    const int ch = F.tid & 255, tg = F.tid >> 8;
    const float* sw = INP(F, I_HSW) + (size_t)l * 3 * 768 + g * 256 + ch;
    const float w0 = sw[0], w1 = sw[768], w2 = sw[1536], bias = INP(F, I_HSB)[l * 768 + g * 256 + ch];
    bf16_t* dst = (bf16_t*)(F.ws + WS_HT) + (((size_t)b * 3 + g) * 256 + ch) * TB + t0 + tg * 32;
    float p0 = bf2f(s[(tg * 32) * LDW + ch]), p1 = bf2f(s[(tg * 32 + 1) * LDW + ch]);
#pragma unroll
    for (int q = 0; q < 4; ++q) { unsigned w[4];
#pragma unroll
        for (int e = 0; e < 4; ++e) { const int tl = tg * 32 + q * 8 + e * 2;
            const float p2 = bf2f(s[(tl + 2) * LDW + ch]), p3 = bf2f(s[(tl + 3) * LDW + ch]);
            const float o0 = w0 * p0 + w1 * p1 + w2 * p2 + bias, o1 = w0 * p1 + w1 * p2 + w2 * p3 + bias;
            w[e] = pk2(o0, o1); p0 = p2; p1 = p3; }
        *(u32x4*)(dst + q * 8) = (u32x4){w[0], w[1], w[2], w[3]}; }
}
__device__ __forceinline__ void conformer_unit(Frame& F, int l, int unit) {
    F.tid = opaque_tid(F.wv); F.lane = F.tid & 63; F.wave = __builtin_amdgcn_readfirstlane(F.tid >> 6);
    LAS float* y = (LAS float*)F.lds;
    LAS float* o = (LAS float*)(F.lds + 62 * 256 * 4);
    const int tt = unit % 136, b = unit / 136; const int t0 = tt * 32; const bool isctx = t0 >= SEQ; const int lo = isctx ? SEQ : 0, hi = isctx ? TB : SEQ;
    const bf16_t* UB = (const bf16_t*)(F.ws + WS_UB) + (size_t)b * TB * UBW + OFF_CF;
    __syncthreads();
    for (int i = F.tid; i < 62 * 32; i += NTHR) { const int rr = i >> 5, ch8 = (i & 31) * 8; const int t = t0 - 15 + rr;
        float r[8];
        if (t >= lo && t < hi) { const u32x4 a = *(const u32x4*)(UB + (size_t)t * UBW + ch8), g = *(const u32x4*)(UB + (size_t)t * UBW + 256 + ch8);
            r[0] = bf_lo(a.x) * fast_sigmoid(bf_lo(g.x)); r[1] = bf_hi(a.x) * fast_sigmoid(bf_hi(g.x)); r[2] = bf_lo(a.y) * fast_sigmoid(bf_lo(g.y)); r[3] = bf_hi(a.y) * fast_sigmoid(bf_hi(g.y));
            r[4] = bf_lo(a.z) * fast_sigmoid(bf_lo(g.z)); r[5] = bf_hi(a.z) * fast_sigmoid(bf_hi(g.z)); r[6] = bf_lo(a.w) * fast_sigmoid(bf_lo(g.w)); r[7] = bf_hi(a.w) * fast_sigmoid(bf_hi(g.w));
        } else {
#pragma unroll
            for (int q = 0; q < 8; ++q) r[q] = 0.f; }
        *(LAS f32x4*)(y + rr * 256 + ch8) = (f32x4){r[0], r[1], r[2], r[3]}; *(LAS f32x4*)(y + rr * 256 + ch8 + 4) = (f32x4){r[4], r[5], r[6], r[7]}; }
    __syncthreads();
    { const int ch = F.tid & 255, tg = F.tid >> 8;
      const float* dw = INP(F, I_CFW) + (size_t)l * 31 * 256 + ch; const float bias = INP(F, I_CFB)[l * 256 + ch];
      float acc[16];
#pragma unroll
      for (int q = 0; q < 16; ++q) acc[q] = bias;
#pragma unroll
      for (int j = 0; j < 46; ++j) { const float v = y[(tg * 16 + j) * 256 + ch];
#pragma unroll
          for (int q = 0; q < 16; ++q) { const int tap = j - q; if (tap >= 0 && tap < 31) acc[q] += dw[tap * 256] * v; } }
#pragma unroll
      for (int q = 0; q < 16; ++q) o[(tg * 16 + q) * 256 + ch] = acc[q]; }
    __syncthreads();
    { const float* lg = INP(F, I_CFG) + l * 256; const float* lb = INP(F, I_CFLB) + l * 256;
      const f32x4 gv = *(const f32x4*)(lg + 4 * F.lane), bv = *(const f32x4*)(lb + 4 * F.lane);
      bf16_t* YB = (bf16_t*)(F.ws + WS_YB) + ((size_t)b * TB + t0) * DM + 256 + 4 * F.lane;
#pragma unroll
      for (int q = 0; q < 4; ++q) { const int tl = F.wave * 4 + q; const f32x4 v = *(const LAS f32x4*)(o + tl * 256 + 4 * F.lane);
          const float mu = wave_sum((v[0] + v[1]) + (v[2] + v[3])) * (1.0f / 256.0f);
          const f32x4 d = v - mu; const float var = wave_sum((d[0] * d[0] + d[1] * d[1]) + (d[2] * d[2] + d[3] * d[3])) * (1.0f / 256.0f);
          const float rstd = 1.0f / sqrtf(var + EPS); float z[4];
#pragma unroll
          for (int e = 0; e < 4; ++e) { const float h = d[e] * rstd * gv[e] + bv[e]; z[e] = h * fast_sigmoid(h); }
          u32x2 w; w.x = pk2(z[0], z[1]); w.y = pk2(z[2], z[3]); *(u32x2*)(YB + (size_t)tl * DM) = w; } }
}
__device__ __forceinline__ void qk_prep_tables(Frame& F) {
    LAS f32x2* cs64 = (LAS f32x2*)F.lds; LAS f32x2* cs32 = cs64 + 64 * 16;
    __syncthreads();
    for (int i = F.tid; i < 64 * 16; i += NTHR) { const int p = i >> 4, f = i & 15; const float inv = powf(10000.0f, -(float)f / 16.0f); const float a = (float)p * inv; cs64[i] = (f32x2){cosf(a), sinf(a)}; }
    for (int i = F.tid; i < 64 * 8; i += NTHR) { const int p = i >> 3, f = i & 7; const float inv = powf(10000.0f, -(float)f / 8.0f); const float a = (float)p * inv; cs32[i] = (f32x2){cosf(a), sinf(a)}; }
    __syncthreads();
}
__device__ __forceinline__ void qk_prep_items(Frame& F, int l) {
    F.tid = opaque_tid(F.wv); F.lane = F.tid & 63; F.wave = __builtin_amdgcn_readfirstlane(F.tid >> 6);
    LAS f32x2* cs64 = (LAS f32x2*)F.lds; LAS f32x2* cs32 = cs64 + 64 * 16;
    const bf16_t* UB = (const bf16_t*)(F.ws + WS_UB);
    const float C2G = 0.125f * LOG2E, C2D = 0.17677669529663687f * LOG2E;
    const int T = F.bid * NTHR + F.tid, NT = F.G * NTHR;
    {
        const int rows_per_sweep = NT / 6; const int q = T % 6; const bool isq = q < 4; const int h = isq ? q : q - 4;
        const float* gn = INP(F, isq ? I_GQN : I_GKN) + l * 64; float g[64];
#pragma unroll
        for (int d = 0; d < 64; ++d) g[d] = gn[d];
        const float sc = isq ? C2G : 1.0f;
        if (T < rows_per_sweep * 6)
        for (int m = T / 6; m < MT; m += rows_per_sweep) {
            const int b = m / TB, t = m - b * TB; const bool lat = t < SEQ; const int prow = t >> 6, pcol = t & 63;
            const bf16_t* src = UB + (size_t)m * UBW + OFF_GQA + (isq ? 0 : 256) + h * 64;
            float v[64]; float ss = 0.f;
#pragma unroll
            for (int c8 = 0; c8 < 8; ++c8) { const u32x4 w = *(const u32x4*)(src + c8 * 8);
                v[c8 * 8 + 0] = bf_lo(w.x); v[c8 * 8 + 1] = bf_hi(w.x); v[c8 * 8 + 2] = bf_lo(w.y); v[c8 * 8 + 3] = bf_hi(w.y); v[c8 * 8 + 4] = bf_lo(w.z); v[c8 * 8 + 5] = bf_hi(w.z); v[c8 * 8 + 6] = bf_lo(w.w); v[c8 * 8 + 7] = bf_hi(w.w); }
#pragma unroll
            for (int d = 0; d < 64; ++d) ss += v[d] * v[d];
            const float rstd = 1.0f / sqrtf(ss * (1.0f / 64.0f) + EPS);
#pragma unroll
            for (int d = 0; d < 64; ++d) v[d] = v[d] * rstd * g[d];
            if (lat) {
#pragma unroll
                for (int hf = 0; hf < 2; ++hf) { const int p = hf ? pcol : prow;
#pragma unroll
                    for (int f = 0; f < 16; ++f) { const f32x2 cs = cs64[p * 16 + f]; const float x1 = v[hf * 32 + f], x2 = v[hf * 32 + 16 + f];
                        v[hf * 32 + f] = x1 * cs.x - x2 * cs.y; v[hf * 32 + 16 + f] = x2 * cs.x + x1 * cs.y; } }
            }
            bf16_t* dst = isq ? (bf16_t*)(F.ws + WS_QG) + (size_t)m * 256 + h * 64 : (bf16_t*)(F.ws + WS_KG) + (size_t)m * 128 + h * 64;
#pragma unroll
            for (int c8 = 0; c8 < 8; ++c8) { u32x4 w; w.x = pk2(v[c8 * 8] * sc, v[c8 * 8 + 1] * sc); w.y = pk2(v[c8 * 8 + 2] * sc, v[c8 * 8 + 3] * sc); w.z = pk2(v[c8 * 8 + 4] * sc, v[c8 * 8 + 5] * sc); w.w = pk2(v[c8 * 8 + 6] * sc, v[c8 * 8 + 7] * sc);
                *(u32x4*)(dst + c8 * 8) = w; }
        }
    }
    {
        const int rows_per_sweep = NT / 16; const int q = T % 16; const bool isq = q < 8; const int hm = q & 7; const int mm = hm & 1;
        const float* gn = INP(F, isq ? I_DQN : I_DKN) + l * 64 + mm * 32; float g[32];
#pragma unroll
        for (int d = 0; d < 32; ++d) g[d] = gn[d];
        const float sc = isq ? C2D : 1.0f;
        for (int m0 = T / 16; m0 < MT; m0 += 2 * rows_per_sweep) {
            float v[2][32]; bool ok[2];
#pragma unroll
            for (int u = 0; u < 2; ++u) { const int m = m0 + u * rows_per_sweep; ok[u] = m < MT; const int mc = ok[u] ? m : m0;
                const bf16_t* src = UB + (size_t)mc * UBW + OFF_DIFF + (isq ? 0 : 256) + hm * 32;
#pragma unroll
                for (int c8 = 0; c8 < 4; ++c8) { const u32x4 w = *(const u32x4*)(src + c8 * 8);
                    v[u][c8 * 8 + 0] = bf_lo(w.x); v[u][c8 * 8 + 1] = bf_hi(w.x); v[u][c8 * 8 + 2] = bf_lo(w.y); v[u][c8 * 8 + 3] = bf_hi(w.y); v[u][c8 * 8 + 4] = bf_lo(w.z); v[u][c8 * 8 + 5] = bf_hi(w.z); v[u][c8 * 8 + 6] = bf_lo(w.w); v[u][c8 * 8 + 7] = bf_hi(w.w); } }
#pragma unroll
            for (int u = 0; u < 2; ++u) { const int m = m0 + u * rows_per_sweep; if (!ok[u]) continue;
                const int b = m / TB, t = m - b * TB; const bool lat = t < SEQ; const int prow = t >> 6, pcol = t & 63;
                float ss = 0.f;
#pragma unroll
                for (int d = 0; d < 32; ++d) ss += v[u][d] * v[u][d];
                const float rstd = 1.0f / sqrtf(ss * (1.0f / 32.0f) + EPS);
#pragma unroll
                for (int d = 0; d < 32; ++d) v[u][d] = v[u][d] * rstd * g[d];
                if (lat) {
#pragma unroll
                    for (int hf = 0; hf < 2; ++hf) { const int p = hf ? pcol : prow;
#pragma unroll
                        for (int f = 0; f < 8; ++f) { const f32x2 cs = cs32[p * 8 + f]; const float x1 = v[u][hf * 16 + f], x2 = v[u][hf * 16 + 8 + f];
                            v[u][hf * 16 + f] = x1 * cs.x - x2 * cs.y; v[u][hf * 16 + 8 + f] = x2 * cs.x + x1 * cs.y; } }
                }
                bf16_t* dst = (bf16_t*)(F.ws + (isq ? WS_QD : WS_KD)) + (size_t)m * 256 + hm * 32;
#pragma unroll
                for (int c8 = 0; c8 < 4; ++c8) { u32x4 w; w.x = pk2(v[u][c8 * 8] * sc, v[u][c8 * 8 + 1] * sc); w.y = pk2(v[u][c8 * 8 + 2] * sc, v[u][c8 * 8 + 3] * sc); w.z = pk2(v[u][c8 * 8 + 4] * sc, v[u][c8 * 8 + 5] * sc); w.w = pk2(v[u][c8 * 8 + 6] * sc, v[u][c8 * 8 + 7] * sc);
                    *(u32x4*)(dst + c8 * 8) = w; } }
        }
    }
}

__device__ __forceinline__ void hyena_conv_unit(Frame& F, int l, int unit) {
    F.tid = opaque_tid(F.wv); F.lane = F.tid & 63; F.wave = __builtin_amdgcn_readfirstlane(F.tid >> 6);
    LAS f32x2* bufA = (LAS f32x2*)F.lds; LAS f32x2* bufB = (LAS f32x2*)(F.lds + 69632);
    const int c = unit >> 1, hb = unit & 1; const int b0 = 4 * hb, b1 = b0 + 1, b2 = b0 + 2, b3 = b0 + 3;
    const bf16_t* HT = (const bf16_t*)(F.ws + WS_HT);
    const size_t bstr = (size_t)3 * 256 * TB;
    const bf16_t* x1p = HT + ((size_t)b0 * 3 * 256 + 0 * 256 + c) * TB; const bf16_t* x2p = HT + ((size_t)b0 * 3 * 256 + 1 * 256 + c) * TB; const bf16_t* vp = HT + ((size_t)b0 * 3 * 256 + 2 * 256 + c) * TB;
    const f32x2* KF0 = (const f32x2*)(F.ws + WS_KF) + (size_t)c * 8192; const f32x2* KF1 = KF0 + (size_t)256 * 8192;
    const float bias0 = INP(F, I_HBIAS)[(l * 2 + 0) * 256 + c], bias1 = INP(F, I_HBIAS)[(l * 2 + 1) * 256 + c];
    f32x2 za[8], zb[8];
    __syncthreads();
#pragma unroll
    for (int q = 0; q < 8; ++q) { const int t = F.tid + NTHR * q; za[q] = (f32x2){bf2f(vp[t]), bf2f(vp[bstr + t])}; zb[q] = (f32x2){bf2f(vp[2 * bstr + t]), bf2f(vp[3 * bstr + t])}; }
#pragma unroll 1
    for (int o = 0; o < 2; ++o) {
        fft_fwd_regs_mulK_x2(bufA, bufB, F.tid, za, zb, o ? KF1 : KF0);
        f32x2 ra[8], rb[8];
        fft_to_regs_lo_x2(bufA, bufB, F.tid, ra, rb);
        const bf16_t* gp = o ? x2p : x1p; const float bias = o ? bias1 : bias0;
#pragma unroll
        for (int q = 0; q < 8; ++q) { const int t = F.tid + NTHR * q;
            za[q] = (f32x2){bf2f(gp[t]) * (ra[q].x + bias * za[q].x), bf2f(gp[bstr + t]) * (-ra[q].y + bias * za[q].y)};
            zb[q] = (f32x2){bf2f(gp[2 * bstr + t]) * (rb[q].x + bias * zb[q].x), bf2f(gp[3 * bstr + t]) * (-rb[q].y + bias * zb[q].y)}; }
        __syncthreads();
    }
    bf16_t* YB = (bf16_t*)(F.ws + WS_YB);
#pragma unroll
    for (int q = 0; q < 8; ++q) { const int t = F.tid + NTHR * q;
        YB[((size_t)b0 * TB + t) * DM + c] = (bf16_t)f2bf(za[q].x); YB[((size_t)b1 * TB + t) * DM + c] = (bf16_t)f2bf(za[q].y);
        YB[((size_t)b2 * TB + t) * DM + c] = (bf16_t)f2bf(zb[q].x); YB[((size_t)b3 * TB + t) * DM + c] = (bf16_t)f2bf(zb[q].y); }
}
__device__ __forceinline__ void hyena_ctx_unit(Frame& F, int l, int unit) {
    F.tid = opaque_tid(F.wv); F.lane = F.tid & 63; F.wave = __builtin_amdgcn_readfirstlane(F.tid >> 6);
    LAS float* zs = (LAS float*)F.lds;
    LAS float* Gs = (LAS float*)(F.lds + 8192);
    const int b = unit >> 5, c0 = (unit & 31) * 8; const int ch = F.tid & 7, tg = F.tid >> 3; const int c = c0 + ch;
    const bf16_t* HT = (const bf16_t*)(F.ws + WS_HT);
    const bf16_t* x1 = HT + (((size_t)b * 3 + 0) * 256 + c) * TB + SEQ; const bf16_t* x2 = HT + (((size_t)b * 3 + 1) * 256 + c) * TB + SEQ; const bf16_t* vv = HT + (((size_t)b * 3 + 2) * 256 + c) * TB + SEQ;
    const float* KC = (const float*)(F.ws + WS_KC);
    const int t0 = tg * 4;
    float z[4];
#pragma unroll
    for (int q = 0; q < 4; ++q) z[q] = bf2f(vv[t0 + q]);
#pragma unroll 1
    for (int o = 0; o < 2; ++o) {
        __syncthreads();
#pragma unroll
        for (int q = 0; q < 4; ++q) zs[(t0 + q) * 8 + ch] = z[q];
        for (int i = F.tid; i < 512 * 8; i += NTHR) { const int d = i >> 3, cc = i & 7; Gs[i] = d < 511 ? KC[((size_t)o * 256 + c0 + cc) * 512 + d] : 0.f; }
        __syncthreads();
        float acc[4] = {0.f, 0.f, 0.f, 0.f};
#pragma unroll 1
        for (int s0 = 0; s0 < 256; s0 += 16) {
            float tw[19];
#pragma unroll
            for (int i = 0; i < 19; ++i) tw[i] = Gs[(t0 - s0 - 15 + i + 255) * 8 + ch];
#pragma unroll
            for (int k = 0; k < 16; ++k) { const float zv = zs[(s0 + k) * 8 + ch];
#pragma unroll
                for (int q = 0; q < 4; ++q) acc[q] += zv * tw[q - k + 15]; }
        }
        const bf16_t* g = o ? x2 : x1; const float bias = INP(F, I_HBIAS)[(l * 2 + o) * 256 + c];
#pragma unroll
        for (int q = 0; q < 4; ++q) z[q] = bf2f(g[t0 + q]) * (acc[q] + bias * z[q]);
    }
    bf16_t* YB = (bf16_t*)(F.ws + WS_YB) + ((size_t)b * TB + SEQ) * DM + c;
#pragma unroll
    for (int q = 0; q < 4; ++q) YB[(size_t)(t0 + q) * DM] = (bf16_t)f2bf(z[q]);
}
namespace attn_body {
constexpr int D = 64, NW = 8, QBLK = 32, QB = QBLK * NW, KVBLK = 64;
__device__ __forceinline__ int crow(int r, int hi) { return (r & 3) + 8 * (r >> 2) + 4 * hi; }
#define SBAR() __builtin_amdgcn_sched_barrier(0)
constexpr int NSLOT = 3, SLOTB = 8192;
constexpr int LDS_K = 0, LDS_V = NSLOT * SLOTB, LDS_WS = 2 * NSLOT * SLOTB, LDS_OST = LDS_WS + NW * 64 * 4, LDS_O1 = LDS_OST + NW * 4096, LDS_BYTES_ATTN = LDS_O1 + NW * 8192;
__device__ __forceinline__ void glds16(const void* gsrc, unsigned lds_dst) { unsigned keep;
  asm volatile("s_mov_b32 %0, m0\n\ts_mov_b32 m0, %2\n\ts_nop 0\n\tglobal_load_lds_dwordx4 %1, off\n\ts_mov_b32 m0, %0" : "=&s"(keep) : "v"(gsrc), "s"(lds_dst) : "memory"); }
__device__ __forceinline__ float max3f(float a, float b, float c) { float r; asm("v_max3_f32 %0, %1, %2, %3" : "=v"(r) : "v"(a), "v"(b), "v"(c)); return r; }
__device__ __forceinline__ float max2f(float a, float b) { float r; asm("v_max_f32_e32 %0, %1, %2" : "=v"(r) : "v"(a), "v"(b)); return r; }
__device__ __forceinline__ float fadd_s(float a, float b) { float r; asm("v_add_f32_e32 %0, %1, %2" : "=v"(r) : "v"(a), "v"(b)); return r; }
__device__ __forceinline__ float fsub_s(float a, float b) { float r; asm("v_sub_f32_e32 %0, %1, %2" : "=v"(r) : "v"(a), "v"(b)); return r; }
typedef float f32x2_t __attribute__((ext_vector_type(2))); typedef __bf16 bf16x2_t __attribute__((ext_vector_type(2)));
__device__ __forceinline__ unsigned cvtpk_s(float lo, float hi) { f32x2_t v = {lo, hi}; bf16x2_t b = __builtin_convertvector(v, bf16x2_t); return __builtin_bit_cast(unsigned, b); }
#define WAIT_BAR(N) asm volatile("s_waitcnt vmcnt(" #N ") lgkmcnt(0)\n\ts_barrier" ::: "memory")
template <int ND0> __device__ __forceinline__ void qkt(f32x16& p0, f32x16& p1, const char* Kslot, const bf16x8* qr, const f32x16& negm, int r32, int hi) {
  const char* kb = Kslot + hi * 1024 + r32 * 16;
  #pragma unroll
  for (int d0 = 0; d0 < ND0; ++d0) {
    const bf16x8 b0 = *reinterpret_cast<const bf16x8*>(kb + d0 * 2048);
    const bf16x8 b1 = *reinterpret_cast<const bf16x8*>(kb + d0 * 2048 + 512);
    if (d0 == 0) { p0 = __builtin_amdgcn_mfma_f32_32x32x16_bf16(b0, qr[0], negm, 0, 0, 0); p1 = __builtin_amdgcn_mfma_f32_32x32x16_bf16(b1, qr[0], negm, 0, 0, 0); }
    else { p0 = __builtin_amdgcn_mfma_f32_32x32x16_bf16(b0, qr[d0], p0, 0, 0, 0); p1 = __builtin_amdgcn_mfma_f32_32x32x16_bf16(b1, qr[d0], p1, 0, 0, 0); } }
}
typedef __attribute__((address_space(3))) const char* lds_cptr;
typedef short v4i16_t __attribute__((ext_vector_type(4)));
template <int ND0> __device__ __forceinline__ void kload8(bf16x8* kf, lds_cptr kp) {
  kf[0] = *(const __attribute__((address_space(3))) bf16x8*)(kp);        kf[1] = *(const __attribute__((address_space(3))) bf16x8*)(kp + 512);
  kf[2] = *(const __attribute__((address_space(3))) bf16x8*)(kp + 2048); kf[3] = *(const __attribute__((address_space(3))) bf16x8*)(kp + 2560);
  if constexpr (ND0 == 4) {
  kf[4] = *(const __attribute__((address_space(3))) bf16x8*)(kp + 4096); kf[5] = *(const __attribute__((address_space(3))) bf16x8*)(kp + 4608);
  kf[6] = *(const __attribute__((address_space(3))) bf16x8*)(kp + 6144); kf[7] = *(const __attribute__((address_space(3))) bf16x8*)(kp + 6656); }
}
__device__ __forceinline__ void kload2(bf16x8* kf, lds_cptr kp, int j) { kf[2 * j] = *(const __attribute__((address_space(3))) bf16x8*)(kp + j * 2048); kf[2 * j + 1] = *(const __attribute__((address_space(3))) bf16x8*)(kp + j * 2048 + 512); }
__device__ __forceinline__ s16x4 vtr(lds_cptr p) { return __builtin_bit_cast(s16x4, __builtin_amdgcn_ds_read_tr16_b64_v4i16((__attribute__((address_space(3))) v4i16_t*)p)); }
__device__ __forceinline__ float rowmax(const f32x16& p0, const f32x16& p1) {
  float a = max3f(p0[0], p0[1], p1[0]), b = max3f(p0[2], p0[3], p1[1]); a = max3f(a, p1[2], p1[3]);
  #pragma unroll
  for (int r = 4; r < 16; r += 4) { a = max3f(a, p0[r], p0[r + 1]); b = max3f(b, p0[r + 2], p0[r + 3]); a = max3f(a, p1[r], p1[r + 1]); b = max3f(b, p1[r + 2], p1[r + 3]); }
  const float m = max2f(a, b);
  auto rr = __builtin_amdgcn_permlane32_swap(__float_as_uint(m), __float_as_uint(m), false, false);
  return max2f(__uint_as_float(rr[0]), __uint_as_float(rr[1]));
}
__device__ __forceinline__ void pv(f32x16* o, int vb, bf16x8 pa0, bf16x8 pa1, bf16x8 pa2, bf16x8 pa3) {
  #pragma unroll
  for (int d0 = 0; d0 < 2; ++d0) { s16x4 lo[4], hi[4];
    #pragma unroll
    for (int ks = 0; ks < 4; ++ks) {
      asm volatile("ds_read_b64_tr_b16 %0,%1 offset:%c2" : "=&v"(lo[ks]) : "v"(vb), "i"(d0 * 4096 + ks * 1024) : "memory");
      asm volatile("ds_read_b64_tr_b16 %0,%1 offset:%c2" : "=&v"(hi[ks]) : "v"(vb), "i"(d0 * 4096 + ks * 1024 + 512) : "memory"); }
    asm volatile("s_waitcnt lgkmcnt(0)" ::: "memory"); SBAR();
    #define PK(k) (bf16x8){lo[k][0], lo[k][1], lo[k][2], lo[k][3], hi[k][0], hi[k][1], hi[k][2], hi[k][3]}
    o[d0] = __builtin_amdgcn_mfma_f32_32x32x16_bf16(pa0, PK(0), o[d0], 0, 0, 0);
    o[d0] = __builtin_amdgcn_mfma_f32_32x32x16_bf16(pa1, PK(1), o[d0], 0, 0, 0);
    o[d0] = __builtin_amdgcn_mfma_f32_32x32x16_bf16(pa2, PK(2), o[d0], 0, 0, 0);
    o[d0] = __builtin_amdgcn_mfma_f32_32x32x16_bf16(pa3, PK(3), o[d0], 0, 0, 0);
    #undef PK
  }
}
template <int THRL, int MODE, int DQ = 64> __device__ __forceinline__ void attn_unit(const bf16_t* Qw0, int qp, const bf16_t* __restrict__ Kh, int kp, const bf16_t* __restrict__ Vh, int vp, int NT, bf16_t* Ow0, int op, char* shm, float lam, const float* gsub, float post, const int wv) {
  const int tid = opaque_tid(wv), lane = tid & 63, r32 = lane & 31, hi = lane >> 5; const int wid = __builtin_amdgcn_readfirstlane(tid >> 6);
  const bf16_t* Qw = Qw0 + (long)wid * QBLK * qp;
  const unsigned lds0 = (unsigned)(uintptr_t)shm;
  float* wsf = (float*)(shm + LDS_WS) + wid * 64;
  constexpr int ND0 = DQ / 16;
  const int kch = (DQ == 32) ? (wid & 3) : wid;
  const bf16_t* ksrc = Kh + (long)lane * kp + kch * 8;
  const bf16_t* vsrc = Vh + (long)(16 * (wid & 3) + (lane >> 2)) * vp + (wid >> 2) * 32 + (lane & 3) * 8;
  const unsigned kdst = lds0 + LDS_K + kch * 1024, vdst = lds0 + LDS_V + wid * 1024;
  #define DMA_K(t, slot) glds16(ksrc + (long)(t) * KVBLK * kp, (unsigned)__builtin_amdgcn_readfirstlane(kdst + (slot)))
  #define DMA_V(t, slot) glds16(vsrc + (long)(t) * KVBLK * vp, (unsigned)__builtin_amdgcn_readfirstlane(vdst + (slot)))
  const int vb0 = (int)(lds0 + LDS_V) + ((lane >> 4) & 1) * 32 + (lane & 3) * 8 + (4 * hi + ((lane & 15) >> 2)) * 64;
  const char* Kbase = shm + LDS_K; bf16x8 kf[8];
  const lds_cptr shm3 = (lds_cptr)shm; const lds_cptr kp0 = shm3 + LDS_K + hi * 1024 + r32 * 16; const lds_cptr vp0 = shm3 + LDS_V + ((lane >> 4) & 1) * 32 + (lane & 3) * 8 + (4 * hi + ((lane & 15) >> 2)) * 64;
  DMA_K(0, 0); DMA_V(0, 0); DMA_K(1, SLOTB);
  bf16x8 qr[4];
  #pragma unroll
  for (int d0 = 0; d0 < ND0; ++d0) qr[d0] = *reinterpret_cast<const bf16x8*>(&Qw[(long)r32 * qp + d0 * 16 + hi * 8]);
  float mhat = 0.f, l_reg = 0.f; f32x16 o[2]; o[0] = f32x16{}; o[1] = f32x16{}; f32x16 negm = f32x16{}; asm volatile("" : "+v"(negm));
  bool resc = false;
  #define START(P0, P1) do { const float rm = rowmax(P0, P1); resc = false; \
    { const float dl = rm; mhat = fadd_s(mhat, dl); \
      _Pragma("unroll") for (int r = 0; r < 16; ++r) { P0[r] = fsub_s(P0[r], dl); P1[r] = fsub_s(P1[r], dl); } \
      _Pragma("unroll") for (int r = 0; r < 16; ++r) negm[r] = -mhat; asm volatile("" : "+v"(negm)); } \
    _Pragma("unroll") for (int r = 0; r < 16; ++r) P0[r] = __builtin_amdgcn_exp2f(P0[r]); } while (0)
  #define RESC() do { if (resc) { asm volatile("s_waitcnt lgkmcnt(0)" ::: "memory"); \
      _Pragma("unroll") for (int d_ = 0; d_ < 2; ++d_) _Pragma("unroll") for (int r = 0; r < 16; ++r) o[d_][r] *= wsf[crow(r, hi)]; } } while (0)
  f32x16 pA0, pA1, pB0, pB1;
  int sl_prev = 0, sl_cur = 0, sl_next = SLOTB;
  #define ROT() do { sl_prev = sl_cur; sl_cur = sl_next; sl_next = (sl_next == (NSLOT - 1) * SLOTB) ? 0 : sl_next + SLOTB; } while (0)
  DMA_K(2, 2 * SLOTB);
  WAIT_BAR(3);
  qkt<ND0>(pA0, pA1, Kbase, qr, negm, r32, hi); asm volatile("s_nop 15\n\ts_nop 7" : "+v"(pA0), "+v"(pA1));
  START(pA0, pA1);
  _Pragma("unroll") for (int r = 0; r < 16; ++r) pA1[r] = __builtin_amdgcn_exp2f(pA1[r]);
  WAIT_BAR(0);
  DMA_K(3, 0); DMA_V(1, SLOTB);
  ROT();
  kload8<ND0>(kf, kp0 + sl_cur);
  WAIT_BAR(2);
  s16x4 vlo[8], vhi[8]; u32x4 pw0, pw1, pw2, pw3;
  #define PKW(P, B) cvtpk_s(P[B], P[B + 1])
  #define PAF(k) __builtin_bit_cast(bf16x8, pw##k)
  #define VFR(i) (bf16x8){vlo[i][0], vlo[i][1], vlo[i][2], vlo[i][3], vhi[i][0], vhi[i][1], vhi[i][2], vhi[i][3]}
  #define PIN(x) asm volatile("" : "+v"(x))
  #define MX3(a, b, c) __builtin_fmaxf(__builtin_fmaxf((a), (b)), (c))
  #define GAPA(MF, A0, A1, A2, A3, W0, W1, PW) do { MF; sacc += A0; sacc += A1; sacc += A2; sacc += A3; PIN(sacc); W0; W1; PIN(PW); SBAR(); } while (0)
  #define EX(v) __builtin_amdgcn_exp2f(v)
  #define GAPB(MF, X, B) do { MF; X[B] = EX(X[B]); X[B + 1] = EX(X[B + 1]); X[B + 2] = EX(X[B + 2]); X[B + 3] = EX(X[B + 3]); PIN(X); SBAR(); } while (0)
  #define VRD(i) do { vlo[i] = vtr(vp_ + (((i) >> 2) * 4096 + ((i) & 3) * 1024)); vhi[i] = vtr(vp_ + (((i) >> 2) * 4096 + ((i) & 3) * 1024 + 512)); } while (0)
  #define KRD(G, j) do { if ((j) < ND0 && (G)) { kload2(kf, kp0 + sl_next, j); SBAR(); } } while (0)
  #define QKX(C, k, q) do { if constexpr (ND0 == 4) { C = __builtin_amdgcn_mfma_f32_32x32x16_bf16(kf[k], qr[q], C, 0, 0, 0); } } while (0)
  #define STEP(C0, C1, P0, P1, t, GK, GV, GL) do { SBAR(); \
    const lds_cptr vp_ = vp0 + sl_prev; \
    VRD(0); SBAR(); float sacc = (P0[0] + P0[1]); \
    GAPA(C0 = __builtin_amdgcn_mfma_f32_32x32x16_bf16(kf[0], qr[0], negm, 0, 0, 0), P0[2], P0[3], P0[4], P0[5],     pw0[0] = PKW(P0, 0), pw0[1] = PKW(P0, 2), pw0); \
    VRD(4); SBAR(); GAPA(C1 = __builtin_amdgcn_mfma_f32_32x32x16_bf16(kf[1], qr[0], negm, 0, 0, 0), P0[6], P0[7], P0[8], P0[9],     pw0[2] = PKW(P0, 4), pw0[3] = PKW(P0, 6), pw0); \
    VRD(1); SBAR(); GAPA(C0 = __builtin_amdgcn_mfma_f32_32x32x16_bf16(kf[2], qr[1], C0, 0, 0, 0),   P0[10], P0[11], P0[12], P0[13], pw1[0] = PKW(P0, 8), pw1[1] = PKW(P0, 10), pw1); \
    VRD(5); SBAR(); GAPA(C1 = __builtin_amdgcn_mfma_f32_32x32x16_bf16(kf[3], qr[1], C1, 0, 0, 0),   P0[14], P0[15], P1[0], P1[1],   pw1[2] = PKW(P0, 12), pw1[3] = PKW(P0, 14), pw1); \
    VRD(2); SBAR(); GAPA(QKX(C0, 4, 2),   P1[2], P1[3], P1[4], P1[5],     pw2[0] = PKW(P1, 0), pw2[1] = PKW(P1, 2), pw2); \
    VRD(6); SBAR(); GAPA(QKX(C1, 5, 2),   P1[6], P1[7], P1[8], P1[9],     pw2[2] = PKW(P1, 4), pw2[3] = PKW(P1, 6), pw2); \
    VRD(3); SBAR(); GAPA(QKX(C0, 6, 3),   P1[10], P1[11], P1[12], P1[13], pw3[0] = PKW(P1, 8), pw3[1] = PKW(P1, 10), pw3); \
    VRD(7); SBAR(); GAPA(QKX(C1, 7, 3),   P1[14], P1[15], 0.f, 0.f,       pw3[2] = PKW(P1, 12), pw3[3] = PKW(P1, 14), pw3); \
    l_reg += sacc; \
    if (GK) { DMA_K((t) + 3, sl_cur); } if (GV) { DMA_V((t) + 1, sl_next); } \
    { float a = MX3(C0[0], C0[1], C1[0]), b = MX3(C0[2], C0[3], C1[1]); a = MX3(a, C1[2], C1[3]); \
      _Pragma("unroll") for (int r = 4; r < 16; r += 4) { a = MX3(a, C0[r], C0[r + 1]); b = MX3(b, C0[r + 2], C0[r + 3]); a = MX3(a, C1[r], C1[r + 1]); b = MX3(b, C1[r + 2], C1[r + 3]); } \
      float rm = __builtin_fmaxf(a, b); { auto rr = __builtin_amdgcn_permlane32_swap(__float_as_uint(rm), __float_as_uint(rm), false, false); rm = __builtin_fmaxf(__uint_as_float(rr[0]), __uint_as_float(rr[1])); } \
      resc = false; \
      if (__builtin_expect(__any(rm > (float)THRL), 0)) { const float dl = __builtin_fmaxf(rm, 0.f); mhat += dl; \
        _Pragma("unroll") for (int r = 0; r < 16; ++r) { C0[r] -= dl; C1[r] -= dl; } \
        _Pragma("unroll") for (int r = 0; r < 16; ++r) negm[r] = -mhat; asm volatile("" : "+v"(negm)); \
        const float f = __builtin_amdgcn_exp2f(-dl); l_reg *= f; if (hi == 0) wsf[r32] = f; resc = true; } } \
    SBAR(); \
    GAPB(o[0] = __builtin_amdgcn_mfma_f32_32x32x16_bf16(PAF(0), VFR(0), o[0], 0, 0, 0), C0, 0); \
    GAPB(o[1] = __builtin_amdgcn_mfma_f32_32x32x16_bf16(PAF(0), VFR(4), o[1], 0, 0, 0), C0, 4); \
    KRD(GL, 0); GAPB(o[0] = __builtin_amdgcn_mfma_f32_32x32x16_bf16(PAF(1), VFR(1), o[0], 0, 0, 0), C0, 8); \
    KRD(GL, 1); GAPB(o[1] = __builtin_amdgcn_mfma_f32_32x32x16_bf16(PAF(1), VFR(5), o[1], 0, 0, 0), C0, 12); \
    KRD(GL, 2); GAPB(o[0] = __builtin_amdgcn_mfma_f32_32x32x16_bf16(PAF(2), VFR(2), o[0], 0, 0, 0), C1, 0); \
    KRD(GL, 3); GAPB(o[1] = __builtin_amdgcn_mfma_f32_32x32x16_bf16(PAF(2), VFR(6), o[1], 0, 0, 0), C1, 4); \
    GAPB(o[0] = __builtin_amdgcn_mfma_f32_32x32x16_bf16(PAF(3), VFR(3), o[0], 0, 0, 0), C1, 8); \
    GAPB(o[1] = __builtin_amdgcn_mfma_f32_32x32x16_bf16(PAF(3), VFR(7), o[1], 0, 0, 0), C1, 12); \
    } while (0)
  int t = 1;
  for (; t + 5 < NT; t += 2) {
    STEP(pB0, pB1, pA0, pA1, t, true, true, true);     WAIT_BAR(2); RESC(); ROT();
    STEP(pA0, pA1, pB0, pB1, t + 1, true, true, true); WAIT_BAR(2); RESC(); ROT();
  }
  #define ENDW(tt) do { if ((tt) + 3 < NT) { WAIT_BAR(2); } else if ((tt) + 2 < NT) { WAIT_BAR(1); } else { WAIT_BAR(0); } } while (0)
  for (; t + 1 < NT; t += 2) {
    STEP(pB0, pB1, pA0, pA1, t, (t + 3 < NT), (t + 1 < NT), (t + 1 < NT));         ENDW(t);     RESC(); ROT();
    STEP(pA0, pA1, pB0, pB1, t + 1, (t + 4 < NT), (t + 2 < NT), (t + 2 < NT));     ENDW(t + 1); RESC(); ROT();
  }
  STEP(pB0, pB1, pA0, pA1, NT - 1, false, false, false); RESC();
  { float sacc = pB0[0] + pB0[1]; _Pragma("unroll") for (int r = 2; r < 16; ++r) sacc += pB0[r]; _Pragma("unroll") for (int r = 0; r < 16; ++r) sacc += pB1[r]; l_reg += sacc;
    pw0 = (u32x4){PKW(pB0, 0), PKW(pB0, 2), PKW(pB0, 4), PKW(pB0, 6)}; pw1 = (u32x4){PKW(pB0, 8), PKW(pB0, 10), PKW(pB0, 12), PKW(pB0, 14)}; pw2 = (u32x4){PKW(pB1, 0), PKW(pB1, 2), PKW(pB1, 4), PKW(pB1, 6)}; pw3 = (u32x4){PKW(pB1, 8), PKW(pB1, 10), PKW(pB1, 12), PKW(pB1, 14)};
    SBAR(); pv(o, vb0 + sl_cur, PAF(0), PAF(1), PAF(2), PAF(3)); }
  #undef PKW
  #undef PAF
  #undef VFR
  #undef PIN
  #undef MX3
  #undef GAPA
  #undef GAPB
  #undef EX
  #undef VRD
  #undef KRD
  #undef QKX
  #undef STEP
  #undef ENDW
  { auto rr = __builtin_amdgcn_permlane32_swap(__float_as_uint(l_reg), __float_as_uint(l_reg), false, false); l_reg = __uint_as_float(rr[0]) + __uint_as_float(rr[1]); }
  if (hi == 0) wsf[32 + r32] = l_reg; asm volatile("s_waitcnt lgkmcnt(0)" ::: "memory");
  float rli[16];
  #pragma unroll
  for (int r = 0; r < 16; ++r) rli[r] = __builtin_amdgcn_rcpf(wsf[32 + crow(r, hi)]);
  bf16_t* Ow = Ow0 + (long)wid * QBLK * op;
  float* o1s = (float*)(shm + LDS_O1) + wid * 2048;
  if constexpr (MODE == 0) {
    bf16_t* stg = (bf16_t*)(shm + LDS_OST) + wid * 2048;
    #pragma unroll
    for (int r = 0; r < 16; ++r) { const int orow = crow(r, hi);
      #pragma unroll
      for (int d0 = 0; d0 < 2; ++d0) stg[orow * 64 + d0 * 32 + r32] = (bf16_t)f2bf(o[d0][r] * rli[r]); }
    asm volatile("s_waitcnt lgkmcnt(0)" ::: "memory");
    #pragma unroll
    for (int i = 0; i < 4; ++i) { const int row = i * 8 + (lane >> 3), ch = lane & 7; const u32x4 v = *(const u32x4*)(stg + row * 64 + ch * 8); *(u32x4*)(Ow + (long)row * op + ch * 8) = v; }
  } else if constexpr (MODE == 1) {
    #pragma unroll
    for (int r = 0; r < 16; ++r) { const int orow = crow(r, hi);
      #pragma unroll
      for (int d0 = 0; d0 < 2; ++d0) o1s[orow * 64 + d0 * 32 + r32] = o[d0][r] * rli[r]; }
  } else {
    #pragma unroll
    for (int r = 0; r < 16; ++r) { const int orow = crow(r, hi);
      #pragma unroll
      for (int d0 = 0; d0 < 2; ++d0) { const int ix = orow * 64 + d0 * 32 + r32; o1s[ix] = o1s[ix] - lam * (o[d0][r] * rli[r]); } }
    asm volatile("s_waitcnt lgkmcnt(0)" ::: "memory");
    #pragma unroll
    for (int i = 0; i < 4; ++i) { const int row = i * 8 + (lane >> 3), ch = lane & 7;
      const f32x4 a = *(const f32x4*)(o1s + row * 64 + ch * 8), b = *(const f32x4*)(o1s + row * 64 + ch * 8 + 4);
      float ss = (a[0] * a[0] + a[1] * a[1]) + (a[2] * a[2] + a[3] * a[3]) + (b[0] * b[0] + b[1] * b[1]) + (b[2] * b[2] + b[3] * b[3]);
      ss += __builtin_bit_cast(float, __builtin_amdgcn_update_dpp(0, __builtin_bit_cast(int, ss), 0xB1, 0xf, 0xf, false));
      ss += __builtin_bit_cast(float, __builtin_amdgcn_update_dpp(0, __builtin_bit_cast(int, ss), 0x4E, 0xf, 0xf, false));
      ss += __builtin_bit_cast(float, __builtin_amdgcn_update_dpp(0, __builtin_bit_cast(int, ss), 0x141, 0xf, 0xf, false));
      const float rs = post / sqrtf(ss * (1.0f / 64.0f) + EPS);
      const f32x4 g0 = *(const f32x4*)(gsub + ch * 8), g1 = *(const f32x4*)(gsub + ch * 8 + 4);
      u32x4 v; v.x = pk2(a[0] * rs * g0[0], a[1] * rs * g0[1]); v.y = pk2(a[2] * rs * g0[2], a[3] * rs * g0[3]); v.z = pk2(b[0] * rs * g1[0], b[1] * rs * g1[1]); v.w = pk2(b[2] * rs * g1[2], b[3] * rs * g1[3]);
      *(u32x4*)(Ow + (long)row * op + ch * 8) = v; }
  }
  asm volatile("s_waitcnt lgkmcnt(0)\n\ts_barrier" ::: "memory");
  #undef DMA_K
  #undef DMA_V
  #undef START
  #undef RESC
  #undef ROT
}
#undef SBAR
#undef WAIT_BAR
}
__device__ __forceinline__ void norm2_rows(Frame& F, int l) {
    F.tid = opaque_tid(F.wv); F.lane = F.tid & 63; F.wave = __builtin_amdgcn_readfirstlane(F.tid >> 6);
    const int gw = F.bid * NWAVES + F.wave, NGW = F.G * NWAVES;
    const bool moe = l & 1, last = l == DEPTH - 1; const int li = l >> 1;
    const float* gain = INP(F, I_NFFN) + l * DM;
    const float* wr = INP(F, I_ROUTER) + (size_t)li * DM * NEXP;
    unsigned* cw = F.ctl + CW_MOE + li * NEXP * 64;
    int* TOK = (int*)(F.ws + WS_TOK); float* GWT = (float*)(F.ws + WS_GW);
    LAS int* lcnt = (LAS int*)F.lds;
    LAS int* lbase = lcnt + 8;
    LAS int* nrec = lcnt + 16;
    LAS int* rec_m = lcnt + 32;
    LAS int* rec_e = rec_m + 1024;
    LAS float* rec_g = (LAS float*)(rec_e + 1024);
    f32x4 wreg[16][2];
    if (moe) { __syncthreads(); if (F.tid < 17) lcnt[F.tid] = 0; __syncthreads();
#pragma unroll
        for (int j = 0; j < 4; ++j)
#pragma unroll
            for (int q = 0; q < 4; ++q) { const int col = 4 * F.lane + 256 * j + q; wreg[4 * j + q][0] = *(const f32x4*)(wr + (size_t)col * NEXP); wreg[4 * j + q][1] = *(const f32x4*)(wr + (size_t)col * NEXP + 4); } }
    f32x4 cur[4], nxt[4], nx2[4]; load_xrow(F, gw, 0, cur); load_xrow(F, (gw + NGW < MT) ? gw + NGW : gw, 0, nxt);
    for (int m = gw; m < MT; m += NGW) {
        const int mn = (m + 2 * NGW < MT) ? m + 2 * NGW : m;
        float h[16];
        const bool skip = last && (m % TB) >= SEQ;
        if (!skip) norm_row(F, l, m, 3, 0, h, true, cur, mn, nx2); else load_xrow(F, mn, 0, nx2);
#pragma unroll
        for (int j = 0; j < 4; ++j) { cur[j] = nxt[j]; nxt[j] = nx2[j]; }
        if (skip) continue;
        if (moe) {
            float lg[NEXP];
#pragma unroll
            for (int e = 0; e < NEXP; ++e) lg[e] = 0.f;
#pragma unroll
            for (int j = 0; j < 4; ++j)
#pragma unroll
                for (int q = 0; q < 4; ++q) { const f32x4 w0 = wreg[4 * j + q][0], w1 = wreg[4 * j + q][1]; const float hv = h[4 * j + q];
                    lg[0] += hv * w0[0]; lg[1] += hv * w0[1]; lg[2] += hv * w0[2]; lg[3] += hv * w0[3]; lg[4] += hv * w1[0]; lg[5] += hv * w1[1]; lg[6] += hv * w1[2]; lg[7] += hv * w1[3]; }
#pragma unroll
            for (int e = 0; e < NEXP; ++e) lg[e] = wave_sum(lg[e]);
            int e1 = 0; float v1 = lg[0];
#pragma unroll
            for (int e = 1; e < NEXP; ++e) if (lg[e] > v1) { v1 = lg[e]; e1 = e; }
            int e2 = -1; float v2 = -INFINITY;
#pragma unroll
            for (int e = 0; e < NEXP; ++e) if (e != e1 && lg[e] > v2) { v2 = lg[e]; e2 = e; }
            const float g1 = 1.0f / (1.0f + __expf(v2 - v1)), g2 = 1.0f - g1;
            if (F.lane < 2) { const int e = F.lane ? e2 : e1; const float g = F.lane ? g2 : g1;
                const int rank = __hip_atomic_fetch_add(lcnt + e, 1, __ATOMIC_RELAXED, __HIP_MEMORY_SCOPE_WORKGROUP);
                const int slot = __hip_atomic_fetch_add(nrec, 1, __ATOMIC_RELAXED, __HIP_MEMORY_SCOPE_WORKGROUP);
                rec_m[slot] = (int)((unsigned)m | ((unsigned)F.lane << 31)); rec_e[slot] = (e << 16) | rank; rec_g[slot] = g; }
        }
    }
    if (moe) {
        __syncthreads();
        if (F.tid < NEXP) lbase[F.tid] = (int)__hip_atomic_fetch_add(cw + F.tid * 64, (unsigned)lcnt[F.tid], RLX_AGENT);
        __syncthreads();
        const int n = nrec[0];
        for (int i = F.tid; i < n; i += NTHR) { const int er = rec_e[i], e = er >> 16, pos = lbase[e] + (er & 0xffff);
            TOK[(size_t)e * MT + pos] = rec_m[i]; GWT[(size_t)e * MT + pos] = rec_g[i]; }
        __syncthreads();
    }
}
__device__ __forceinline__ void final_rows(Frame& F) {
    F.tid = opaque_tid(F.wv); F.lane = F.tid & 63; F.wave = __builtin_amdgcn_readfirstlane(F.tid >> 6);
    const int gw = F.bid * NWAVES + F.wave, NGW = F.G * NWAVES; const int l = DEPTH - 1;
    const float* MODS = (const float*)(F.ws + WS_MODS);
    for (int i = gw; i < NB * SEQ; i += NGW) { const int b = i / SEQ, t = i - b * SEQ; const int m = b * TB + t;
        GAS f32x4* xr = (GAS f32x4*)(F.out + (size_t)i * DM) + F.lane;
        const bf16_t* sl = (const bf16_t*)(F.ws + WS_SLOT) + (size_t)m * 2 * DM; const float* m5 = MODS + ((size_t)l * 9 + b) * 6144 + 5 * DM;
#pragma unroll
        for (int j = 0; j < 4; ++j) { const int col = 4 * F.lane + 256 * j; f32x4 v = xr[64 * j];
            const u32x2 s0 = *(const u32x2*)(sl + col), s1 = *(const u32x2*)(sl + DM + col); const f32x4 mq = *(const f32x4*)(m5 + col);
            v[0] += mq[0] * (bf_lo(s0.x) + bf_lo(s1.x)); v[1] += mq[1] * (bf_hi(s0.x) + bf_hi(s1.x)); v[2] += mq[2] * (bf_lo(s0.y) + bf_lo(s1.y)); v[3] += mq[3] * (bf_hi(s0.y) + bf_hi(s1.y));
            xr[64 * j] = v; } }
}

struct Args { const float* in[42]; float* out; unsigned char* ws; };

#define PHASE_BEGIN { F.tid = opaque_tid(F.wv); F.lane = F.tid & 63; F.wave = __builtin_amdgcn_readfirstlane(F.tid >> 6); \
    F.ws = (unsigned char*)opaque_ptr(args.ws); F.ctl = (unsigned*)(F.ws + WS_CTL); F.out = (float*)(GAS float*)opaque_ptr(args.out);
#define PHASE_END   { XcdBarrier b2_ = bar; b2_.bar = (unsigned*)opaque_ptr(F.ctl + CW_BAR); unsigned x_ = __builtin_amdgcn_readfirstlane(bar.x); asm volatile("" : "+s"(x_)); b2_.x = x_; xcd_barrier(b2_); } }
template <int l> __device__ __forceinline__ void layer_phases(Frame& F, const Args& args, const XcdBarrier& bar, LAS unsigned* misc, const int vcu, const XMap& X, unsigned char* lds) {
        constexpr bool last = l == DEPTH - 1, moe = l & 1; constexpr int li = l >> 1;

        PHASE_BEGIN
            __syncthreads();
            if (l == 0 || F.G != 256) for (int c = F.bid; c < 256; c += F.G) hyena_filter_unit(F, l, c);
            __syncthreads();
            convert_weights(F, l);
            { const int gw = F.bid * NWAVES + F.wave, NGW = F.G * NWAVES; const float* gain = INP(F, I_NMIX) + l * DM; const int mode = (l == 0) ? 1 : ((l & 1) ? 0 : 2); float h[16];
              f32x4 cur[4], nxt[4], nx2[4]; load_xrow(F, gw, mode, cur); load_xrow(F, (gw + NGW < MT) ? gw + NGW : gw, mode, nxt);
              for (int m = gw; m < MT; m += NGW) { const int mn = (m + 2 * NGW < MT) ? m + 2 * NGW : m;
                  norm_row(F, l, m, 0, mode, h, true, cur, mn, nx2);
#pragma unroll
                  for (int j = 0; j < 4; ++j) { cur[j] = nxt[j]; nxt[j] = nx2[j]; } } }
        PHASE_END
        PHASE_BEGIN
            SchedPlain S; S.init((const bf16_t*)(F.ws + WS_HB), (const bf16_t*)(F.ws + WS_WIN), NPAN, D_IN / 256, DM, F.G, F.bid);
            EpiInProj E{(bf16_t*)(F.ws + WS_UB), (bf16_t*)(F.ws + WS_RB)};
            pg8::gemm_phase<EpiInProj, SchedPlain, false, false>(F.lds, DM, S, E, F.wv);
        PHASE_END
        PHASE_BEGIN
            for (int u = F.bid; u < NB * 68 * 3; u += F.G) hyena_short_unit(F, l, u);
            for (int u = F.bid; u < NB * 136; u += F.G) conformer_unit(F, l, u);
            qk_prep_tables(F);
            qk_prep_items(F, l);
        PHASE_END
        PHASE_BEGIN
            __syncthreads();
            const bf16_t* QG = (const bf16_t*)(F.ws + WS_QG); const bf16_t* KG = (const bf16_t*)(F.ws + WS_KG); const bf16_t* QD = (const bf16_t*)(F.ws + WS_QD); const bf16_t* KD = (const bf16_t*)(F.ws + WS_KD);
            const bf16_t* UB = (const bf16_t*)(F.ws + WS_UB); bf16_t* YB = (bf16_t*)(F.ws + WS_YB);
#pragma unroll 1
            for (int i = 0; i < 3; ++i) {
                int b, hq, kvh, NT; size_t row0, kv0;
                if (i < 2) { const int U = vcu + F.G * i; if (U >= 512) continue; const int pr = U >> 5, w = U & 31; b = pr >> 1; kvh = pr & 1; hq = kvh * 2 + (w >> 4); row0 = (size_t)b * TB + (w & 15) * 256; kv0 = (size_t)b * TB; NT = 68; }
                else { if (last || F.bid >= 32) continue; b = F.bid >> 2; hq = F.bid & 3; kvh = hq >> 1; row0 = (size_t)b * TB + SEQ; kv0 = row0; NT = 4; }
                attn_body::attn_unit<8, 0>(QG + row0 * 256 + hq * 64, 256, KG + kv0 * 128 + kvh * 64, 128, UB + kv0 * UBW + OFF_GQA + 384 + kvh * 64, UBW, NT,
                                           YB + row0 * DM + 512 + hq * 64, DM, (char*)lds, 0.f, nullptr, 0.f, F.wv);
            }
            float lam, post; const float* gsub = INP(F, I_SUBLN) + l * 64;
            { float s1 = 0.f, s2 = 0.f;
              for (int i = 0; i < 32; ++i) { s1 += INP(F, I_LQ1)[l * 32 + i] * INP(F, I_LK1)[l * 32 + i]; s2 += INP(F, I_LQ2)[l * 32 + i] * INP(F, I_LK2)[l * 32 + i]; }
              const float lam_init = 0.8f - 0.6f * expf(-0.3f * (float)l); lam = expf(s1) - expf(s2) + lam_init; post = 1.0f - lam_init; }
#pragma unroll 1
            for (int i = 0; i < 3; ++i) {
                int b, h, NT; size_t row0, kv0;
                if (i < 2) { const int U = vcu + F.G * i; if (U >= 512) continue; const int pr = U >> 4; b = pr >> 2; h = pr & 3; row0 = (size_t)b * TB + (U & 15) * 256; kv0 = (size_t)b * TB; NT = 68; }
                else { if (last || F.bid < 32 || F.bid >= 64) continue; const int u = F.bid - 32; b = u >> 2; h = u & 3; row0 = (size_t)b * TB + SEQ; kv0 = row0; NT = 4; }
                const bf16_t* Vh = UB + kv0 * UBW + OFF_DIFF + 512 + h * 64;
                attn_body::attn_unit<8, 1, 32>(QD + row0 * 256 + (h * 2) * 32, 256, KD + kv0 * 256 + (h * 2) * 32, 256, Vh, UBW, NT, nullptr, 0, (char*)lds, 0.f, nullptr, 0.f, F.wv);
                attn_body::attn_unit<8, 2, 32>(QD + row0 * 256 + (h * 2 + 1) * 32, 256, KD + kv0 * 256 + (h * 2 + 1) * 32, 256, Vh, UBW, NT, YB + row0 * DM + 768 + h * 64, DM, (char*)lds, lam, gsub, post, F.wv);
            }
            if (!last) hyena_ctx_unit(F, l, F.bid);
            __syncthreads();
#pragma unroll 1
            for (int i = 0; i < 2; ++i) { const int U = vcu * 2 + i; if (U < 512) hyena_conv_unit(F, l, U); }
        PHASE_END
        PHASE_BEGIN
            SchedPlain S; S.init((const bf16_t*)(F.ws + WS_YB), (const bf16_t*)(F.ws + WS_WBR), NPAN, 4, DM, F.G, F.bid, last);
            EpiMerge E{(const bf16_t*)(F.ws + WS_RB), (bf16_t*)(F.ws + WS_HB)};
            pg8::gemm_phase<EpiMerge, SchedPlain, false, true>(F.lds, DM, S, E, F.wv);
            if (!last && F.G == 256 && F.bid >= 32) { __syncthreads(); hyena_filter_unit(F, l + 1, F.bid - 32); __syncthreads(); }
        PHASE_END
        PHASE_BEGIN
            SchedPlain S; S.init((const bf16_t*)(F.ws + WS_HB), (const bf16_t*)(F.ws + WS_WOUT), NPAN, 4, DM, F.G, F.bid, last);
            EpiResid E{X, (const float*)(F.ws + WS_MODS) + (size_t)l * 9 * 6144 + 2 * DM, last, l == 0 ? INP(F, I_X) : (const float*)X.lat, l == 0 ? INP(F, I_CTX) : (const float*)X.ctx};
            pg8::gemm_phase<EpiResid, SchedPlain, false, false, false>(F.lds, DM, S, E, F.wv);
            if (!last && F.G == 256 && F.bid >= 32 && F.bid < 64) { __syncthreads(); hyena_filter_unit(F, l + 1, F.bid + 192); __syncthreads(); }
            else if (!last && F.bid >= NPAN * 4 - 2 * F.G) convert_ffn_queue(F, l + 1, 1);
        PHASE_END
        PHASE_BEGIN
            norm2_rows(F, l);
        PHASE_END
        PHASE_BEGIN
            if (!moe) {
                SchedPlain S; S.init((const bf16_t*)(F.ws + WS_HB), (const bf16_t*)(F.ws + WS_WF1), NPAN, 2 * DFF / 256, DM, F.G, F.bid);
                EpiSwiGLU E{(bf16_t*)(F.ws + WS_HID), DFF};
                pg8::gemm_phase<EpiSwiGLU, SchedPlain, false, false>(F.lds, DM, S, E, F.wv);
            } else {
                LAS int* mi = (LAS int*)(misc + 16);
                __syncthreads();
                if (F.tid == 0) moe_info_build(mi, F.ctl + CW_MOE + li * NEXP * 64);
                __syncthreads();
                SchedMoeUp S; S.I.p = mi; S.nN = 2 * DFFE / 256; S.G = F.G; S.c = F.bid; S.A = (const char*)(F.ws + WS_HB); S.W = (const char*)(F.ws + WS_WM13); S.tok = (const int*)(F.ws + WS_TOK);
                S.wstride = (size_t)2 * DFFE * DM * 2; S.tstep = (size_t)256 * DM * 2;
                EpiSwiGLU E{(bf16_t*)(F.ws + WS_HID), DFFE};
                pg8::gemm_phase<EpiSwiGLU, SchedMoeUp, true, false>(F.lds, DM, S, E, F.wv);
            }
        PHASE_END
        PHASE_BEGIN
            int bgq = 0;
            if (!moe) {
                SchedPlain S; S.init((const bf16_t*)(F.ws + WS_HID), (const bf16_t*)(F.ws + WS_WF2), NPAN, 4, DFF, F.G, F.bid);
                EpiResid E{X, (const float*)(F.ws + WS_MODS) + (size_t)l * 9 * 6144 + 5 * DM, last, (const float*)X.lat, (const float*)X.ctx};
                pg8::gemm_phase<EpiResid, SchedPlain, false, false, false>(F.lds, DFF, S, E, F.wv);
                if (!last && F.bid >= NPAN * 4 - 2 * F.G) bgq = 2;
            } else {
                LAS int* mi = (LAS int*)(misc + 16);
                __syncthreads();
                if (F.tid == 0) moe_info_build(mi, F.ctl + CW_MOE + li * NEXP * 64);
                __syncthreads();
                SchedMoeDown S; S.I.p = mi; S.nN = 4; S.G = F.G; S.c = F.bid; S.A = (const char*)(F.ws + WS_HID); S.W = (const char*)(F.ws + WS_WM2);
                S.wstride = (size_t)DM * DFFE * 2; S.tstepA = (size_t)256 * DFFE * 2; S.tstepB = (size_t)256 * DFFE * 2;
                MoeInfo I2; I2.p = mi;
                EpiMoeDown E{&I2, (const int*)(F.ws + WS_TOK), (const float*)(F.ws + WS_GW), (bf16_t*)(F.ws + WS_SLOT)};
                pg8::gemm_phase<EpiMoeDown, SchedMoeDown, false, false>(F.lds, DFFE, S, E, F.wv);
                if (!last) { const int n = mi[16] * 4; const int rounds = (n + F.G - 1) / F.G; if (F.bid >= n - (rounds - 1) * F.G) bgq = 2; }
            }
            if (bgq) convert_ffn_queue(F, l + 1, bgq);
        PHASE_END
    }
__global__ void __launch_bounds__(NTHR, 2) mk_fwd(Args args) {
    extern __shared__ __attribute__((aligned(16))) unsigned char lds[];
    Frame F;
    F.lds = (LAS unsigned char*)lds; F.tid = threadIdx.x; F.lane = F.tid & 63; F.wave = __builtin_amdgcn_readfirstlane(F.tid >> 6); F.wv = F.wave;
    F.G = gridDim.x; F.bid = blockIdx.x; F.in = args.in; F.ws = args.ws; F.out = args.out; F.ctl = (unsigned*)(args.ws + WS_CTL);
    LAS unsigned* misc = (LAS unsigned*)(F.lds + MISC_OFF);
    if (F.tid < 64) misc[F.tid] = 0u;
    __syncthreads();
    XcdBarrier bar = xcd_barrier_post(F.ctl + CW_BAR, (volatile LAS unsigned*)(misc + 8));
    const int vcu = (F.G % 8 == 0) ? (F.bid % 8) * (F.G / 8) + F.bid / 8 : F.bid;
    XMap X{F.out, (float*)(F.ws + WS_XC)};

    PHASE_BEGIN
        p0_mods(F); p0_a3(F); p0_zero_rows(F);
    PHASE_END

    layer_phases<0>(F, args, bar, misc, vcu, X, lds); layer_phases<1>(F, args, bar, misc, vcu, X, lds); layer_phases<2>(F, args, bar, misc, vcu, X, lds); layer_phases<3>(F, args, bar, misc, vcu, X, lds);
    { F.tid = opaque_tid(F.wv); F.lane = F.tid & 63; F.wave = __builtin_amdgcn_readfirstlane(F.tid >> 6);
      final_rows(F); }
#undef PHASE_BEGIN
#undef PHASE_END
}

extern "C" void kernel_launch(void* const* d_in, const int* in_sizes, int n_in, void* d_out, int out_size, void* d_ws, size_t ws_size, hipStream_t stream) {
    static int grid = 0;
    if (grid == 0) {
        if (n_in != 42 || in_sizes[0] != NB * SEQ * DM || out_size != NB * SEQ * DM || ws_size < WS_END) { fprintf(stderr, "kernel_launch: unexpected shapes (n_in %d, ws %zu)\n", n_in, ws_size); grid = -1; return; }
        int dev = 0, cus = 0;
        if (hipGetDevice(&dev) != hipSuccess || hipDeviceGetAttribute(&cus, hipDeviceAttributeMultiprocessorCount, dev) != hipSuccess) { grid = -1; return; }
        if (hipFuncSetAttribute((const void*)mk_fwd, hipFuncAttributeMaxDynamicSharedMemorySize, LDS_BYTES) != hipSuccess) { fprintf(stderr, "kernel_launch: hipFuncSetAttribute failed\n"); grid = -1; return; }
        int per_cu = 0;
        if (hipOccupancyMaxActiveBlocksPerMultiprocessor(&per_cu, (const void*)mk_fwd, NTHR, LDS_BYTES) != hipSuccess || per_cu < 1) fprintf(stderr, "kernel_launch: occupancy query reports %d\n", per_cu);
        (void)hipGetLastError();
        if (cus < 256) { fprintf(stderr, "kernel_launch: built for a 256-CU device (one resident workgroup per CU), found %d\n", cus); grid = -1; return; }
        grid = 256;
    }
    if (grid < 0) return;
    if (hipMemsetAsync((char*)d_ws + WS_CTL, 0, CTL_ZERO_BYTES, stream) != hipSuccess) return;
    Args a{};
    for (int i = 0; i < 42; ++i) a.in[i] = (const float*)d_in[i];
    a.out = (float*)d_out; a.ws = (unsigned char*)d_ws;
    hipLaunchKernelGGL(mk_fwd, dim3(grid), dim3(NTHR), LDS_BYTES, stream, a);
}
```
